# Optimizing an MI355X kernel written in HIP

```python
import math
import jax
import jax.numpy as jnp
from jax import lax
import numpy as np

D_MODEL = 2048
BATCH = 16
SEQ = 2048
DEPTH = 2
DEC_BATCH = 2
DEC_SEQ = 16384
PAST_LEN = 128

GRID_W = 64
N_EVEN = (DEPTH + 1) // 2
N_ODD = DEPTH // 2
EPS = 1e-6
NA_HEADS = 8
NA_HEAD_DIM = 128
NA_WIN_ROWS = 8
NA_WIN_COLS = 16
NA_COL_BLOCK = 16
NA_KEY_COLS = 32
NA_W = NA_HEADS * NA_HEAD_DIM
HG_HEADS = 8
HG_KEY_DIM = 128
HG_VAL_DIM = 128
HG_CHUNK = 32
HG_K = HG_HEADS * HG_KEY_DIM
HG_V = HG_HEADS * HG_VAL_DIM
EVEN_IN = 3 * NA_W + 3 * HG_K + 2 * HG_V
EVEN_MIX = NA_W + HG_V
MLA_HEADS = 16
MLA_Q_RANK = 768
MLA_KV_RANK = 512
MLA_NOPE = 128
MLA_ROPE = 64
MLA_V = 128
MLA_QK = MLA_NOPE + MLA_ROPE
ODD_IN = MLA_Q_RANK + MLA_KV_RANK + MLA_ROPE
ROPE_BASE = 10000.0
ATTN_Q_BLOCK = 128
PEER_HEADS = 8
PEER_N_KEYS = 128
PEER_N_EXPERTS = PEER_N_KEYS * PEER_N_KEYS
PEER_TOPK = 16
PEER_D_KEY = 256
PEER_TOKEN_BLOCK = 128

kernel_name = 'hybrid_natten_hgrn2_mla_peer_encoder'


def _rmsnorm(x, gain):
    xf = x.astype(jnp.float32)
    y = xf * lax.rsqrt(jnp.mean(xf * xf, axis=-1, keepdims=True) + EPS)
    return (y * gain.astype(jnp.float32)).astype(x.dtype)


def _neighbourhood_attention(q, k, v, rpb):
    B, S, H, Dh = q.shape
    rows = S // GRID_W
    wr = min(NA_WIN_ROWS, rows)
    n_cb = GRID_W // NA_COL_BLOCK
    qcol = np.arange(GRID_W).reshape(n_cb, NA_COL_BLOCK)
    qc0 = np.clip(qcol - NA_WIN_COLS // 2, 0, GRID_W - NA_WIN_COLS)
    kc0 = np.clip(np.arange(n_cb) * NA_COL_BLOCK - NA_WIN_COLS // 2, 0, GRID_W - NA_KEY_COLS)
    kcol = kc0[:, None] + np.arange(NA_KEY_COLS)[None, :]
    col_ok = (kcol[:, None, :] >= qc0[:, :, None]) & (kcol[:, None, :] < qc0[:, :, None] + NA_WIN_COLS)
    dcol = np.clip(kcol[:, None, :] - qcol[:, :, None] + NA_WIN_COLS - 1, 0, 2 * NA_WIN_COLS - 2)
    col_bias = rpb.astype(jnp.float32)[:, :, dcol]
    mask = jnp.asarray(col_ok)[:, :, None, :]
    qg = q.reshape(B, rows, n_cb, NA_COL_BLOCK, H, Dh).transpose(1, 0, 2, 3, 4, 5)
    kg = k.reshape(B, rows, GRID_W, H, Dh)[:, :, kcol]
    vg = v.reshape(B, rows, GRID_W, H, Dh)[:, :, kcol]
    scale = NA_HEAD_DIM ** -0.5

    def row_block(args):
        r, q_r = args
        r0 = jnp.clip(r - wr // 2, 0, rows - wr)
        k_r = lax.dynamic_slice_in_dim(kg, r0, wr, axis=1)
        v_r = lax.dynamic_slice_in_dim(vg, r0, wr, axis=1)
        s = jnp.einsum('bjqhd,bwjkhd->bhjqwk', q_r, k_r).astype(jnp.float32) * scale
        dr = r0 + jnp.arange(wr) - r + (NA_WIN_ROWS - 1)
        bias = jnp.take(col_bias, dr, axis=1).transpose(0, 2, 3, 1, 4)
        s = jnp.where(mask, s + bias, -jnp.inf)
        p = jax.nn.softmax(s.reshape(s.shape[:4] + (wr * NA_KEY_COLS,)), axis=-1).reshape(s.shape)
        return jnp.einsum('bhjqwk,bwjkhd->bjqhd', p.astype(v.dtype), v_r)

    out = lax.map(row_block, (jnp.arange(rows), qg))
    return out.transpose(1, 0, 2, 3, 4, 5).reshape(B, S, H * Dh)


def _hgrn2_scan(q, f_logit, lb, i):
    B, S, H, K = q.shape
    V = i.shape[-1]
    C = HG_CHUNK
    N = S // C
    lbh = lb.astype(jnp.float32).reshape(H, K)
    f = lbh + (1.0 - lbh) * jax.nn.sigmoid(f_logit.astype(jnp.float32))
    logf = jnp.log(f)
    kk = 1.0 - f

    def chunks(a):
        return a.astype(jnp.float32).reshape(B, N, C, H, a.shape[-1]).transpose(1, 0, 3, 2, 4)

    causal = jnp.tril(jnp.ones((C, C), dtype=bool))[:, :, None]

    def step(state, inp):
        qc, lc, kc, vc = inp
        b = jnp.cumsum(lc, axis=2)
        o_inter = jnp.einsum('bhtk,bhkv->bhtv', qc * jnp.exp(b), state)
        decay = jnp.exp(jnp.where(causal, b[:, :, :, None, :] - b[:, :, None, :, :], -jnp.inf))
        a = jnp.einsum('bhtsk,bhsk->bhts', qc[:, :, :, None, :] * decay, kc)
        o_intra = jnp.einsum('bhts,bhsv->bhtv', a, vc)
        b_last = b[:, :, -1:, :]
        new_state = jnp.exp(b_last[:, :, 0, :])[..., None] * state + jnp.einsum('bhsk,bhsv->bhkv', kc * jnp.exp(b_last - b), vc)
        return new_state, o_inter + o_intra

    state0 = jnp.zeros((B, H, K, V), jnp.float32)
    _, o = lax.scan(step, state0, (chunks(q), chunks(logf), chunks(kk), chunks(i)))
    return o.transpose(1, 0, 3, 2, 4).reshape(B, S, H, V)


def _even_mixer(x, norm, w_in, na_q_gain, na_k_gain, na_rpb, lb, hg_out_gain, w_out):
    B, S, _ = x.shape
    h = _rmsnorm(x, norm)
    p = h @ w_in
    sizes = [NA_W, NA_W, NA_W, HG_K, HG_K, HG_K, HG_V, HG_V]
    cuts = [int(c) for c in np.cumsum(sizes)[:-1]]
    qa, ka, va, qb, f_fw, f_bw, ib, gb = jnp.split(p, cuts, axis=-1)
    qa = _rmsnorm(qa.reshape(B, S, NA_HEADS, NA_HEAD_DIM), na_q_gain)
    ka = _rmsnorm(ka.reshape(B, S, NA_HEADS, NA_HEAD_DIM), na_k_gain)
    na = _neighbourhood_attention(qa, ka, va.reshape(B, S, NA_HEADS, NA_HEAD_DIM), na_rpb)
    qb = jax.nn.silu(qb.reshape(B, S, HG_HEADS, HG_KEY_DIM))
    f_fw = f_fw.reshape(B, S, HG_HEADS, HG_KEY_DIM)
    f_bw = f_bw.reshape(B, S, HG_HEADS, HG_KEY_DIM)
    ib = ib.reshape(B, S, HG_HEADS, HG_VAL_DIM)
    o = _hgrn2_scan(qb, f_fw, lb[0], ib) + _hgrn2_scan(qb[:, ::-1], f_bw[:, ::-1], lb[1], ib[:, ::-1])[:, ::-1]
    gate = jax.nn.silu(gb.reshape(B, S, HG_HEADS, HG_VAL_DIM).astype(jnp.float32))
    hg = (_rmsnorm(o, hg_out_gain) * gate).astype(x.dtype).reshape(B, S, HG_V)
    return jnp.concatenate([na, hg], axis=-1) @ w_out


def _rope_tail(t):
    S = t.shape[1]
    half = MLA_ROPE // 2
    pos = jnp.arange(S, dtype=jnp.float32)
    inv = 1.0 / (ROPE_BASE ** (jnp.arange(0, MLA_ROPE, 2, dtype=jnp.float32) / MLA_ROPE))
    ang = pos[:, None] * inv[None, :]
    cos = jnp.cos(ang)[None, :, None, :]
    sin = jnp.sin(ang)[None, :, None, :]
    tf = t.astype(jnp.float32)
    x1 = tf[..., MLA_NOPE:MLA_NOPE + half]
    x2 = tf[..., MLA_NOPE + half:]
    rot = jnp.concatenate([x1 * cos - x2 * sin, x2 * cos + x1 * sin], axis=-1)
    return jnp.concatenate([tf[..., :MLA_NOPE], rot], axis=-1).astype(t.dtype)


def _mla(x, norm, w_in, q_norm, kv_norm, w_uq, w_ukv, q_gain, k_gain, w_out):
    B, S, _ = x.shape
    h = _rmsnorm(x, norm)
    c_q, c_kv, k_rope = jnp.split(h @ w_in, [MLA_Q_RANK, MLA_Q_RANK + MLA_KV_RANK], axis=-1)
    q = (_rmsnorm(c_q, q_norm) @ w_uq).reshape(B, S, MLA_HEADS, MLA_QK)
    kv = (_rmsnorm(c_kv, kv_norm) @ w_ukv).reshape(B, S, MLA_HEADS, MLA_NOPE + MLA_V)
    k_nope, v = jnp.split(kv, [MLA_NOPE], axis=-1)
    k = jnp.concatenate([k_nope, jnp.broadcast_to(k_rope[:, :, None, :], (B, S, MLA_HEADS, MLA_ROPE))], axis=-1)
    q = _rope_tail(_rmsnorm(q, q_gain))
    k = _rope_tail(_rmsnorm(k, k_gain))
    nb = S // ATTN_Q_BLOCK
    qb = q.reshape(B, nb, ATTN_Q_BLOCK, MLA_HEADS, MLA_QK).transpose(1, 0, 2, 3, 4)
    scale = MLA_QK ** -0.5

    def block(q_blk):
        s = jnp.einsum('bqhd,bkhd->bhqk', q_blk, k).astype(jnp.float32) * scale
        p = jax.nn.softmax(s, axis=-1).astype(v.dtype)
        return jnp.einsum('bhqk,bkhd->bqhd', p, v)

    o = lax.map(block, qb).transpose(1, 0, 2, 3, 4).reshape(B, S, MLA_HEADS * MLA_V)
    return o @ w_out


def _peer(h, w_query, sub_keys, u, v):
    B, S, D = h.shape
    T = B * S
    x = h.reshape(T, D)
    qry = (x @ w_query).reshape(T, PEER_HEADS, 2, PEER_D_KEY // 2)
    s = jnp.einsum('thpd,hpnd->thpn', qry, sub_keys).astype(jnp.float32)
    s1, i1 = lax.top_k(s[:, :, 0], PEER_TOPK)
    s2, i2 = lax.top_k(s[:, :, 1], PEER_TOPK)
    cand = (s1[..., :, None] + s2[..., None, :]).reshape(T, PEER_HEADS, PEER_TOPK * PEER_TOPK)
    cidx = (i1[..., :, None] * PEER_N_KEYS + i2[..., None, :]).reshape(T, PEER_HEADS, PEER_TOPK * PEER_TOPK)
    top_s, pos = lax.top_k(cand, PEER_TOPK)
    idx = jnp.take_along_axis(cidx, pos, axis=-1)
    gate = jax.nn.softmax(top_s, axis=-1).astype(h.dtype)
    nb = T // PEER_TOKEN_BLOCK
    E = PEER_HEADS * PEER_TOPK

    def blk(args):
        xb, ib, gb = args
        ue = jnp.take(u, ib, axis=0)
        ve = jnp.take(v, ib, axis=0)
        a = jax.nn.gelu(jnp.einsum('td,ted->te', xb, ue), approximate=False)
        return jnp.einsum('te,ted->td', gb * a, ve)

    out = lax.map(blk, (x.reshape(nb, PEER_TOKEN_BLOCK, D), idx.reshape(nb, PEER_TOKEN_BLOCK, E), gate.reshape(nb, PEER_TOKEN_BLOCK, E)))
    return out.reshape(B, S, D)


def setup_inputs(seed: int = 0) -> dict:
    key = jax.random.key(seed)
    ks = iter(jax.random.split(key, 32))

    def nrm(shape, scale):
        return jax.random.normal(next(ks), shape, jnp.float32) * scale

    def gain(shape):
        return 1.0 + 0.02 * jax.random.normal(next(ks), shape, jnp.float32)

    return {
        'x_prompt': nrm((BATCH, SEQ, D_MODEL), 1.0),
        'x_sample': nrm((DEC_BATCH, DEC_SEQ, D_MODEL), 1.0),
        'ev_norm': gain((N_EVEN, D_MODEL)),
        'ev_w_in': nrm((N_EVEN, D_MODEL, EVEN_IN), D_MODEL ** -0.5),
        'ev_na_q_gain': gain((N_EVEN, NA_HEAD_DIM)),
        'ev_na_k_gain': gain((N_EVEN, NA_HEAD_DIM)),
        'ev_na_rpb': nrm((N_EVEN, NA_HEADS, 2 * NA_WIN_ROWS - 1, 2 * NA_WIN_COLS - 1), 0.02),
        'ev_hg_lb_logits': nrm((2, N_EVEN + 1, HG_K), 0.5),
        'ev_hg_out_gain': gain((N_EVEN, HG_VAL_DIM)),
        'ev_w_out': nrm((N_EVEN, EVEN_MIX, D_MODEL), EVEN_MIX ** -0.5),
        'od_norm': gain((N_ODD, D_MODEL)),
        'od_w_in': nrm((N_ODD, D_MODEL, ODD_IN), D_MODEL ** -0.5),
        'od_q_norm': gain((N_ODD, MLA_Q_RANK)),
        'od_kv_norm': gain((N_ODD, MLA_KV_RANK)),
        'od_w_uq': nrm((N_ODD, MLA_Q_RANK, MLA_HEADS * MLA_QK), MLA_Q_RANK ** -0.5),
        'od_w_ukv': nrm((N_ODD, MLA_KV_RANK, MLA_HEADS * (MLA_NOPE + MLA_V)), MLA_KV_RANK ** -0.5),
        'od_q_gain': gain((N_ODD, MLA_QK)),
        'od_k_gain': gain((N_ODD, MLA_QK)),
        'od_w_out': nrm((N_ODD, MLA_HEADS * MLA_V, D_MODEL), (MLA_HEADS * MLA_V) ** -0.5),
        'ff_norm': gain((DEPTH, D_MODEL)),
        'peer_w_query': nrm((DEPTH, D_MODEL, PEER_HEADS * PEER_D_KEY), D_MODEL ** -0.5),
        'peer_sub_keys': nrm((DEPTH, PEER_HEADS, 2, PEER_N_KEYS, PEER_D_KEY // 2), (PEER_D_KEY // 2) ** -0.5),
        'peer_u': nrm((DEPTH, PEER_N_EXPERTS, D_MODEL), D_MODEL ** -0.5),
        'peer_v': nrm((DEPTH, PEER_N_EXPERTS, D_MODEL), (PEER_HEADS * PEER_TOPK) ** -0.5),
    }


def reference(x_prompt, x_sample, ev_norm, ev_w_in, ev_na_q_gain, ev_na_k_gain, ev_na_rpb, ev_hg_lb_logits, ev_hg_out_gain, ev_w_out, od_norm, od_w_in, od_q_norm, od_kv_norm, od_w_uq, od_w_ukv, od_q_gain, od_k_gain, od_w_out, ff_norm, peer_w_query, peer_sub_keys, peer_u, peer_v):
    lb_all = jnp.cumsum(jax.nn.softmax(ev_hg_lb_logits.astype(jnp.float32), axis=1), axis=1)

    def run(x):
        for layer in range(DEPTH):
            j = layer // 2
            if layer % 2 == 0:
                x = x + _even_mixer(x, ev_norm[j], ev_w_in[j], ev_na_q_gain[j], ev_na_k_gain[j], ev_na_rpb[j], lb_all[:, j], ev_hg_out_gain[j], ev_w_out[j])
            else:
                x = x + _mla(x, od_norm[j], od_w_in[j], od_q_norm[j], od_kv_norm[j], od_w_uq[j], od_w_ukv[j], od_q_gain[j], od_k_gain[j], od_w_out[j])
            x = x + _peer(_rmsnorm(x, ff_norm[layer]), peer_w_query[layer], peer_sub_keys[layer], peer_u[layer], peer_v[layer])
        return x

    y_prompt = run(x_prompt)
    y_sample = run(x_sample)
    return (y_prompt, y_sample)
```

```cpp
#include <hip/hip_runtime.h>
#include <stdint.h>
#include <stdio.h>

#define DEVI __device__ __forceinline__
typedef unsigned short u16;
typedef unsigned int u32;
using bf16x8 = __attribute__((ext_vector_type(8))) short;
using s16x4  = __attribute__((ext_vector_type(4))) short;
using f32x4  = __attribute__((ext_vector_type(4))) float;
using f32x16 = __attribute__((ext_vector_type(16))) float;
using u32x4  = __attribute__((ext_vector_type(4))) unsigned;
using u32x2  = __attribute__((ext_vector_type(2))) unsigned;

constexpr int DM = 2048;
constexpr int T_ALL = 65536;
constexpr int MBT = 16384;
constexpr int NMB = 4;
constexpr int NTHR = 512;
constexpr int EVEN_IN = 8192;
constexpr int ODD_IN = 1344, ODD_IN_PAD = 1536;
constexpr float EPS = 1e-6f;

constexpr size_t A256(size_t x) { return (x + 255) / 256 * 256; }
constexpr size_t WS_BAR      = 0;
constexpr size_t WS_WT_EVIN  = 16384;
constexpr size_t WS_WT_EVOUT = WS_WT_EVIN  + (size_t)8192 * 2048 * 2;
constexpr size_t WS_WT_ODIN  = WS_WT_EVOUT + (size_t)2048 * 2048 * 2;
constexpr size_t WS_WT_UQ    = WS_WT_ODIN  + (size_t)1536 * 2048 * 2;
constexpr size_t WS_WT_UKV   = WS_WT_UQ    + (size_t)3072 * 768 * 2;
constexpr size_t WS_WT_ODOUT = WS_WT_UKV   + (size_t)4096 * 512 * 2;
constexpr size_t WS_WEFF     = WS_WT_ODOUT + (size_t)2048 * 2048 * 2;
constexpr size_t WS_ROPE     = WS_WEFF     + (size_t)2 * 2048 * 2048 * 2;
constexpr size_t WS_UB       = WS_ROPE     + (size_t)16384 * 64 * 4;
constexpr size_t WS_VB       = WS_UB       + (size_t)16384 * 2048 * 2;
constexpr size_t WS_IDX      = WS_VB       + (size_t)16384 * 2048 * 2;
constexpr size_t WS_GATE     = WS_IDX      + (size_t)T_ALL * 128 * 4;
constexpr size_t WS_H        = WS_GATE     + (size_t)T_ALL * 128 * 4;
constexpr size_t WS_P        = WS_H        + (size_t)MBT * 2048 * 2;
constexpr size_t WS_MIX      = WS_P        + (size_t)MBT * 8192 * 2;
constexpr size_t WS_E        = WS_MIX      + (size_t)MBT * 2048 * 2;
constexpr size_t WS_DEC      = WS_E        + (size_t)64 * 16 * 16384 * 4;
constexpr size_t WS_OFB      = WS_DEC      + (size_t)64 * 16 * 128 * 4;
constexpr size_t WS_END      = WS_OFB      + (size_t)2 * MBT * 1024 * 4;

constexpr int LDS_BYTES = 131072 + 2048;

struct Params {
  const float* in[24];
  float* out;
  unsigned char* ws;
  int step_lo, step_hi;
};

#define XB_TMO      128
#define XB_XCNT(j)  (256  + 64 * (j))
#define XB_XSUB(j)  (1280 + 64 * (j))
#define XB_XGEN(j)  (2304 + 64 * (j))
#define XB_TOP      3328
#define XB_TOPGEN   3392
#define XCD_BAR_WORDS 3456
#define XB_SPIN_CAP (1u << 18)
#define LAS __attribute__((address_space(3)))

__device__ __forceinline__ unsigned xb_ld(unsigned* p)              { return __hip_atomic_load(p, __ATOMIC_RELAXED, __HIP_MEMORY_SCOPE_AGENT); }
__device__ __forceinline__ unsigned xb_add(unsigned* p, unsigned v) { return __hip_atomic_fetch_add(p, v, __ATOMIC_RELAXED, __HIP_MEMORY_SCOPE_AGENT); }
__device__ __forceinline__ unsigned xb_xcc_id() { return (unsigned)__builtin_amdgcn_s_getreg((3 << 11) | 20) & 0xFu; }
#define XB_SPIN(cond, bar) do { unsigned _sp = 0; while (cond) { __builtin_amdgcn_s_sleep(1); \
    if ((++_sp & 255u) == 0u) { if (xb_ld(&(bar)[XB_TMO])) break; if (_sp > XB_SPIN_CAP) { atomicAdd(&(bar)[XB_TMO], 1u); break; } } } } while (0)

struct XcdBarrier {
    unsigned* bar; unsigned x;
    volatile LAS unsigned* st;
};
__device__ __forceinline__ XcdBarrier xcd_barrier_post(unsigned* bar, volatile LAS unsigned* st) {
    XcdBarrier b; b.bar = bar; b.x = xb_xcc_id(); b.st = st;
    if (threadIdx.x == 0) (void)xb_add(&bar[XB_XCNT(b.x)], 1u);
    return b;
}
__device__ __forceinline__ void xcd_barrier_complete(unsigned* bar, unsigned x, unsigned& nloc, unsigned& nx) {
    const unsigned G = gridDim.x * gridDim.y * gridDim.z;
    unsigned sum, cnt, mine, sp = 0u;
    for (;;) {
        sum = 0u; cnt = 0u; mine = 0u;
#pragma unroll
        for (unsigned j = 0; j < 16; ++j) { const unsigned c = xb_ld(&bar[XB_XCNT(j)]); sum += c; cnt += (c > 0u) ? 1u : 0u; mine = (j == x) ? c : mine; }
        if (sum == G) break;
        __builtin_amdgcn_s_sleep(1);
        if ((++sp & 255u) == 0u) { if (xb_ld(&bar[XB_TMO])) break; if (sp > XB_SPIN_CAP) { atomicAdd(&bar[XB_TMO], 1u); break; } }
    }
    nloc = mine > 0u ? mine : 1u; nx = cnt > 0u ? cnt : 1u;
}
__device__ __forceinline__ void xcd_barrier(const XcdBarrier& b) {
    asm volatile("s_waitcnt vmcnt(0)" ::: "memory");
    __syncthreads();
    if (threadIdx.x == 0) {
        unsigned* bar = b.bar;
        __builtin_amdgcn_s_waitcnt(0);
        unsigned nloc = b.st[0], nx = b.st[1];
        if (nloc == 0u) { xcd_barrier_complete(bar, b.x, nloc, nx); b.st[0] = nloc; b.st[1] = nx; }
        const unsigned old = xb_add(&bar[XB_XSUB(b.x)], 1u);
        const unsigned gen = old / nloc;
        if (old + 1u == (gen + 1u) * nloc) {
            __builtin_amdgcn_fence(__ATOMIC_RELEASE, "agent");
            asm volatile("s_waitcnt vmcnt(0)" ::: "memory");
            const unsigned og = xb_add(&bar[XB_TOP], 1u);
            const unsigned tg = og / nx;
            if (og + 1u == (tg + 1u) * nx) xb_add(&bar[XB_TOPGEN], 1u);
            else XB_SPIN(xb_ld(&bar[XB_TOPGEN]) == tg, bar);
            __builtin_amdgcn_fence(__ATOMIC_ACQUIRE, "agent");
            xb_add(&bar[XB_XGEN(b.x)], 1u);
            asm volatile("s_waitcnt vmcnt(0)" ::: "memory");
        } else {
            XB_SPIN(xb_ld(&bar[XB_XGEN(b.x)]) == gen, bar);
            __builtin_amdgcn_fence(__ATOMIC_ACQUIRE, "agent");
            asm volatile("s_waitcnt vmcnt(0)" ::: "memory");
        }
    }
    __syncthreads();
}

DEVI unsigned cvtpk(float lo, float hi) {
  unsigned r; asm volatile("v_cvt_pk_bf16_f32 %0, %1, %2" : "=v"(r) : "v"(lo), "v"(hi)); return r;
}
DEVI u16 f2bf(float x) { return (u16)(cvtpk(x, 0.f) & 0xffffu); }
DEVI float bf2f(u16 x) { return __uint_as_float(((unsigned)x) << 16); }
DEVI float bflo(unsigned w) { return __uint_as_float(w << 16); }
DEVI float bfhi(unsigned w) { return __uint_as_float(w & 0xffff0000u); }
DEVI int tid_l() { int t = threadIdx.x; asm volatile("" : "+v"(t)); return t; }
DEVI float wave_sum(float v) {
#pragma unroll
  for (int o = 32; o > 0; o >>= 1) v += __shfl_xor(v, o, 64);
  return v;
}

DEVI void transpose_tile(const float* __restrict__ src, int K, int N, u16* __restrict__ dst, int tile, float* lds) {
  const int ntk = K / 64;
  const int tk = tile % ntk, tn = tile / ntk;
  const int k0 = tk * 64, n0 = tn * 64;
  const int tid = tid_l();
  __syncthreads();
#pragma unroll
  for (int i = 0; i < 8; ++i) {
    int e = tid + i * NTHR; int kk = e >> 6, nn = e & 63;
    float v = (n0 + nn < N) ? src[(size_t)(k0 + kk) * N + n0 + nn] : 0.f;
    lds[kk * 65 + nn] = v;
  }
  __syncthreads();
#pragma unroll
  for (int i = 0; i < 8; ++i) {
    int e = tid + i * NTHR; int nn = e >> 6, kk = e & 63;
    dst[(size_t)(n0 + nn) * K + k0 + kk] = f2bf(lds[kk * 65 + nn]);
  }
}

DEVI void ph_prologue(const Params& p, char* smem) {
  float* lds = (float*)smem;
  const int G = gridDim.x, b = blockIdx.x, tid = tid_l();
#define TJOB(srcp, K_, N_, NP_, OFF_) do { const int nt_ = ((K_) / 64) * ((NP_) / 64); \
    _Pragma("unroll 1") for (int t = b; t < nt_; t += G) transpose_tile(srcp, K_, N_, (u16*)(p.ws + (OFF_)), t, lds); } while (0)
  TJOB(p.in[3],  2048, 8192, 8192, WS_WT_EVIN);
  TJOB(p.in[9],  2048, 2048, 2048, WS_WT_EVOUT);
  TJOB(p.in[11], 2048, ODD_IN, ODD_IN_PAD, WS_WT_ODIN);
  TJOB(p.in[14], 768,  3072, 3072, WS_WT_UQ);
  TJOB(p.in[15], 512,  4096, 4096, WS_WT_UKV);
  TJOB(p.in[18], 2048, 2048, 2048, WS_WT_ODOUT);
#undef TJOB
  __syncthreads();
  {
    float* sk = lds;
    float* wq = lds + 128 * 129;
#pragma unroll 1
    for (int job = b; job < 2 * 16 * 32; job += G) {
      const int l = job / 512, hp = (job / 32) % 16, kt = job % 32, k0 = kt * 64;
      const float* SK = p.in[21] + ((size_t)(l * 16 + hp) * 128) * 128;
      const float* WQ = p.in[20] + (size_t)l * 2048 * 2048;
      __syncthreads();
      for (int e = tid; e < 128 * 128; e += NTHR) sk[(e >> 7) * 129 + (e & 127)] = SK[e];
      for (int e = tid; e < 64 * 128; e += NTHR) { int kk = e >> 7, d = e & 127; wq[kk * 129 + d] = WQ[(size_t)(k0 + kk) * 2048 + hp * 128 + d]; }
      __syncthreads();
      const int kk = tid & 63, ng = tid >> 6;
      float acc[16];
#pragma unroll
      for (int i = 0; i < 16; ++i) acc[i] = 0.f;
#pragma unroll 4
      for (int d = 0; d < 128; ++d) {
        const float w = wq[kk * 129 + d];
#pragma unroll
        for (int i = 0; i < 16; ++i) acc[i] += sk[(ng * 16 + i) * 129 + d] * w;
      }
      u16* dst = (u16*)(p.ws + WS_WEFF) + (size_t)l * 2048 * 2048;
#pragma unroll
      for (int i = 0; i < 16; ++i) dst[(size_t)(hp * 128 + ng * 16 + i) * 2048 + k0 + kk] = f2bf(acc[i]);
    }
  }
  {
    float* rc = (float*)(p.ws + WS_ROPE);
    for (int e = b * NTHR + tid; e < 16384 * 32; e += G * NTHR) {
      const int pos = e >> 5, i = e & 31;
      const float inv = 1.0f / powf(10000.f, (float)(2 * i) / 64.f);
      const float ang = (float)pos * inv;
      float s, c; sincosf(ang, &s, &c);
      rc[e] = c; rc[16384 * 32 + e] = s;
    }
  }
}

DEVI void ph_convert_uv(const Params& p, int layer) {
  const size_t n8 = (size_t)16384 * 2048 / 8;
  const float* U = p.in[22] + (size_t)layer * 16384 * 2048;
  const float* V = p.in[23] + (size_t)layer * 16384 * 2048;
  u32x4* ub = (u32x4*)(p.ws + WS_UB); u32x4* vb = (u32x4*)(p.ws + WS_VB);
  for (size_t i = (size_t)blockIdx.x * NTHR + tid_l(); i < 2 * n8; i += (size_t)gridDim.x * NTHR) {
    const bool isu = i < n8; const size_t j = isu ? i : i - n8;
    const f32x4* s = (const f32x4*)((isu ? U : V) + j * 8);
    const f32x4 a = s[0], c = s[1];
    u32x4 w = {cvtpk(a[0], a[1]), cvtpk(a[2], a[3]), cvtpk(c[0], c[1]), cvtpk(c[2], c[3])};
    (isu ? ub : vb)[j] = w;
  }
}

DEVI void ph_copy_x(const Params& p) {
  const size_t n4 = (size_t)T_ALL * DM / 4, h4 = n4 / 2;
  const f32x4* a = (const f32x4*)p.in[0]; const f32x4* c = (const f32x4*)p.in[1];
  f32x4* o = (f32x4*)p.out;
  for (size_t i = (size_t)blockIdx.x * NTHR + threadIdx.x; i < n4; i += (size_t)gridDim.x * NTHR)
    o[i] = (i < h4) ? a[i] : c[i - h4];
}


constexpr int G_BK = 64, G_HALF = 128, G_HT = G_HALF * G_BK;
DEVI int g_lds_byte(int r, int c) {
  int st = (r >> 4) * 2 + (c >> 5), rr = r & 15, cc = c & 31, ob = rr * 64 + cc * 2;
  return st * 1024 + (ob ^ (((ob >> 9) & 1) << 5));
}
DEVI void g_stage_rc(int b, int& R, int& C) {
  int st = b / 1024, sb = b % 1024, swz = sb ^ (((sb >> 9) & 1) << 5);
  R = (st >> 1) * 16 + swz / 64; C = (st & 1) * 32 + (swz % 64) / 2;
}
enum { EPI_BF16 = 0, EPI_F32 = 1, EPI_RESID = 2 };
struct GemmEpi { void* out; const float* resid; int ldc; };

template <int EPI>
DEVI void gemm_tile(const u16* __restrict__ A, const u16* __restrict__ Bt, const int K, const int brow, const int bcol, const GemmEpi ep, char* smem) {
  u16* shm = (u16*)smem;
#define SA(b,h) (shm+((b)*2+(h))*G_HT)
#define SB(b,h) (shm+(4+(b)*2+(h))*G_HT)
#define STAGE_X(T,P,BASE,br,kt) do{long _g=(long)(br)*K+(long)(kt)*G_BK; \
    for(int _i=0;_i<2;++_i){int _b=(T)*16+_i*8192;int _r,_c;g_stage_rc(_b,_r,_c); \
      __builtin_amdgcn_global_load_lds((const unsigned*)(BASE+_g+(long)_r*K+_c), \
        (LAS unsigned*)((char*)(P)+_b),16,0,0);}}while(0)
#define STAGE(P,BASE,br,kt) STAGE_X(tid0,P,BASE,br,kt)
#define LDA(dst,b,h) for(int m=0;m<4;++m)for(int k=0;k<2;++k) \
    dst[m][k]=*reinterpret_cast<const bf16x8*>((char*)SA(b,h)+g_lds_byte(wr*64+m*16+fr,k*32+fq*8))
#define LDB(dst,b,h) for(int n=0;n<2;++n)for(int k=0;k<2;++k) \
    dst[n][k]=*reinterpret_cast<const bf16x8*>((char*)SB(b,h)+g_lds_byte(wc*32+n*16+fr,k*32+fq*8))
#define MMA(ai,bj,At_,Bt_) do{__builtin_amdgcn_s_setprio(1); \
    for(int m=0;m<4;++m)for(int n=0;n<2;++n)for(int k=0;k<2;++k) \
      acc[ai][bj][m][n]=__builtin_amdgcn_mfma_f32_16x16x32_bf16(Bt_[n][k],At_[m][k],acc[ai][bj][m][n],0,0,0); \
    __builtin_amdgcn_s_setprio(0);}while(0)
#define WAIT_V(n) asm volatile("s_waitcnt vmcnt(" #n ")":::"memory")
#define WAIT_L(n) asm volatile("s_waitcnt lgkmcnt(" #n ")":::"memory")
#define BAR __builtin_amdgcn_s_barrier()
#define SCHED __builtin_amdgcn_sched_barrier(0)
  const int tid0=tid_l();
  int wid=tid0>>6,lane=tid0&63,wr=wid>>2,wc=wid&3,fr=lane&15,fq=lane>>4;
  f32x4 acc[2][2][4][2]={};
  bf16x8 At[4][2],B0[2][2],B1[2][2];
  const int nt=K/G_BK;
  STAGE(SB(0,0),Bt,bcol,0); STAGE(SA(0,0),A,brow,0);
  STAGE(SB(0,1),Bt,bcol+G_HALF,0); STAGE(SA(0,1),A,brow+G_HALF,0);
  if(wr==1)BAR;
  WAIT_V(4); BAR;
  STAGE(SB(1,0),Bt,bcol,1); STAGE(SA(1,0),A,brow,1); STAGE(SB(1,1),Bt,bcol+G_HALF,1);
  WAIT_V(6); BAR;
#pragma unroll 1
  for(int t=0;t<nt-2;t+=2){
    LDB(B0,0,0); SCHED; LDA(At,0,0); STAGE(SA(1,1),A,brow+G_HALF,t+1);
    WAIT_L(8); BAR; WAIT_L(0); MMA(0,0,At,B0); BAR; SCHED;
    LDB(B1,0,1); STAGE(SB(0,0),Bt,bcol,t+2);
    BAR; WAIT_L(0); MMA(0,1,At,B1); BAR;
    LDA(At,0,1); STAGE(SA(0,0),A,brow,t+2);
    BAR; WAIT_L(0); MMA(1,0,At,B0); BAR; SCHED;
    STAGE(SB(0,1),Bt,bcol+G_HALF,t+2);
    WAIT_V(6); BAR; MMA(1,1,At,B1); BAR;
    LDB(B0,1,0); SCHED; LDA(At,1,0); STAGE(SA(0,1),A,brow+G_HALF,t+2);
    WAIT_L(8); BAR; WAIT_L(0); MMA(0,0,At,B0); BAR; SCHED;
    LDB(B1,1,1); STAGE(SB(1,0),Bt,bcol,t+3);
    BAR; WAIT_L(0); MMA(0,1,At,B1); BAR;
    LDA(At,1,1); STAGE(SA(1,0),A,brow,t+3);
    BAR; WAIT_L(0); MMA(1,0,At,B0); BAR; SCHED;
    STAGE(SB(1,1),Bt,bcol+G_HALF,t+3);
    WAIT_V(6); BAR; MMA(1,1,At,B1); BAR;
  }
  int tz=tid_l(); wid=tz>>6; lane=tz&63; wr=wid>>2; wc=wid&3; fr=lane&15; fq=lane>>4;
  { LDB(B0,0,0); WAIT_V(0); LDA(At,0,0); STAGE_X(tz,SA(1,1),A,brow+G_HALF,nt-1);
    BAR; WAIT_L(0); MMA(0,0,At,B0); BAR;
    LDB(B1,0,1); BAR; WAIT_L(0); MMA(0,1,At,B1); BAR;
    LDA(At,0,1); WAIT_V(4); BAR; WAIT_L(0); MMA(1,0,At,B0); MMA(1,1,At,B1); BAR; }
  { LDB(B0,1,0); LDA(At,1,0); WAIT_V(2); BAR; WAIT_L(0); MMA(0,0,At,B0); BAR;
    LDB(B1,1,1); WAIT_V(0); BAR; WAIT_L(0); MMA(0,1,At,B1); BAR;
    LDA(At,1,1); BAR; WAIT_L(0); MMA(1,0,At,B0); MMA(1,1,At,B1); BAR; }
  if(wr==0)BAR;
#pragma unroll
  for(int ai=0;ai<2;++ai)
#pragma unroll
  for(int m=0;m<4;++m){
    const long row=brow+ai*G_HALF+wr*64+m*16+fr;
#pragma unroll
    for(int bj=0;bj<2;++bj)
#pragma unroll
    for(int n=0;n<2;++n){
      const int col=bcol+bj*G_HALF+wc*32+n*16+fq*4;
      const f32x4 v=acc[ai][bj][m][n];
      if constexpr (EPI==EPI_BF16) {
        u32x2 w={cvtpk(v[0],v[1]),cvtpk(v[2],v[3])};
        *(u32x2*)((u16*)ep.out+row*ep.ldc+col)=w;
      } else if constexpr (EPI==EPI_F32) {
        *(f32x4*)((float*)ep.out+row*ep.ldc+col)=v;
      } else {
        const f32x4 r=*(const f32x4*)(ep.resid+row*ep.ldc+col);
        *(f32x4*)((float*)ep.out+row*ep.ldc+col)=r+v;
      }
    }
  }
#undef SA
#undef SB
#undef STAGE_X
#undef STAGE
#undef LDA
#undef LDB
#undef MMA
#undef BAR
#undef SCHED
}
DEVI void g_tile_map(int t, int nM, int nN, int& pm, int& pn) {
  const int nwg = nM * nN;
  int wgid = t;
  { int q = nwg / 8, r = nwg % 8, xcd = wgid % 8, off = wgid / 8;
    wgid = (xcd < r ? xcd * (q + 1) : r * (q + 1) + (xcd - r) * q) + off; }
  const int WGM = 8;
  int nig = WGM * nN, gid = wgid / nig, fm = gid * WGM, gsz = min(nM - fm, WGM);
  pm = fm + ((wgid % nig) % gsz); pn = (wgid % nig) / gsz;
}
template <int EPI>
DEVI void ph_gemm(const u16* A, const u16* Bt, int M, int N, int K, GemmEpi ep, char* smem) {
  const int nM = M / 256, nN = N / 256, ntile = nM * nN;
#pragma unroll 1
  for (int t = blockIdx.x; t < ntile; t += gridDim.x) {
    int pm, pn; g_tile_map(t, nM, nN, pm, pn);
    gemm_tile<EPI>(A, Bt, K, pm * 256, pn * 256, ep, smem);
  }
}

DEVI void ph_norm(const float* __restrict__ x, const float* __restrict__ gain, u16* __restrict__ out, int nrows) {
  const int tid = tid_l(); const int lane = tid & 63, gw = blockIdx.x * 8 + (tid >> 6), nw = gridDim.x * 8;
  f32x4 g[8];
#pragma unroll
  for (int c = 0; c < 8; ++c) g[c] = *(const f32x4*)(gain + c * 256 + lane * 4);
#pragma unroll 1
  for (int r = gw; r < nrows; r += nw) {
    const float* xr = x + (size_t)r * DM;
    f32x4 v[8]; float ss = 0.f;
#pragma unroll
    for (int c = 0; c < 8; ++c) { v[c] = *(const f32x4*)(xr + c * 256 + lane * 4); ss += v[c][0]*v[c][0] + v[c][1]*v[c][1] + v[c][2]*v[c][2] + v[c][3]*v[c][3]; }
    ss = wave_sum(ss);
    const float rstd = rsqrtf(ss * (1.f / DM) + EPS);
#pragma unroll
    for (int c = 0; c < 8; ++c) {
      u32x2 w = {cvtpk(v[c][0] * rstd * g[c][0], v[c][1] * rstd * g[c][1]), cvtpk(v[c][2] * rstd * g[c][2], v[c][3] * rstd * g[c][3])};
      *(u32x2*)(out + (size_t)r * DM + c * 256 + lane * 4) = w;
    }
  }
}


DEVI const float* xin_mb(const Params& p, int mb) { return (mb < 2 ? p.in[0] : p.in[1]) + (size_t)(mb & 1) * MBT * DM; }
DEVI float sigmoidf_(float x) { return 1.f / (1.f + __expf(-x)); }

DEVI void ph_l0_post(const Params& p) {
  u16* P = (u16*)(p.ws + WS_P);
  const float* qg = p.in[4]; const float* kg = p.in[5]; const float* lbl = p.in[7];
  const size_t total = (size_t)MBT * 1024;
#pragma unroll 1
  for (size_t it = (size_t)blockIdx.x * NTHR + tid_l(); it < total; it += (size_t)gridDim.x * NTHR) {
    const int ch = (int)(it & 1023); const size_t tok = it >> 10;
    const int seg = ch >> 7;
    if (seg == 2 || seg == 6) continue;
    u16* ptr = P + tok * 8192 + ch * 8;
    const u32x4 w = *(const u32x4*)ptr;
    float v[8];
#pragma unroll
    for (int j = 0; j < 4; ++j) { v[2*j] = bflo(w[j]); v[2*j+1] = bfhi(w[j]); }
    if (seg <= 1) {
      float ss = 0.f;
#pragma unroll
      for (int j = 0; j < 8; ++j) ss += v[j] * v[j];
      ss += __shfl_xor(ss, 1, 64); ss += __shfl_xor(ss, 2, 64); ss += __shfl_xor(ss, 4, 64); ss += __shfl_xor(ss, 8, 64);
      const float rstd = rsqrtf(ss * (1.f / 128.f) + EPS);
      const float* g = (seg == 0 ? qg : kg) + (ch & 15) * 8;
#pragma unroll
      for (int j = 0; j < 8; ++j) v[j] = v[j] * rstd * g[j];
    } else if (seg == 3 || seg == 7) {
#pragma unroll
      for (int j = 0; j < 8; ++j) v[j] = v[j] * sigmoidf_(v[j]);
    } else {
      const int dir = seg - 4; const int k0 = (ch & 127) * 8;
#pragma unroll
      for (int j = 0; j < 8; ++j) {
        const float l0 = lbl[(dir * 2 + 0) * 1024 + k0 + j], l1 = lbl[(dir * 2 + 1) * 1024 + k0 + j];
        const float lb = 1.f / (1.f + expf(l1 - l0));
        const float f = lb + (1.f - lb) * (1.f / (1.f + expf(-v[j])));
        v[j] = logf(f);
      }
    }
    u32x4 o = {cvtpk(v[0], v[1]), cvtpk(v[2], v[3]), cvtpk(v[4], v[5]), cvtpk(v[6], v[7])};
    *(u32x4*)ptr = o;
  }
}

template <int OFF> DEVI s16x4 tr_read(int vb) {
  s16x4 r; asm volatile("ds_read_b64_tr_b16 %0, %1 offset:%2" : "=&v"(r) : "v"(vb), "i"(OFF) : "memory"); return r;
}
DEVI bf16x8 pk44(s16x4 l, s16x4 h) { return (bf16x8){l[0], l[1], l[2], l[3], h[0], h[1], h[2], h[3]}; }

DEVI void ph_na(const Params& p, int mb, char* smem) {
  const u16* P = (const u16*)(p.ws + WS_P);
  u16* MIX = (u16*)(p.ws + WS_MIX);
  const float* rpb = p.in[6];
  const int S = (mb < 2) ? 2048 : 16384; const int rows = S / 64;
  const int tid = tid_l(), wid = tid >> 6, lane = tid & 63, fr = lane & 15, fq = lane >> 4;
  char* vl = smem + wid * 9216;
  const int vlb = (int)(uintptr_t)vl + (fq * 4 + (fr >> 2)) * 288 + (fr & 3) * 8;
  const int nunits = (MBT / 64) * 4;
#pragma unroll 1
  for (int u = blockIdx.x; u < nunits; u += gridDim.x) {
    const int hp = u & 3, rowg = u >> 2;
    const int j = wid & 3, h = hp * 2 + (wid >> 2);
    const int seqrow0 = (rowg / rows) * rows;
    const int r = rowg - seqrow0;
    const int r0 = min(max(r - 4, 0), rows - 8);
    const int kc0 = min(max(j * 16 - 8, 0), 32);
    const size_t qtok = (size_t)rowg * 64 + j * 16 + fr;
    bf16x8 qf[4];
#pragma unroll
    for (int ks = 0; ks < 4; ++ks) qf[ks] = *(const bf16x8*)(P + qtok * 8192 + h * 128 + ks * 32 + fq * 8);
    f32x4 sacc[16];
#pragma unroll
    for (int i = 0; i < 16; ++i) sacc[i] = (f32x4){0.f, 0.f, 0.f, 0.f};
#pragma unroll
    for (int w = 0; w < 8; ++w)
#pragma unroll
      for (int c2 = 0; c2 < 2; ++c2) {
        const size_t ktok = (size_t)(seqrow0 + r0 + w) * 64 + kc0 + c2 * 16 + fr;
        const u16* kp = P + ktok * 8192 + 1024 + h * 128 + fq * 8;
#pragma unroll
        for (int ks = 0; ks < 4; ++ks) {
          const bf16x8 a = *(const bf16x8*)(kp + ks * 32);
          sacc[w * 2 + c2] = __builtin_amdgcn_mfma_f32_16x16x32_bf16(a, qf[ks], sacc[w * 2 + c2], 0, 0, 0);
        }
      }
    const float scale = 0.08838834764831845f;
    const int qcol = j * 16 + fr; const int qc0 = min(max(qcol - 8, 0), 48);
    float mx = -1e30f;
#pragma unroll
    for (int w = 0; w < 8; ++w) {
      const int dr = r0 + w - r + 7;
      const float* brow = rpb + (h * 15 + dr) * 31;
#pragma unroll
      for (int c2 = 0; c2 < 2; ++c2)
#pragma unroll
        for (int e = 0; e < 4; ++e) {
          const int kcol = kc0 + c2 * 16 + fq * 4 + e;
          const bool valid = (kcol >= qc0) && (kcol < qc0 + 16);
          const int dcol = min(max(kcol - qcol + 15, 0), 30);
          const float sv = valid ? sacc[w * 2 + c2][e] * scale + brow[dcol] : -1e30f;
          sacc[w * 2 + c2][e] = sv; mx = fmaxf(mx, sv);
        }
    }
    mx = fmaxf(mx, __shfl_xor(mx, 16, 64)); mx = fmaxf(mx, __shfl_xor(mx, 32, 64));
    float sum = 0.f;
#pragma unroll
    for (int i = 0; i < 16; ++i)
#pragma unroll
      for (int e = 0; e < 4; ++e) { const float sv = sacc[i][e]; const float pe = (sv > -1e29f) ? __expf(sv - mx) : 0.f; sacc[i][e] = pe; sum += pe; }
    sum += __shfl_xor(sum, 16, 64); sum += __shfl_xor(sum, 32, 64);
    const float inv = 1.f / sum;
    f32x4 oacc[8];
#pragma unroll
    for (int c = 0; c < 8; ++c) oacc[c] = (f32x4){0.f, 0.f, 0.f, 0.f};
#pragma unroll
    for (int w = 0; w < 8; ++w) {
      const size_t vt0 = (size_t)(seqrow0 + r0 + w) * 64 + kc0;
#pragma unroll
      for (int i = 0; i < 8; ++i) {
        const int q = i * 64 + lane, row = q >> 4, ch = q & 15;
        const u32x4 d = *(const u32x4*)(P + (vt0 + row) * 8192 + 2048 + h * 128 + ch * 8);
        *(u32x4*)(vl + row * 288 + ch * 16) = d;
      }
      asm volatile("s_waitcnt lgkmcnt(0)" ::: "memory");
      const f32x4 a0 = sacc[w * 2], a1 = sacc[w * 2 + 1];
      u32x4 pw = {cvtpk(a0[0] * inv, a0[1] * inv), cvtpk(a0[2] * inv, a0[3] * inv), cvtpk(a1[0] * inv, a1[1] * inv), cvtpk(a1[2] * inv, a1[3] * inv)};
      const bf16x8 pa = *reinterpret_cast<bf16x8*>(&pw);
#define NA_PV(c) do { const s16x4 t0 = tr_read<(c) * 32>(vlb), t1 = tr_read<(c) * 32 + 16 * 288>(vlb); \
        asm volatile("s_waitcnt lgkmcnt(0)" ::: "memory"); __builtin_amdgcn_sched_barrier(0); \
        oacc[c] = __builtin_amdgcn_mfma_f32_16x16x32_bf16(pa, pk44(t0, t1), oacc[c], 0, 0, 0); } while (0)
      NA_PV(0); NA_PV(1); NA_PV(2); NA_PV(3); NA_PV(4); NA_PV(5); NA_PV(6); NA_PV(7);
#undef NA_PV
      asm volatile("s_waitcnt lgkmcnt(0)" ::: "memory");
    }
#pragma unroll
    for (int c = 0; c < 8; ++c)
#pragma unroll
      for (int e = 0; e < 4; ++e)
        MIX[((size_t)rowg * 64 + j * 16 + fq * 4 + e) * 2048 + h * 128 + c * 16 + fr] = f2bf(oacc[c][e]);
  }
}

template <bool OUT>
DEVI void ph_hgrn_pass(const Params& p, int mb, char* smem) {
  const u16* P = (const u16*)(p.ws + WS_P);
  float* E = (float*)(p.ws + WS_E); float* DEC = (float*)(p.ws + WS_DEC); float* OFB = (float*)(p.ws + WS_OFB);
  const int tid = tid_l(), cl = tid >> 7, v = tid & 127;
  float* lf = (float*)smem + cl * 4 * 8 * 128; float* lk = lf + 8 * 128; float* lq = lk + 8 * 128; float* lv = lq + 8 * 128;
#pragma unroll 1
  for (int cu = blockIdx.x; cu < 256; cu += gridDim.x) {
    const int chain = cu * 4 + cl; const int seg = chain >> 4, hd = chain & 15, h = hd >> 1, dir = hd & 1;
    float Sreg[128];
    float* Eb = E + (size_t)(seg * 16 + hd) * 16384 + v;
#pragma unroll
    for (int k = 0; k < 128; ++k) Sreg[k] = OUT ? Eb[k * 128] : 0.f;
    float lsum = 0.f;
#pragma unroll 1
    for (int tb = 0; tb < 256; tb += 8) {
      __syncthreads();
#pragma unroll
      for (int i = 0; i < 8; ++i) {
        const int tt = tb + i; const size_t tok = (size_t)seg * 256 + (dir ? 255 - tt : tt);
        const u16* pr = P + tok * 8192 + h * 128 + v;
        const float lg = bf2f(pr[4096 + dir * 1024]);
        lf[i * 128 + v] = __expf(lg); lk[i * 128 + v] = -expm1f(lg); lq[i * 128 + v] = bf2f(pr[3072]);
        lsum += lg; lv[i * 128 + v] = bf2f(pr[6144]);
      }
      __syncthreads();
#pragma unroll 1
      for (int i = 0; i < 8; ++i) {
        float o = 0.f;
        const float vi = lv[i * 128 + v];
        const f32x4* f4 = (const f32x4*)(lf + i * 128); const f32x4* k4 = (const f32x4*)(lk + i * 128); const f32x4* q4 = (const f32x4*)(lq + i * 128);
#pragma unroll
        for (int k = 0; k < 32; ++k) {
          const f32x4 ff = f4[k], kk = k4[k];
#pragma unroll
          for (int e = 0; e < 4; ++e) Sreg[k * 4 + e] = ff[e] * Sreg[k * 4 + e] + kk[e] * vi;
          if (OUT) { const f32x4 qq = q4[k];
#pragma unroll
            for (int e = 0; e < 4; ++e) o += qq[e] * Sreg[k * 4 + e]; }
        }
        if (OUT) { const int tt = tb + i; const size_t tok = (size_t)seg * 256 + (dir ? 255 - tt : tt);
          OFB[((size_t)dir * MBT + tok) * 1024 + h * 128 + v] = o; }
      }
    }
    if (!OUT) {
#pragma unroll
      for (int k = 0; k < 128; ++k) Eb[k * 128] = Sreg[k];
      DEC[(seg * 16 + hd) * 128 + v] = __expf(lsum);
    }
  }
}

DEVI void ph_hgrn_carry(const Params& p, int mb) {
  const int S = (mb < 2) ? 2048 : 16384; const int sps = S / 256;
  float* E = (float*)(p.ws + WS_E); const float* DEC = (const float*)(p.ws + WS_DEC);
#pragma unroll 1
  for (int e = blockIdx.x * NTHR + tid_l(); e < 16 * 16384; e += gridDim.x * NTHR) {
    const int hd = e >> 14, kv = e & 16383, k = kv >> 7, dir = hd & 1;
    float run = 0.f;
#pragma unroll 4
    for (int s = 0; s < 64; ++s) {
      const int seg = dir ? 63 - s : s;
      const bool first = dir ? (((seg + 1) % sps) == 0) : ((seg % sps) == 0);
      if (first) run = 0.f;
      const size_t ix = ((size_t)seg * 16 + hd) * 16384 + kv;
      const float tmp = E[ix]; E[ix] = run; run = DEC[(seg * 16 + hd) * 128 + k] * run + tmp;
    }
  }
}

DEVI void ph_hg_combine(const Params& p) {
  const u16* P = (const u16*)(p.ws + WS_P); const float* OFB = (const float*)(p.ws + WS_OFB);
  u16* MIX = (u16*)(p.ws + WS_MIX); const float* og = p.in[8];
#pragma unroll 1
  for (int it = blockIdx.x * NTHR + tid_l(); it < MBT * 128; it += gridDim.x * NTHR) {
    const int tok = it >> 7, ch = it & 127, col = ch * 8;
    const f32x4* a = (const f32x4*)(OFB + (size_t)tok * 1024 + col);
    const f32x4* b = (const f32x4*)(OFB + ((size_t)MBT + tok) * 1024 + col);
    const f32x4 a0 = a[0], a1 = a[1], b0 = b[0], b1 = b[1];
    float o[8] = {a0[0] + b0[0], a0[1] + b0[1], a0[2] + b0[2], a0[3] + b0[3], a1[0] + b1[0], a1[1] + b1[1], a1[2] + b1[2], a1[3] + b1[3]};
    float ss = 0.f;
#pragma unroll
    for (int j = 0; j < 8; ++j) ss += o[j] * o[j];
    ss += __shfl_xor(ss, 1, 64); ss += __shfl_xor(ss, 2, 64); ss += __shfl_xor(ss, 4, 64); ss += __shfl_xor(ss, 8, 64);
    const float rstd = rsqrtf(ss * (1.f / 128.f) + EPS);
    const u32x4 gw = *(const u32x4*)(P + (size_t)tok * 8192 + 7168 + col);
    float g[8];
#pragma unroll
    for (int j = 0; j < 4; ++j) { g[2*j] = bflo(gw[j]); g[2*j+1] = bfhi(gw[j]); }
    const float* gn = og + (col & 127);
#pragma unroll
    for (int j = 0; j < 8; ++j) o[j] = o[j] * rstd * gn[j] * g[j];
    u32x4 w = {cvtpk(o[0], o[1]), cvtpk(o[2], o[3]), cvtpk(o[4], o[5]), cvtpk(o[6], o[7])};
    *(u32x4*)(MIX + (size_t)tok * 2048 + 1024 + col) = w;
  }
}


DEVI unsigned fkey(float x) { const unsigned u = __float_as_uint(x); return (u & 0x80000000u) ? ~u : (u | 0x80000000u); }
template <int N>
DEVI void select16(const float (&v)[N], const int (&id)[N], float* outv, int* outi, int lane) {
  unsigned key[N];
#pragma unroll
  for (int n = 0; n < N; ++n) key[n] = fkey(v[n]);
  unsigned prefix = 0u;
#pragma unroll 1
  for (int bit = 31; bit >= 0; --bit) {
    const unsigned cand = prefix | (1u << bit);
    int cnt = 0;
#pragma unroll
    for (int n = 0; n < N; ++n) cnt += __popcll(__ballot(key[n] >= cand));
    if (cnt >= 16) prefix = cand;
  }
  int base = 0;
  const unsigned long long below = (1ull << lane) - 1ull;
#pragma unroll
  for (int n = 0; n < N; ++n) {
    const bool sel = key[n] >= prefix;
    const unsigned long long m = __ballot(sel);
    const int pos = base + __popcll(m & below);
    if (sel && pos < 16) { outv[pos] = v[n]; outi[pos] = id[n]; }
    base += __popcll(m);
  }
}

DEVI void ph_topk(const Params& p, int mb, char* smem) {
  const float* SC = (const float*)(p.ws + WS_P);
  int* IDX = (int*)(p.ws + WS_IDX) + (size_t)mb * MBT * 128; float* GATE = (float*)(p.ws + WS_GATE) + (size_t)mb * MBT * 128;
  const int tid = tid_l(), wid = tid >> 6, lane = tid & 63;
  float* wv = (float*)smem + wid * 128; int* wi = (int*)wv;
#pragma unroll 1
  for (int pair = blockIdx.x * 8 + wid; pair < MBT * 8; pair += gridDim.x * 8) {
    const int tok = pair >> 3, h = pair & 7;
    const float* sp = SC + (size_t)tok * 2048 + h * 256;
    { const float a[2] = {sp[lane], sp[lane + 64]}; const int ia[2] = {lane, lane + 64}; select16<2>(a, ia, wv, wi + 16, lane); }
    { const float b[2] = {sp[128 + lane], sp[192 + lane]}; const int ib[2] = {lane, lane + 64}; select16<2>(b, ib, wv + 32, wi + 48, lane); }
    const int i = lane >> 2, j0 = (lane & 3) * 4;
    const float s1 = wv[i]; const int i1 = wi[16 + i];
    float c[4]; int ci[4];
#pragma unroll
    for (int e = 0; e < 4; ++e) { c[e] = s1 + wv[32 + j0 + e]; ci[e] = i1 * 128 + wi[48 + j0 + e]; }
    select16<4>(c, ci, wv + 64, wi + 80, lane);
    float mx = -1e30f;
#pragma unroll
    for (int e = 0; e < 16; ++e) mx = fmaxf(mx, wv[64 + e]);
    float sum = 0.f;
#pragma unroll
    for (int e = 0; e < 16; ++e) sum += __expf(wv[64 + e] - mx);
    if (lane < 16) {
      GATE[(size_t)tok * 128 + h * 16 + lane] = __expf(wv[64 + lane] - mx) / sum;
      IDX[(size_t)tok * 128 + h * 16 + lane] = wi[80 + lane];
    }
  }
}

DEVI float gelu_exact(float a) { return 0.5f * a * (1.f + erff(a * 0.70710678118654752f)); }

DEVI void ph_experts(const Params& p, int layer) {
  const u16* UB = (const u16*)(p.ws + WS_UB); const u16* VB = (const u16*)(p.ws + WS_VB);
  const int* IDX = (const int*)(p.ws + WS_IDX); const float* GATE = (const float*)(p.ws + WS_GATE);
  const float* gain = p.in[19] + layer * DM;
  const int tid = tid_l(), lane = tid & 63, gw = blockIdx.x * 8 + (tid >> 6), nw = gridDim.x * 8;
#pragma unroll 1
  for (int tok = gw; tok < T_ALL; tok += nw) {
    float* xr = p.out + (size_t)tok * DM + lane * 8;
    float hx[32]; float ss = 0.f;
#pragma unroll
    for (int c = 0; c < 4; ++c) {
      const f32x4 a = *(const f32x4*)(xr + c * 512), b = *(const f32x4*)(xr + c * 512 + 4);
#pragma unroll
      for (int j = 0; j < 4; ++j) { hx[c * 8 + j] = a[j]; hx[c * 8 + 4 + j] = b[j]; ss += a[j] * a[j] + b[j] * b[j]; }
    }
    ss = wave_sum(ss);
    const float rstd = rsqrtf(ss * (1.f / DM) + EPS);
#pragma unroll
    for (int c = 0; c < 4; ++c) {
      const f32x4 a = *(const f32x4*)(gain + c * 512 + lane * 8), b = *(const f32x4*)(gain + c * 512 + lane * 8 + 4);
#pragma unroll
      for (int j = 0; j < 4; ++j) { hx[c * 8 + j] *= rstd * a[j]; hx[c * 8 + 4 + j] *= rstd * b[j]; }
    }
    const int i0 = IDX[(size_t)tok * 128 + lane], i1 = IDX[(size_t)tok * 128 + 64 + lane];
    const float g0 = GATE[(size_t)tok * 128 + lane], g1 = GATE[(size_t)tok * 128 + 64 + lane];
    float a_lo = 0.f, a_hi = 0.f;
#define EXP_DOTS(ISRC, ADST) _Pragma("unroll 1") for (int e0 = 0; e0 < 64; e0 += 4) { float part[4]; \
      _Pragma("unroll") for (int q = 0; q < 4; ++q) { const int ie = __builtin_amdgcn_readlane(ISRC, e0 + q); \
        const u16* ur = UB + (size_t)ie * DM + lane * 8; float sacc = 0.f; \
        _Pragma("unroll") for (int c = 0; c < 4; ++c) { const u32x4 w = *(const u32x4*)(ur + c * 512); \
          _Pragma("unroll") for (int j = 0; j < 4; ++j) sacc += bflo(w[j]) * hx[c * 8 + 2 * j] + bfhi(w[j]) * hx[c * 8 + 2 * j + 1]; } \
        part[q] = sacc; } \
      _Pragma("unroll") for (int q = 0; q < 4; ++q) part[q] = wave_sum(part[q]); \
      _Pragma("unroll") for (int q = 0; q < 4; ++q) if (lane == e0 + q) ADST = part[q]; }
    EXP_DOTS(i0, a_lo)
    EXP_DOTS(i1, a_hi)
#undef EXP_DOTS
    const float w0 = g0 * gelu_exact(a_lo), w1 = g1 * gelu_exact(a_hi);
    float acc[32];
#pragma unroll
    for (int k = 0; k < 32; ++k) acc[k] = 0.f;
#define EXP_ACC(ISRC, WSRC) _Pragma("unroll 1") for (int e0 = 0; e0 < 64; e0 += 4) { \
      _Pragma("unroll") for (int q = 0; q < 4; ++q) { const int ie = __builtin_amdgcn_readlane(ISRC, e0 + q); \
        const float we = __uint_as_float(__builtin_amdgcn_readlane(__float_as_uint(WSRC), e0 + q)); \
        const u16* vr = VB + (size_t)ie * DM + lane * 8; \
        _Pragma("unroll") for (int c = 0; c < 4; ++c) { const u32x4 w = *(const u32x4*)(vr + c * 512); \
          _Pragma("unroll") for (int j = 0; j < 4; ++j) { acc[c * 8 + 2 * j] += we * bflo(w[j]); acc[c * 8 + 2 * j + 1] += we * bfhi(w[j]); } } } }
    EXP_ACC(i0, w0)
    EXP_ACC(i1, w1)
#undef EXP_ACC
#pragma unroll
    for (int c = 0; c < 4; ++c) {
      f32x4 a = *(const f32x4*)(xr + c * 512), b = *(const f32x4*)(xr + c * 512 + 4);
#pragma unroll
      for (int j = 0; j < 4; ++j) { a[j] += acc[c * 8 + j]; b[j] += acc[c * 8 + 4 + j]; }
      *(f32x4*)(xr + c * 512) = a; *(f32x4*)(xr + c * 512 + 4) = b;
    }
  }
}

DEVI void ph_l1_post1(const Params& p) {
  const u16* C = (const u16*)(p.ws + WS_E); u16* CQ = (u16*)(p.ws + WS_MIX); u16* CKV = CQ + (size_t)MBT * 768;
  const float* gq = p.in[12]; const float* gkv = p.in[13];
  const int tid = tid_l(), lane = tid & 63, gw = blockIdx.x * 8 + (tid >> 6), nw = gridDim.x * 8;
#pragma unroll 1
  for (int tok = gw; tok < MBT; tok += nw) {
    const u16* cr = C + (size_t)tok * ODD_IN_PAD;
    const u32x4 wa = *(const u32x4*)(cr + lane * 8);
    const u32x4 wb = (lane < 32) ? *(const u32x4*)(cr + 512 + lane * 8) : (u32x4){0u, 0u, 0u, 0u};
    const u32x4 wk = *(const u32x4*)(cr + 768 + lane * 8);
    float a[8], b[8], k[8]; float sq = 0.f, sk = 0.f;
#pragma unroll
    for (int j = 0; j < 4; ++j) { a[2*j] = bflo(wa[j]); a[2*j+1] = bfhi(wa[j]); b[2*j] = bflo(wb[j]); b[2*j+1] = bfhi(wb[j]); k[2*j] = bflo(wk[j]); k[2*j+1] = bfhi(wk[j]); }
#pragma unroll
    for (int j = 0; j < 8; ++j) { sq += a[j] * a[j] + b[j] * b[j]; sk += k[j] * k[j]; }
    sq = wave_sum(sq); sk = wave_sum(sk);
    const float rq = rsqrtf(sq * (1.f / 768.f) + EPS), rk = rsqrtf(sk * (1.f / 512.f) + EPS);
    { const float* g = gq + lane * 8; u32x4 o = {cvtpk(a[0]*rq*g[0], a[1]*rq*g[1]), cvtpk(a[2]*rq*g[2], a[3]*rq*g[3]), cvtpk(a[4]*rq*g[4], a[5]*rq*g[5]), cvtpk(a[6]*rq*g[6], a[7]*rq*g[7])};
      *(u32x4*)(CQ + (size_t)tok * 768 + lane * 8) = o; }
    if (lane < 32) { const float* g = gq + 512 + lane * 8; u32x4 o = {cvtpk(b[0]*rq*g[0], b[1]*rq*g[1]), cvtpk(b[2]*rq*g[2], b[3]*rq*g[3]), cvtpk(b[4]*rq*g[4], b[5]*rq*g[5]), cvtpk(b[6]*rq*g[6], b[7]*rq*g[7])};
      *(u32x4*)(CQ + (size_t)tok * 768 + 512 + lane * 8) = o; }
    { const float* g = gkv + lane * 8; u32x4 o = {cvtpk(k[0]*rk*g[0], k[1]*rk*g[1]), cvtpk(k[2]*rk*g[2], k[3]*rk*g[3]), cvtpk(k[4]*rk*g[4], k[5]*rk*g[5]), cvtpk(k[6]*rk*g[6], k[7]*rk*g[7])};
      *(u32x4*)(CKV + (size_t)tok * 512 + lane * 8) = o; }
  }
}

DEVI void ph_l1_post2(const Params& p, int mb) {
  u16* Q = (u16*)(p.ws + WS_P); const u16* KV = Q + (size_t)MBT * 3072; const u16* C = (const u16*)(p.ws + WS_E); u16* KB = (u16*)(p.ws + WS_OFB);
  const float* rc = (const float*)(p.ws + WS_ROPE); const float* rs = rc + 16384 * 32;
  const int S = (mb < 2) ? 2048 : 16384;
  const size_t total = (size_t)MBT * 16 * 2 * 32;
#pragma unroll 1
  for (size_t it = (size_t)blockIdx.x * NTHR + tid_l(); it < total; it += (size_t)gridDim.x * NTHR) {
    const int sub = (int)(it & 31); const size_t grp = it >> 5;
    const int which = (int)(grp & 1), head = (int)((grp >> 1) & 15); const size_t tok = grp >> 5;
    const int pos = (int)(tok % (size_t)S);
    const u16* np = which ? (KV + tok * 4096 + head * 256 + 4 * sub) : (Q + tok * 3072 + head * 192 + 4 * sub);
    const u16* rp = which ? (C + tok * ODD_IN_PAD + 1280 + sub) : (Q + tok * 3072 + head * 192 + 128 + sub);
    const u32x2 nw = *(const u32x2*)np;
    float n[4] = {bflo(nw[0]), bfhi(nw[0]), bflo(nw[1]), bfhi(nw[1])};
    float x1 = bf2f(rp[0]), x2 = bf2f(rp[32]);
    float ss = n[0]*n[0] + n[1]*n[1] + n[2]*n[2] + n[3]*n[3] + x1*x1 + x2*x2;
    ss += __shfl_xor(ss, 1, 64); ss += __shfl_xor(ss, 2, 64); ss += __shfl_xor(ss, 4, 64); ss += __shfl_xor(ss, 8, 64); ss += __shfl_xor(ss, 16, 64);
    const float rstd = rsqrtf(ss * (1.f / 192.f) + EPS);
    const float* g = which ? p.in[17] : p.in[16];
    const f32x4 gn = *(const f32x4*)(g + 4 * sub);
    const float y1 = x1 * rstd * g[128 + sub], y2 = x2 * rstd * g[160 + sub];
    const float c = rc[pos * 32 + sub], sn = rs[pos * 32 + sub];
    u16* dp = which ? (KB + tok * 3072 + head * 192) : (Q + tok * 3072 + head * 192);
    u32x2 o = {cvtpk(n[0]*rstd*gn[0], n[1]*rstd*gn[1]), cvtpk(n[2]*rstd*gn[2], n[3]*rstd*gn[3])};
    *(u32x2*)(dp + 4 * sub) = o;
    dp[128 + sub] = f2bf(y1 * c - y2 * sn);
    dp[160 + sub] = f2bf(y2 * c + y1 * sn);
  }
}

constexpr int A_NW = 8, A_QBLK = 32, A_KVBLK = 64;
constexpr float A_SCALE = 0.07216878364870322f;
constexpr int A_LDQ = 3072, A_LDK = 3072, A_LDV = 4096, A_LDO = 2048;
constexpr int A_SHM_V = 64 * 128 * 2, A_SHM_K = 64 * 192 * 2;
constexpr float A_THR = 8.f;
#define KSWZ2(row, colB) ((row) * 384 + ((colB) ^ ((((row) >> 1) & 7) << 4)))
#define SBAR() __builtin_amdgcn_sched_barrier(0)
DEVI int crow(int r, int hi) { return (r & 3) + 8 * (r >> 2) + 4 * hi; }
DEVI void a_partialSM(f32x16& p0, f32x16& p1, float& m_reg, float& mn, float& alpha) {
  constexpr float C = A_SCALE * 1.4426950408889634f;
  float pmax = p0[0];
#pragma unroll
  for (int r = 1; r < 16; ++r) pmax = fmaxf(pmax, p0[r]);
#pragma unroll
  for (int r = 0; r < 16; ++r) pmax = fmaxf(pmax, p1[r]);
  { auto rr = __builtin_amdgcn_permlane32_swap(__float_as_uint(pmax), __float_as_uint(pmax), false, false);
    pmax = fmaxf(__uint_as_float(rr[0]), __uint_as_float(rr[1])); }
  if (__builtin_expect(__all(pmax - m_reg <= A_THR / A_SCALE), 1)) { mn = m_reg; alpha = 1.f; }
  else { mn = fmaxf(m_reg, pmax); alpha = __builtin_amdgcn_exp2f((m_reg - mn) * C); m_reg = mn; }
  const float mnC = -mn * C;
#pragma unroll
  for (int r = 0; r < 16; ++r) p0[r] = fmaf(p0[r], C, mnC);
#pragma unroll
  for (int r = 0; r < 16; ++r) p1[r] = fmaf(p1[r], C, mnC);
#pragma unroll
  for (int r = 0; r < 16; ++r) p0[r] = __builtin_amdgcn_exp2f(p0[r]);
}
DEVI void a_finishSM(f32x16& p0, f32x16& p1, float alpha, float& l_reg, bf16x8& pa0, bf16x8& pa1, bf16x8& pa2, bf16x8& pa3) {
#pragma unroll
  for (int r = 0; r < 16; ++r) p1[r] = __builtin_amdgcn_exp2f(p1[r]);
  float ps = 0;
#pragma unroll
  for (int r = 0; r < 16; ++r) ps += p0[r];
#pragma unroll
  for (int r = 0; r < 16; ++r) ps += p1[r];
  { auto rr = __builtin_amdgcn_permlane32_swap(__float_as_uint(ps), __float_as_uint(ps), false, false);
    ps = __uint_as_float(rr[0]) + __uint_as_float(rr[1]); }
  l_reg = l_reg * alpha + ps;
#define PK4(P, BASE, OUT) do { unsigned a0 = cvtpk(P[BASE + 0], P[BASE + 1]), a1 = cvtpk(P[BASE + 2], P[BASE + 3]);   \
    unsigned b0 = cvtpk(P[BASE + 4], P[BASE + 5]), b1 = cvtpk(P[BASE + 6], P[BASE + 7]);                              \
    auto r0 = __builtin_amdgcn_permlane32_swap(a0, b0, false, false); auto r1 = __builtin_amdgcn_permlane32_swap(a1, b1, false, false); \
    u32x4 w = {r0[0], r1[0], r0[1], r1[1]}; OUT = *reinterpret_cast<bf16x8*>(&w); } while (0)
  PK4(p0, 0, pa0); PK4(p0, 8, pa1); PK4(p1, 0, pa2); PK4(p1, 8, pa3);
#undef PK4
}
DEVI void a_qkt(f32x16& p0, f32x16& p1, const char* Ks, const bf16x8* qr, int r32, int hi) {
  p0 = f32x16{}; p1 = f32x16{};
#pragma unroll
  for (int d0 = 0; d0 < 12; ++d0) { const int cb = (d0 * 16 + hi * 8) * 2;
    const bf16x8 b0 = *reinterpret_cast<const bf16x8*>(Ks + KSWZ2(r32, cb));
    const bf16x8 b1 = *reinterpret_cast<const bf16x8*>(Ks + KSWZ2(32 + r32, cb));
    p0 = __builtin_amdgcn_mfma_f32_32x32x16_bf16(b0, qr[d0], p0, 0, 0, 0);
    p1 = __builtin_amdgcn_mfma_f32_32x32x16_bf16(b1, qr[d0], p1, 0, 0, 0); }
}
DEVI int a_v_st(int k, int c) { const int kk = (k & ~0xC) | ((k & 4) << 1) | ((k & 8) >> 1); return ((kk >> 3) * 4 + (c >> 5)) * 512 + ((kk & 7) * 32 + (c & 31)) * 2; }
DEVI int a_v_rd_base(int lane) { return ((lane & 3) << 3) | (((lane >> 2) & 3) << 6) | (((lane >> 4) & 1) << 5) | (((lane >> 5) & 1) << 8); }
constexpr int a_v_rd_off(int d0, int ks, int half) { return d0 * 512 + ks * 4096 + half * 2048; }
template <int D0> DEVI void a_pv_one(f32x16& od, int vb, bf16x8 pa0, bf16x8 pa1, bf16x8 pa2, bf16x8 pa3) {
  const s16x4 l0 = tr_read<a_v_rd_off(D0, 0, 0)>(vb), h0 = tr_read<a_v_rd_off(D0, 0, 1)>(vb), l1 = tr_read<a_v_rd_off(D0, 1, 0)>(vb), h1 = tr_read<a_v_rd_off(D0, 1, 1)>(vb);
  const s16x4 l2 = tr_read<a_v_rd_off(D0, 2, 0)>(vb), h2 = tr_read<a_v_rd_off(D0, 2, 1)>(vb), l3 = tr_read<a_v_rd_off(D0, 3, 0)>(vb), h3 = tr_read<a_v_rd_off(D0, 3, 1)>(vb);
  asm volatile("s_waitcnt lgkmcnt(0)" ::: "memory"); SBAR();
  od = __builtin_amdgcn_mfma_f32_32x32x16_bf16(pa0, pk44(l0, h0), od, 0, 0, 0);
  od = __builtin_amdgcn_mfma_f32_32x32x16_bf16(pa1, pk44(l1, h1), od, 0, 0, 0);
  od = __builtin_amdgcn_mfma_f32_32x32x16_bf16(pa2, pk44(l2, h2), od, 0, 0, 0);
  od = __builtin_amdgcn_mfma_f32_32x32x16_bf16(pa3, pk44(l3, h3), od, 0, 0, 0);
}
DEVI void a_pv_d0(f32x16* o, int vb, bf16x8 pa0, bf16x8 pa1, bf16x8 pa2, bf16x8 pa3) {
  a_pv_one<0>(o[0], vb, pa0, pa1, pa2, pa3); a_pv_one<1>(o[1], vb, pa0, pa1, pa2, pa3); a_pv_one<2>(o[2], vb, pa0, pa1, pa2, pa3); a_pv_one<3>(o[3], vb, pa0, pa1, pa2, pa3);
}
template <int SDEPTH>
DEVI void attn_body(const u16* __restrict__ Qb, const u16* __restrict__ Kh, const u16* __restrict__ Vh, u16* __restrict__ Ob, int seq, char* lds) {
  const int tid = tid_l(), wid = tid >> 6, lane = tid & 63, r32 = lane & 31, hi = lane >> 5;
  char* V_lds = lds; char* K_lds = lds + 2 * A_SHM_V;
  float* ws = (float*)(lds + 2 * A_SHM_V + 2 * A_SHM_K) + wid * 64; float* li_l = ws; float* al_l = ws + 32;
  float m_reg = -1e30f, l_reg = 0; f32x16 o[4] = {}; bf16x8 qr[12];
  const u16* Qw = Qb + (long)(wid * A_QBLK + r32) * A_LDQ + hi * 8;
#pragma unroll
  for (int d0 = 0; d0 < 12; ++d0) qr[d0] = *reinterpret_cast<const bf16x8*>(Qw + d0 * 16);
  const int sr = tid >> 4, sc = (tid & 15) * 8, vst0 = a_v_st(sr, sc), vst1 = a_v_st(32 + sr, sc);
  const int kr = tid >> 3, kc = (tid & 7) * 8;
  const int kst = KSWZ2(kr, kc * 2);
  const unsigned voff = (unsigned)(sr * A_LDV + sc) * 2u, koff = (unsigned)(kr * A_LDK + kc) * 2u;
  const int vb0 = (int)(uintptr_t)V_lds + a_v_rd_base(lane);
  struct { bf16x8 vs0, vs1, ks0, ks1, ks2; } sr_[SDEPTH];
#define SLOAD(i, k0) do { const char* vb_ = (const char*)(Vh + (long)(k0) * A_LDV); const char* kb_ = (const char*)(Kh + (long)(k0) * A_LDK); \
    sr_[i].vs0 = *(const bf16x8*)(vb_ + voff); sr_[i].vs1 = *(const bf16x8*)(vb_ + 32 * A_LDV * 2 + voff); \
    sr_[i].ks0 = *(const bf16x8*)(kb_ + koff); sr_[i].ks1 = *(const bf16x8*)(kb_ + koff + 128); sr_[i].ks2 = *(const bf16x8*)(kb_ + koff + 256); } while (0)
#define SWRITE(b, i) do { *(bf16x8*)(V_lds + (b) * A_SHM_V + vst0) = sr_[i].vs0; *(bf16x8*)(V_lds + (b) * A_SHM_V + vst1) = sr_[i].vs1; \
    *(bf16x8*)(K_lds + (b) * A_SHM_K + kst) = sr_[i].ks0; *(bf16x8*)(K_lds + (b) * A_SHM_K + kst + 128) = sr_[i].ks1; *(bf16x8*)(K_lds + (b) * A_SHM_K + kst + 256) = sr_[i].ks2; } while (0)
#define SWAIT() do { if constexpr (SDEPTH == 2) asm volatile("s_waitcnt vmcnt(5)" ::: "memory"); else asm volatile("s_waitcnt vmcnt(0)" ::: "memory"); } while (0)
#define RESC(a) do { if (__any((a) < 1.f)) { if (hi == 0) al_l[r32] = (a); asm volatile("s_waitcnt lgkmcnt(0)" ::: "memory"); \
    _Pragma("unroll") for (int d = 0; d < 4; ++d) _Pragma("unroll") for (int r = 0; r < 16; ++r) o[d][r] *= al_l[crow(r, hi)]; } } while (0)
  f32x16 pA0, pA1, pB0, pB1; float mnA, mnB, alA, alB; bf16x8 pa0, pa1, pa2, pa3; const int NT = seq / A_KVBLK;
  constexpr int SE = 0, SO = SDEPTH - 1;
  __syncthreads();
  SLOAD(SE, 0); asm volatile("s_waitcnt vmcnt(0)" ::: "memory"); SWRITE(0, SE); __syncthreads();
  a_qkt(pA0, pA1, K_lds, qr, r32, hi); a_partialSM(pA0, pA1, m_reg, mnA, alA);
  SLOAD(SO, A_KVBLK); if constexpr (SDEPTH == 2) { if (2 < NT) SLOAD(SE, 2 * A_KVBLK); }
  SWAIT(); SWRITE(1, SO); __syncthreads();
#pragma unroll 1
  for (int j = 1; j + 1 < NT; j += 2) {
    SBAR(); a_qkt(pB0, pB1, K_lds + A_SHM_K, qr, r32, hi);
    a_finishSM(pA0, pA1, alA, l_reg, pa0, pa1, pa2, pa3); SBAR();
    SLOAD(SO, (j + SDEPTH) * A_KVBLK); SBAR();
    a_pv_d0(o, vb0, pa0, pa1, pa2, pa3); a_partialSM(pB0, pB1, m_reg, mnB, alB);
    __syncthreads(); SWAIT(); SWRITE(0, SE);
    RESC(alB); __syncthreads();
    SBAR(); a_qkt(pA0, pA1, K_lds, qr, r32, hi);
    a_finishSM(pB0, pB1, alB, l_reg, pa0, pa1, pa2, pa3); SBAR();
    if (SDEPTH == 1 || j + 3 < NT) SLOAD(SE, (j + 1 + SDEPTH) * A_KVBLK); SBAR();
    a_pv_d0(o, vb0 + A_SHM_V, pa0, pa1, pa2, pa3); a_partialSM(pA0, pA1, m_reg, mnA, alA);
    __syncthreads(); SWAIT(); SWRITE(1, SO);
    RESC(alA); __syncthreads();
  }
  SBAR(); a_qkt(pB0, pB1, K_lds + A_SHM_K, qr, r32, hi);
  a_finishSM(pA0, pA1, alA, l_reg, pa0, pa1, pa2, pa3); SBAR();
  a_pv_d0(o, vb0, pa0, pa1, pa2, pa3); a_partialSM(pB0, pB1, m_reg, mnB, alB);
  __syncthreads(); RESC(alB);
  a_finishSM(pB0, pB1, alB, l_reg, pa0, pa1, pa2, pa3); SBAR();
  a_pv_d0(o, vb0 + A_SHM_V, pa0, pa1, pa2, pa3);
  if (hi == 0) li_l[r32] = l_reg; asm volatile("s_waitcnt lgkmcnt(0)" ::: "memory");
  float rli[16];
#pragma unroll
  for (int r = 0; r < 16; ++r) rli[r] = __builtin_amdgcn_rcpf(li_l[crow(r, hi)]);
  u16* Ow = Ob + (long)(wid * A_QBLK) * A_LDO;
#pragma unroll
  for (int r = 0; r < 16; ++r) { const int orow = crow(r, hi);
#pragma unroll
    for (int d0 = 0; d0 < 4; ++d0) Ow[(long)orow * A_LDO + d0 * 32 + r32] = f2bf(o[d0][r] * rli[r]); }
#undef SLOAD
#undef SWRITE
#undef SWAIT
#undef RESC
}

DEVI void ph_attn(const Params& p, int mb, char* smem) {
  const u16* Q = (const u16*)(p.ws + WS_P); const u16* KV = Q + (size_t)MBT * 3072; const u16* KB = (const u16*)(p.ws + WS_OFB); u16* O = (u16*)(p.ws + WS_H);
  const int S = (mb < 2) ? 2048 : 16384; const int QB = S / 256;
  const int nunits = (MBT / 256) * 16;
  const bool swz = (gridDim.x == 256);
#pragma unroll 1
  for (int it = 0; it * (int)gridDim.x + (int)blockIdx.x < nunits; ++it) {
    int seq, head, qb;
    if (swz) { const int x = blockIdx.x & 7, slot = blockIdx.x >> 3; const int li = slot + 32 * it; const int gp = x + 8 * (li / QB); qb = li % QB; head = gp & 15; seq = gp >> 4; }
    else { const int u = it * gridDim.x + blockIdx.x; qb = u % QB; head = (u / QB) & 15; seq = u / (QB * 16); }
    const size_t t0 = (size_t)seq * S;
    attn_body<1>(Q + (t0 + (size_t)qb * 256) * 3072 + head * 192, KB + t0 * 3072 + head * 192, KV + t0 * 4096 + head * 256 + 128,
                 O + (t0 + (size_t)qb * 256) * 2048 + head * 128, S, smem);
  }
}

__global__ void __launch_bounds__(NTHR, 2) fwd(Params p) {
  extern __shared__ __attribute__((aligned(16))) char smem[];
  volatile LAS unsigned* ctl = (volatile LAS unsigned*)(smem + 131072);
  if (threadIdx.x < 16) ctl[threadIdx.x] = 0u;
  __syncthreads();
  XcdBarrier bar; bar.bar = (unsigned*)(p.ws + WS_BAR); bar.x = 0; bar.st = ctl;
  const bool multi = (p.step_hi - p.step_lo) > 1;
  if (multi) bar = xcd_barrier_post((unsigned*)(p.ws + WS_BAR), ctl);
  int step = 0;
#define STEP(code) do { if (step >= p.step_lo && step < p.step_hi) { code; if (step + 1 < p.step_hi) xcd_barrier(bar); } ++step; } while (0)

  STEP(ph_prologue(p, smem); ph_convert_uv(p, 0));
#pragma unroll 1
  for (int mb = 0; mb < NMB; ++mb) {
    u16* H = (u16*)(p.ws + WS_H); u16* PP = (u16*)(p.ws + WS_P); u16* MIX = (u16*)(p.ws + WS_MIX);
    float* outmb = p.out + (size_t)mb * MBT * DM;
    STEP(ph_norm(xin_mb(p, mb), p.in[2], H, MBT));
    STEP(ph_gemm<EPI_BF16>(H, (const u16*)(p.ws + WS_WT_EVIN), MBT, 8192, 2048, GemmEpi{PP, nullptr, 8192}, smem));
    STEP(ph_l0_post(p));
    STEP(ph_na(p, mb, smem); __syncthreads(); ph_hgrn_pass<false>(p, mb, smem));
    STEP(ph_hgrn_carry(p, mb));
    STEP(ph_hgrn_pass<true>(p, mb, smem));
    STEP(ph_hg_combine(p));
    STEP(ph_gemm<EPI_RESID>(MIX, (const u16*)(p.ws + WS_WT_EVOUT), MBT, 2048, 2048, GemmEpi{outmb, xin_mb(p, mb), 2048}, smem));
    STEP(ph_norm(outmb, p.in[19], H, MBT));
    STEP(ph_gemm<EPI_F32>(H, (const u16*)(p.ws + WS_WEFF), MBT, 2048, 2048, GemmEpi{PP, nullptr, 2048}, smem));
    STEP(ph_topk(p, mb, smem));
  }
  STEP(ph_experts(p, 0));
  STEP(ph_convert_uv(p, 1));
#pragma unroll 1
  for (int mb = 0; mb < NMB; ++mb) {
    u16* H = (u16*)(p.ws + WS_H); u16* PP = (u16*)(p.ws + WS_P); u16* CQ = (u16*)(p.ws + WS_MIX);
    float* outmb = p.out + (size_t)mb * MBT * DM;
    STEP(ph_norm(outmb, p.in[10], H, MBT));
    STEP(ph_gemm<EPI_BF16>(H, (const u16*)(p.ws + WS_WT_ODIN), MBT, ODD_IN_PAD, 2048, GemmEpi{p.ws + WS_E, nullptr, ODD_IN_PAD}, smem));
    STEP(ph_l1_post1(p));
    STEP(ph_gemm<EPI_BF16>(CQ, (const u16*)(p.ws + WS_WT_UQ), MBT, 3072, 768, GemmEpi{PP, nullptr, 3072}, smem);
         ph_gemm<EPI_BF16>(CQ + (size_t)MBT * 768, (const u16*)(p.ws + WS_WT_UKV), MBT, 4096, 512, GemmEpi{PP + (size_t)MBT * 3072, nullptr, 4096}, smem));
    STEP(ph_l1_post2(p, mb));
    STEP(ph_attn(p, mb, smem));
    STEP(ph_gemm<EPI_RESID>(H, (const u16*)(p.ws + WS_WT_ODOUT), MBT, 2048, 2048, GemmEpi{outmb, outmb, 2048}, smem));
    STEP(ph_norm(outmb, p.in[19] + DM, H, MBT));
    STEP(ph_gemm<EPI_F32>(H, (const u16*)(p.ws + WS_WEFF) + (size_t)2048 * 2048, MBT, 2048, 2048, GemmEpi{PP, nullptr, 2048}, smem));
    STEP(ph_topk(p, mb, smem));
  }
  STEP(ph_experts(p, 1));
}

constexpr int N_STEPS = 1 + 4 * 11 + 2 + 4 * 10 + 1;

#ifndef MK_MULTI
#define MK_MULTI 0
#endif

extern "C" void kernel_launch(void* const* d_in, const int* in_sizes, int n_in, void* d_out, int out_size, void* d_ws, size_t ws_size, hipStream_t stream) {
  static int grid = 0;
  if (grid == 0) {
    if (n_in != 24 || out_size != T_ALL * DM || ws_size < WS_END) { fprintf(stderr, "kernel_launch: shape/ws mismatch n_in %d out %d ws %zu need %zu\n", n_in, out_size, ws_size, (size_t)WS_END); grid = -1; return; }
    int dev = 0, cus = 0, per_cu = 0;
    if (hipGetDevice(&dev) != hipSuccess || hipDeviceGetAttribute(&cus, hipDeviceAttributeMultiprocessorCount, dev) != hipSuccess) { grid = -1; return; }
    if (hipFuncSetAttribute((const void*)fwd, hipFuncAttributeMaxDynamicSharedMemorySize, LDS_BYTES) != hipSuccess) { fprintf(stderr, "kernel_launch: hipFuncSetAttribute failed\n"); grid = -1; return; }
    if (hipOccupancyMaxActiveBlocksPerMultiprocessor(&per_cu, (const void*)fwd, NTHR, LDS_BYTES) != hipSuccess || per_cu < 1) { fprintf(stderr, "kernel_launch: occupancy query says %d\n", per_cu); (void)hipGetLastError(); grid = -1; return; }
    grid = cus;
  }
  if (grid < 0) return;
  (void)hipMemsetAsync((char*)d_ws + WS_BAR, 0, XCD_BAR_WORDS * 4, stream);
  Params p{};
  for (int i = 0; i < 24; ++i) p.in[i] = (const float*)d_in[i];
  p.out = (float*)d_out; p.ws = (unsigned char*)d_ws;
#if MK_MULTI
  for (int s = 0; s < N_STEPS; ++s) { p.step_lo = s; p.step_hi = s + 1; hipLaunchKernelGGL(fwd, dim3(grid), dim3(NTHR), LDS_BYTES, stream, p); }
#else
  p.step_lo = 0; p.step_hi = N_STEPS;
  hipLaunchKernelGGL(fwd, dim3(grid), dim3(NTHR), LDS_BYTES, stream, p);
#endif
  const hipError_t le = hipPeekAtLastError();
  if (le != hipSuccess) fprintf(stderr, "kernel_launch: launch failed: %s\n", hipGetErrorName(le));
}

#ifdef PHASE_TEST
#define PT(name, body) __global__ void __launch_bounds__(NTHR, 2) name(Params p, int mb) { extern __shared__ __attribute__((aligned(16))) char smem[]; body; }
PT(t_prologue, ph_prologue(p, smem))
PT(t_convert, ph_convert_uv(p, mb))
PT(t_norm, ph_norm(xin_mb(p, mb), p.in[2], (u16*)(p.ws + WS_H), MBT))
PT(t_gemm_bf16, ph_gemm<EPI_BF16>((u16*)(p.ws + WS_H), (const u16*)(p.ws + WS_WT_EVIN), MBT, 8192, 2048, GemmEpi{p.ws + WS_P, nullptr, 8192}, smem))
PT(t_gemm_resid, ph_gemm<EPI_RESID>((u16*)(p.ws + WS_H), (const u16*)(p.ws + WS_WT_EVIN), MBT, 2048, 2048, GemmEpi{p.out, p.in[0], 2048}, smem))
PT(t_l0post, ph_l0_post(p))
PT(t_na, ph_na(p, mb, smem))
PT(t_hg1, ph_hgrn_pass<false>(p, mb, smem))
PT(t_hg3, ph_hgrn_pass<true>(p, mb, smem))
PT(t_carry, ph_hgrn_carry(p, mb))
PT(t_comb, ph_hg_combine(p))
PT(t_topk, ph_topk(p, mb, smem))
PT(t_experts, ph_experts(p, mb))
PT(t_post1, ph_l1_post1(p))
PT(t_post2, ph_l1_post2(p, mb))
PT(t_attn, ph_attn(p, mb, smem))
PT(t_gemm_f32, ph_gemm<EPI_F32>((u16*)(p.ws + WS_H), (const u16*)(p.ws + WS_WT_EVIN), MBT, 2048, 2048, GemmEpi{p.ws + WS_P, nullptr, 2048}, smem))
#endif
```

```cpp
#include <hip/hip_runtime.h>
#include <stdint.h>
#include <stdio.h>

#define DEVI __device__ __forceinline__
typedef unsigned short u16;
typedef unsigned int u32;
using bf16x8 = __attribute__((ext_vector_type(8))) short;
using s16x4  = __attribute__((ext_vector_type(4))) short;
using f32x4  = __attribute__((ext_vector_type(4))) float;
using f32x16 = __attribute__((ext_vector_type(16))) float;
using u32x4  = __attribute__((ext_vector_type(4))) unsigned;
using u32x2  = __attribute__((ext_vector_type(2))) unsigned;

constexpr int DM = 2048;
constexpr int T_ALL = 65536;
constexpr int MBT = 16384;
constexpr int NMB = 4;
constexpr int NTHR = 512;
constexpr int EVEN_IN = 8192;
constexpr int ODD_IN = 1344, ODD_IN_PAD = 1536;
constexpr float EPS = 1e-6f;

constexpr size_t A256(size_t x) { return (x + 255) / 256 * 256; }
constexpr size_t WS_BAR      = 0;
constexpr size_t WS_WT_EVIN  = 16384;
constexpr size_t WS_WT_EVOUT = WS_WT_EVIN  + (size_t)8192 * 2048 * 2;
constexpr size_t WS_WT_ODIN  = WS_WT_EVOUT + (size_t)2048 * 2048 * 2;
constexpr size_t WS_WT_UQ    = WS_WT_ODIN  + (size_t)1536 * 2048 * 2;
constexpr size_t WS_WT_UKV   = WS_WT_UQ    + (size_t)3072 * 768 * 2;
constexpr size_t WS_WT_ODOUT = WS_WT_UKV   + (size_t)4096 * 512 * 2;
constexpr size_t WS_WEFF     = WS_WT_ODOUT + (size_t)2048 * 2048 * 2;
constexpr size_t WS_ROPE     = WS_WEFF     + (size_t)2 * 2048 * 2048 * 2;
constexpr size_t WS_UB       = WS_ROPE     + (size_t)16384 * 64 * 4;
constexpr size_t WS_VB       = WS_UB       + (size_t)2 * 16384 * 2048;
constexpr size_t WS_IDX      = WS_VB       + (size_t)2 * 16384 * 2048;
constexpr size_t WS_GATE     = WS_IDX      + (size_t)T_ALL * 128 * 4;
constexpr size_t WS_H        = WS_GATE     + (size_t)T_ALL * 128 * 4;
constexpr size_t WS_P        = WS_H        + (size_t)MBT * 2048 * 2;
constexpr size_t WS_MIX      = WS_P        + (size_t)MBT * 8192 * 2;
constexpr size_t WS_E        = WS_MIX      + (size_t)MBT * 2048 * 2;
constexpr size_t WS_DEC      = WS_E        + (size_t)64 * 16 * 16384 * 4;
constexpr size_t WS_OFB      = WS_DEC      + (size_t)64 * 16 * 128 * 4;
constexpr size_t WS_END      = WS_OFB      + (size_t)2 * MBT * 1024 * 4;

constexpr int LDS_BYTES = 131072 + 2048;

struct Params {
  const float* in[24];
  float* out;
  unsigned char* ws;
  int step_lo, step_hi;
};

#define XB_TMO      128
#define XB_XCNT(j)  (256  + 64 * (j))
#define XB_XSUB(j)  (1280 + 64 * (j))
#define XB_XGEN(j)  (2304 + 64 * (j))
#define XB_TOP      3328
#define XB_TOPGEN   3392
#define XCD_BAR_WORDS 3456
#define XB_SPIN_CAP (1u << 18)
#define LAS __attribute__((address_space(3)))

__device__ __forceinline__ unsigned xb_ld(unsigned* p)              { return __hip_atomic_load(p, __ATOMIC_RELAXED, __HIP_MEMORY_SCOPE_AGENT); }
__device__ __forceinline__ unsigned xb_add(unsigned* p, unsigned v) { return __hip_atomic_fetch_add(p, v, __ATOMIC_RELAXED, __HIP_MEMORY_SCOPE_AGENT); }
__device__ __forceinline__ unsigned xb_xcc_id() { return (unsigned)__builtin_amdgcn_s_getreg((3 << 11) | 20) & 0xFu; }
#define XB_SPIN(cond, bar) do { unsigned _sp = 0; while (cond) { __builtin_amdgcn_s_sleep(1); \
    if ((++_sp & 255u) == 0u) { if (xb_ld(&(bar)[XB_TMO])) break; if (_sp > XB_SPIN_CAP) { atomicAdd(&(bar)[XB_TMO], 1u); break; } } } } while (0)

struct XcdBarrier {
    unsigned* bar; unsigned x;
    volatile LAS unsigned* st;
};
__device__ __forceinline__ XcdBarrier xcd_barrier_post(unsigned* bar, volatile LAS unsigned* st) {
    XcdBarrier b; b.bar = bar; b.x = xb_xcc_id(); b.st = st;
    if (threadIdx.x == 0) (void)xb_add(&bar[XB_XCNT(b.x)], 1u);
    return b;
}
__device__ __forceinline__ void xcd_barrier_complete(unsigned* bar, unsigned x, unsigned& nloc, unsigned& nx) {
    const unsigned G = gridDim.x * gridDim.y * gridDim.z;
    unsigned sum, cnt, mine, sp = 0u;
    for (;;) {
        sum = 0u; cnt = 0u; mine = 0u;
#pragma unroll
        for (unsigned j = 0; j < 16; ++j) { const unsigned c = xb_ld(&bar[XB_XCNT(j)]); sum += c; cnt += (c > 0u) ? 1u : 0u; mine = (j == x) ? c : mine; }
        if (sum == G) break;
        __builtin_amdgcn_s_sleep(1);
        if ((++sp & 255u) == 0u) { if (xb_ld(&bar[XB_TMO])) break; if (sp > XB_SPIN_CAP) { atomicAdd(&bar[XB_TMO], 1u); break; } }
    }
    nloc = mine > 0u ? mine : 1u; nx = cnt > 0u ? cnt : 1u;
}
__device__ __forceinline__ void xcd_barrier(const XcdBarrier& b) {
    asm volatile("s_waitcnt vmcnt(0)" ::: "memory");
    __syncthreads();
    if (threadIdx.x == 0) {
        unsigned* bar = b.bar;
        __builtin_amdgcn_s_waitcnt(0);
        unsigned nloc = b.st[0], nx = b.st[1];
        if (nloc == 0u) { xcd_barrier_complete(bar, b.x, nloc, nx); b.st[0] = nloc; b.st[1] = nx; }
        const unsigned old = xb_add(&bar[XB_XSUB(b.x)], 1u);
        const unsigned gen = old / nloc;
        if (old + 1u == (gen + 1u) * nloc) {
            __builtin_amdgcn_fence(__ATOMIC_RELEASE, "agent");
            asm volatile("s_waitcnt vmcnt(0)" ::: "memory");
            const unsigned og = xb_add(&bar[XB_TOP], 1u);
            const unsigned tg = og / nx;
            if (og + 1u == (tg + 1u) * nx) xb_add(&bar[XB_TOPGEN], 1u);
            else XB_SPIN(xb_ld(&bar[XB_TOPGEN]) == tg, bar);
            __builtin_amdgcn_fence(__ATOMIC_ACQUIRE, "agent");
            xb_add(&bar[XB_XGEN(b.x)], 1u);
            asm volatile("s_waitcnt vmcnt(0)" ::: "memory");
        } else {
            XB_SPIN(xb_ld(&bar[XB_XGEN(b.x)]) == gen, bar);
            __builtin_amdgcn_fence(__ATOMIC_ACQUIRE, "agent");
            asm volatile("s_waitcnt vmcnt(0)" ::: "memory");
        }
    }
    __syncthreads();
}

DEVI unsigned cvtpk(float lo, float hi) {
  unsigned r; asm volatile("v_cvt_pk_bf16_f32 %0, %1, %2" : "=v"(r) : "v"(lo), "v"(hi)); return r;
}
DEVI u16 f2bf(float x) { return (u16)(cvtpk(x, 0.f) & 0xffffu); }
DEVI float bf2f(u16 x) { return __uint_as_float(((unsigned)x) << 16); }
DEVI float bflo(unsigned w) { return __uint_as_float(w << 16); }
DEVI float bfhi(unsigned w) { return __uint_as_float(w & 0xffff0000u); }
DEVI int tid_l() { int t = threadIdx.x; asm volatile("" : "+v"(t)); return t; }
DEVI float wave_sum(float v) {
#pragma unroll
  for (int o = 32; o > 0; o >>= 1) v += __shfl_xor(v, o, 64);
  return v;
}

DEVI void transpose_tile(const float* __restrict__ src, int K, int N, u16* __restrict__ dst, int tile, float* lds) {
  const int ntk = K / 64;
  const int tk = tile % ntk, tn = tile / ntk;
  const int k0 = tk * 64, n0 = tn * 64;
  const int tid = tid_l();
  __syncthreads();
#pragma unroll
  for (int i = 0; i < 8; ++i) {
    int e = tid + i * NTHR; int kk = e >> 6, nn = e & 63;
    float v = (n0 + nn < N) ? src[(size_t)(k0 + kk) * N + n0 + nn] : 0.f;
    lds[kk * 65 + nn] = v;
  }
  __syncthreads();
#pragma unroll
  for (int i = 0; i < 8; ++i) {
    int e = tid + i * NTHR; int nn = e >> 6, kk = e & 63;
    dst[(size_t)(n0 + nn) * K + k0 + kk] = f2bf(lds[kk * 65 + nn]);
  }
}

DEVI void ph_prologue(const Params& p, char* smem) {
  float* lds = (float*)smem;
  const int G = gridDim.x, b = blockIdx.x, tid = tid_l();
#define TJOB(srcp, K_, N_, NP_, OFF_) do { const int nt_ = ((K_) / 64) * ((NP_) / 64); \
    _Pragma("unroll 1") for (int t = b; t < nt_; t += G) transpose_tile(srcp, K_, N_, (u16*)(p.ws + (OFF_)), t, lds); } while (0)
  TJOB(p.in[3],  2048, 8192, 8192, WS_WT_EVIN);
  TJOB(p.in[9],  2048, 2048, 2048, WS_WT_EVOUT);
  TJOB(p.in[11], 2048, ODD_IN, ODD_IN_PAD, WS_WT_ODIN);
  TJOB(p.in[14], 768,  3072, 3072, WS_WT_UQ);
  TJOB(p.in[15], 512,  4096, 4096, WS_WT_UKV);
  TJOB(p.in[18], 2048, 2048, 2048, WS_WT_ODOUT);
#undef TJOB
  __syncthreads();
  {
    float* sk = lds;
    float* wq = lds + 128 * 129;
#pragma unroll 1
    for (int job = b; job < 2 * 16 * 32; job += G) {
      const int l = job / 512, hp = (job / 32) % 16, kt = job % 32, k0 = kt * 64;
      const float* SK = p.in[21] + ((size_t)(l * 16 + hp) * 128) * 128;
      const float* WQ = p.in[20] + (size_t)l * 2048 * 2048;
      __syncthreads();
      for (int e = tid; e < 128 * 128; e += NTHR) sk[(e >> 7) * 129 + (e & 127)] = SK[e];
      for (int e = tid; e < 64 * 128; e += NTHR) { int kk = e >> 7, d = e & 127; wq[kk * 129 + d] = WQ[(size_t)(k0 + kk) * 2048 + hp * 128 + d]; }
      __syncthreads();
      const int kk = tid & 63, ng = tid >> 6;
      float acc[16];
#pragma unroll
      for (int i = 0; i < 16; ++i) acc[i] = 0.f;
#pragma unroll 4
      for (int d = 0; d < 128; ++d) {
        const float w = wq[kk * 129 + d];
#pragma unroll
        for (int i = 0; i < 16; ++i) acc[i] += sk[(ng * 16 + i) * 129 + d] * w;
      }
      u16* dst = (u16*)(p.ws + WS_WEFF) + (size_t)l * 2048 * 2048;
#pragma unroll
      for (int i = 0; i < 16; ++i) dst[(size_t)(hp * 128 + ng * 16 + i) * 2048 + k0 + kk] = f2bf(acc[i]);
    }
  }
  {
    float* rc = (float*)(p.ws + WS_ROPE);
    for (int e = b * NTHR + tid; e < 16384 * 32; e += G * NTHR) {
      const int pos = e >> 5, i = e & 31;
      const float inv = 1.0f / powf(10000.f, (float)(2 * i) / 64.f);
      const float ang = (float)pos * inv;
      float s, c; sincosf(ang, &s, &c);
      rc[e] = c; rc[16384 * 32 + e] = s;
    }
  }
}

constexpr float U_SCALE = 64.f, V_SCALE = 16.f;
DEVI void ph_convert_uv(const Params& p) {
  const size_t n16 = (size_t)2 * 16384 * 2048 / 16;
  u32x4* ub = (u32x4*)(p.ws + WS_UB); u32x4* vb = (u32x4*)(p.ws + WS_VB);
#pragma unroll 1
  for (size_t i = (size_t)blockIdx.x * NTHR + tid_l(); i < 2 * n16; i += (size_t)gridDim.x * NTHR) {
    const bool isu = i < n16; const size_t j = isu ? i : i - n16;
    const f32x4* s4 = (const f32x4*)((isu ? p.in[22] : p.in[23]) + j * 16);
    const float sc = isu ? U_SCALE : V_SCALE;
    u32x4 w;
#pragma unroll
    for (int k = 0; k < 4; ++k) {
      const f32x4 a = s4[k];
      int d = __builtin_amdgcn_cvt_pk_fp8_f32(a[0] * sc, a[1] * sc, 0, false);
      d = __builtin_amdgcn_cvt_pk_fp8_f32(a[2] * sc, a[3] * sc, d, true);
      w[k] = (unsigned)d;
    }
    (isu ? ub : vb)[j] = w;
  }
}

DEVI void ph_copy_x(const Params& p) {
  const size_t n4 = (size_t)T_ALL * DM / 4, h4 = n4 / 2;
  const f32x4* a = (const f32x4*)p.in[0]; const f32x4* c = (const f32x4*)p.in[1];
  f32x4* o = (f32x4*)p.out;
  for (size_t i = (size_t)blockIdx.x * NTHR + threadIdx.x; i < n4; i += (size_t)gridDim.x * NTHR)
    o[i] = (i < h4) ? a[i] : c[i - h4];
}


constexpr int G_BK = 64, G_HALF = 128, G_HT = G_HALF * G_BK;
DEVI int g_lds_byte(int r, int c) {
  int st = (r >> 4) * 2 + (c >> 5), rr = r & 15, cc = c & 31, ob = rr * 64 + cc * 2;
  return st * 1024 + (ob ^ (((ob >> 9) & 1) << 5));
}
DEVI void g_stage_rc(int b, int& R, int& C) {
  int st = b / 1024, sb = b % 1024, swz = sb ^ (((sb >> 9) & 1) << 5);
  R = (st >> 1) * 16 + swz / 64; C = (st & 1) * 32 + (swz % 64) / 2;
}
enum { EPI_BF16 = 0, EPI_F32 = 1, EPI_RESID = 2 };
struct GemmEpi { void* out; const float* resid; int ldc; };

template <int EPI>
DEVI void gemm_tile(const u16* __restrict__ A, const u16* __restrict__ Bt, const int K, const int brow, const int bcol, const GemmEpi ep, char* smem) {
  u16* shm = (u16*)smem;
#define SA(b,h) (shm+((b)*2+(h))*G_HT)
#define SB(b,h) (shm+(4+(b)*2+(h))*G_HT)
#define STAGE_X(T,P,BASE,br,kt) do{long _g=(long)(br)*K+(long)(kt)*G_BK; \
    for(int _i=0;_i<2;++_i){int _b=(T)*16+_i*8192;int _r,_c;g_stage_rc(_b,_r,_c); \
      __builtin_amdgcn_global_load_lds((const unsigned*)(BASE+_g+(long)_r*K+_c), \
        (LAS unsigned*)((char*)(P)+_b),16,0,0);}}while(0)
#define STAGE(P,BASE,br,kt) STAGE_X(tid0,P,BASE,br,kt)
#define LDA(dst,b,h) for(int m=0;m<4;++m)for(int k=0;k<2;++k) \
    dst[m][k]=*reinterpret_cast<const bf16x8*>((char*)SA(b,h)+g_lds_byte(wr*64+m*16+fr,k*32+fq*8))
#define LDB(dst,b,h) for(int n=0;n<2;++n)for(int k=0;k<2;++k) \
    dst[n][k]=*reinterpret_cast<const bf16x8*>((char*)SB(b,h)+g_lds_byte(wc*32+n*16+fr,k*32+fq*8))
#define MMA(ai,bj,At_,Bt_) do{__builtin_amdgcn_s_setprio(1); \
    for(int m=0;m<4;++m)for(int n=0;n<2;++n)for(int k=0;k<2;++k) \
      acc[ai][bj][m][n]=__builtin_amdgcn_mfma_f32_16x16x32_bf16(Bt_[n][k],At_[m][k],acc[ai][bj][m][n],0,0,0); \
    __builtin_amdgcn_s_setprio(0);}while(0)
#define WAIT_V(n) asm volatile("s_waitcnt vmcnt(" #n ")":::"memory")
#define WAIT_L(n) asm volatile("s_waitcnt lgkmcnt(" #n ")":::"memory")
#define BAR __builtin_amdgcn_s_barrier()
#define SCHED __builtin_amdgcn_sched_barrier(0)
  const int tid0=tid_l();
  int wid=tid0>>6,lane=tid0&63,wr=wid>>2,wc=wid&3,fr=lane&15,fq=lane>>4;
  f32x4 acc[2][2][4][2]={};
  bf16x8 At[4][2],B0[2][2],B1[2][2];
  const int nt=K/G_BK;
  STAGE(SB(0,0),Bt,bcol,0); STAGE(SA(0,0),A,brow,0);
  STAGE(SB(0,1),Bt,bcol+G_HALF,0); STAGE(SA(0,1),A,brow+G_HALF,0);
  if(wr==1)BAR;
  WAIT_V(4); BAR;
  STAGE(SB(1,0),Bt,bcol,1); STAGE(SA(1,0),A,brow,1); STAGE(SB(1,1),Bt,bcol+G_HALF,1);
  WAIT_V(6); BAR;
#pragma unroll 1
  for(int t=0;t<nt-2;t+=2){
    LDB(B0,0,0); SCHED; LDA(At,0,0); STAGE(SA(1,1),A,brow+G_HALF,t+1);
    WAIT_L(8); BAR; WAIT_L(0); MMA(0,0,At,B0); BAR; SCHED;
    LDB(B1,0,1); STAGE(SB(0,0),Bt,bcol,t+2);
    BAR; WAIT_L(0); MMA(0,1,At,B1); BAR;
    LDA(At,0,1); STAGE(SA(0,0),A,brow,t+2);
    BAR; WAIT_L(0); MMA(1,0,At,B0); BAR; SCHED;
    STAGE(SB(0,1),Bt,bcol+G_HALF,t+2);
    WAIT_V(6); BAR; MMA(1,1,At,B1); BAR;
    LDB(B0,1,0); SCHED; LDA(At,1,0); STAGE(SA(0,1),A,brow+G_HALF,t+2);
    WAIT_L(8); BAR; WAIT_L(0); MMA(0,0,At,B0); BAR; SCHED;
    LDB(B1,1,1); STAGE(SB(1,0),Bt,bcol,t+3);
    BAR; WAIT_L(0); MMA(0,1,At,B1); BAR;
    LDA(At,1,1); STAGE(SA(1,0),A,brow,t+3);
    BAR; WAIT_L(0); MMA(1,0,At,B0); BAR; SCHED;
    STAGE(SB(1,1),Bt,bcol+G_HALF,t+3);
    WAIT_V(6); BAR; MMA(1,1,At,B1); BAR;
  }
  int tz=tid_l(); wid=tz>>6; lane=tz&63; wr=wid>>2; wc=wid&3; fr=lane&15; fq=lane>>4;
  { LDB(B0,0,0); WAIT_V(0); LDA(At,0,0); STAGE_X(tz,SA(1,1),A,brow+G_HALF,nt-1);
    BAR; WAIT_L(0); MMA(0,0,At,B0); BAR;
    LDB(B1,0,1); BAR; WAIT_L(0); MMA(0,1,At,B1); BAR;
    LDA(At,0,1); WAIT_V(4); BAR; WAIT_L(0); MMA(1,0,At,B0); MMA(1,1,At,B1); BAR; }
  { LDB(B0,1,0); LDA(At,1,0); WAIT_V(2); BAR; WAIT_L(0); MMA(0,0,At,B0); BAR;
    LDB(B1,1,1); WAIT_V(0); BAR; WAIT_L(0); MMA(0,1,At,B1); BAR;
    LDA(At,1,1); BAR; WAIT_L(0); MMA(1,0,At,B0); MMA(1,1,At,B1); BAR; }
  if(wr==0)BAR;
#pragma unroll
  for(int ai=0;ai<2;++ai)
#pragma unroll
  for(int m=0;m<4;++m){
    const long row=brow+ai*G_HALF+wr*64+m*16+fr;
#pragma unroll
    for(int bj=0;bj<2;++bj)
#pragma unroll
    for(int n=0;n<2;++n){
      const int col=bcol+bj*G_HALF+wc*32+n*16+fq*4;
      const f32x4 v=acc[ai][bj][m][n];
      if constexpr (EPI==EPI_BF16) {
        u32x2 w={cvtpk(v[0],v[1]),cvtpk(v[2],v[3])};
        *(u32x2*)((u16*)ep.out+row*ep.ldc+col)=w;
      } else if constexpr (EPI==EPI_F32) {
        *(f32x4*)((float*)ep.out+row*ep.ldc+col)=v;
      } else {
        const f32x4 r=*(const f32x4*)(ep.resid+row*ep.ldc+col);
        *(f32x4*)((float*)ep.out+row*ep.ldc+col)=r+v;
      }
    }
  }
#undef SA
#undef SB
#undef STAGE_X
#undef STAGE
#undef LDA
#undef LDB
#undef MMA
#undef BAR
#undef SCHED
}
DEVI void g_tile_map(int t, int nM, int nN, int& pm, int& pn) {
  const int nwg = nM * nN;
  int wgid = t;
  { int q = nwg / 8, r = nwg % 8, xcd = wgid % 8, off = wgid / 8;
    wgid = (xcd < r ? xcd * (q + 1) : r * (q + 1) + (xcd - r) * q) + off; }
  const int WGM = 8;
  int nig = WGM * nN, gid = wgid / nig, fm = gid * WGM, gsz = min(nM - fm, WGM);
  pm = fm + ((wgid % nig) % gsz); pn = (wgid % nig) / gsz;
}
template <int EPI>
DEVI void ph_gemm(const u16* A, const u16* Bt, int M, int N, int K, GemmEpi ep, char* smem) {
  const int nM = M / 256, nN = N / 256, ntile = nM * nN;
#pragma unroll 1
  for (int t = blockIdx.x; t < ntile; t += gridDim.x) {
    int pm, pn; g_tile_map(t, nM, nN, pm, pn);
    gemm_tile<EPI>(A, Bt, K, pm * 256, pn * 256, ep, smem);
  }
}

DEVI void ph_norm(const float* __restrict__ x, const float* __restrict__ gain, u16* __restrict__ out, int nrows) {
  const int tid = tid_l(); const int lane = tid & 63, gw = blockIdx.x * 8 + (tid >> 6), nw = gridDim.x * 8;
  f32x4 g[8];
#pragma unroll
  for (int c = 0; c < 8; ++c) g[c] = *(const f32x4*)(gain + c * 256 + lane * 4);
#pragma unroll 1
  for (int r = gw; r < nrows; r += nw) {
    const float* xr = x + (size_t)r * DM;
    f32x4 v[8]; float ss = 0.f;
#pragma unroll
    for (int c = 0; c < 8; ++c) { v[c] = *(const f32x4*)(xr + c * 256 + lane * 4); ss += v[c][0]*v[c][0] + v[c][1]*v[c][1] + v[c][2]*v[c][2] + v[c][3]*v[c][3]; }
    ss = wave_sum(ss);
    const float rstd = rsqrtf(ss * (1.f / DM) + EPS);
#pragma unroll
    for (int c = 0; c < 8; ++c) {
      u32x2 w = {cvtpk(v[c][0] * rstd * g[c][0], v[c][1] * rstd * g[c][1]), cvtpk(v[c][2] * rstd * g[c][2], v[c][3] * rstd * g[c][3])};
      *(u32x2*)(out + (size_t)r * DM + c * 256 + lane * 4) = w;
    }
  }
}


DEVI const float* xin_mb(const Params& p, int mb) { return (mb < 2 ? p.in[0] : p.in[1]) + (size_t)(mb & 1) * MBT * DM; }
DEVI float sigmoidf_(float x) { return 1.f / (1.f + __expf(-x)); }

DEVI void ph_l0_post(const Params& p) {
  u16* P = (u16*)(p.ws + WS_P);
  const float* qg = p.in[4]; const float* kg = p.in[5]; const float* lbl = p.in[7];
  const size_t total = (size_t)MBT * 1024;
#pragma unroll 1
  for (size_t it = (size_t)blockIdx.x * NTHR + tid_l(); it < total; it += (size_t)gridDim.x * NTHR) {
    const int ch = (int)(it & 1023); const size_t tok = it >> 10;
    const int seg = ch >> 7;
    if (seg == 2 || seg == 6) continue;
    u16* ptr = P + tok * 8192 + ch * 8;
    const u32x4 w = *(const u32x4*)ptr;
    float v[8];
#pragma unroll
    for (int j = 0; j < 4; ++j) { v[2*j] = bflo(w[j]); v[2*j+1] = bfhi(w[j]); }
    if (seg <= 1) {
      float ss = 0.f;
#pragma unroll
      for (int j = 0; j < 8; ++j) ss += v[j] * v[j];
      ss += __shfl_xor(ss, 1, 64); ss += __shfl_xor(ss, 2, 64); ss += __shfl_xor(ss, 4, 64); ss += __shfl_xor(ss, 8, 64);
      const float rstd = rsqrtf(ss * (1.f / 128.f) + EPS);
      const float* g = (seg == 0 ? qg : kg) + (ch & 15) * 8;
#pragma unroll
      for (int j = 0; j < 8; ++j) v[j] = v[j] * rstd * g[j];
    } else if (seg == 3 || seg == 7) {
#pragma unroll
      for (int j = 0; j < 8; ++j) v[j] = v[j] * sigmoidf_(v[j]);
    } else {
      const int dir = seg - 4; const int k0 = (ch & 127) * 8;
#pragma unroll
      for (int j = 0; j < 8; ++j) {
        const float l0 = lbl[(dir * 2 + 0) * 1024 + k0 + j], l1 = lbl[(dir * 2 + 1) * 1024 + k0 + j];
        const float lb = 1.f / (1.f + expf(l1 - l0));
        const float f = lb + (1.f - lb) * (1.f / (1.f + expf(-v[j])));
        v[j] = logf(f);
      }
    }
    u32x4 o = {cvtpk(v[0], v[1]), cvtpk(v[2], v[3]), cvtpk(v[4], v[5]), cvtpk(v[6], v[7])};
    *(u32x4*)ptr = o;
  }
}

template <int OFF> DEVI s16x4 tr_read(int vb) {
  s16x4 r; asm volatile("ds_read_b64_tr_b16 %0, %1 offset:%2" : "=&v"(r) : "v"(vb), "i"(OFF) : "memory"); return r;
}
DEVI bf16x8 pk44(s16x4 l, s16x4 h) { return (bf16x8){l[0], l[1], l[2], l[3], h[0], h[1], h[2], h[3]}; }

DEVI void ph_na(const Params& p, int mb, char* smem) {
  const u16* P = (const u16*)(p.ws + WS_P);
  u16* MIX = (u16*)(p.ws + WS_MIX);
  const float* rpb = p.in[6];
  const int S = (mb < 2) ? 2048 : 16384; const int rows = S / 64;
  const int tid = tid_l(), wid = tid >> 6, lane = tid & 63, fr = lane & 15, fq = lane >> 4;
  char* vl = smem + wid * 9216;
  const int vlb = (int)(uintptr_t)vl + (fq * 4 + (fr >> 2)) * 288 + (fr & 3) * 8;
  const int nunits = (MBT / 64) * 4;
#pragma unroll 1
  for (int u = blockIdx.x; u < nunits; u += gridDim.x) {
    const int hp = u & 3, rowg = u >> 2;
    const int j = wid & 3, h = hp * 2 + (wid >> 2);
    const int seqrow0 = (rowg / rows) * rows;
    const int r = rowg - seqrow0;
    const int r0 = min(max(r - 4, 0), rows - 8);
    const int kc0 = min(max(j * 16 - 8, 0), 32);
    const size_t qtok = (size_t)rowg * 64 + j * 16 + fr;
    bf16x8 qf[4];
#pragma unroll
    for (int ks = 0; ks < 4; ++ks) qf[ks] = *(const bf16x8*)(P + qtok * 8192 + h * 128 + ks * 32 + fq * 8);
    f32x4 sacc[16];
#pragma unroll
    for (int i = 0; i < 16; ++i) sacc[i] = (f32x4){0.f, 0.f, 0.f, 0.f};
#pragma unroll
    for (int w = 0; w < 8; ++w)
#pragma unroll
      for (int c2 = 0; c2 < 2; ++c2) {
        const size_t ktok = (size_t)(seqrow0 + r0 + w) * 64 + kc0 + c2 * 16 + fr;
        const u16* kp = P + ktok * 8192 + 1024 + h * 128 + fq * 8;
#pragma unroll
        for (int ks = 0; ks < 4; ++ks) {
          const bf16x8 a = *(const bf16x8*)(kp + ks * 32);
          sacc[w * 2 + c2] = __builtin_amdgcn_mfma_f32_16x16x32_bf16(a, qf[ks], sacc[w * 2 + c2], 0, 0, 0);
        }
      }
    const float scale = 0.08838834764831845f;
    const int qcol = j * 16 + fr; const int qc0 = min(max(qcol - 8, 0), 48);
    float mx = -1e30f;
#pragma unroll
    for (int w = 0; w < 8; ++w) {
      const int dr = r0 + w - r + 7;
      const float* brow = rpb + (h * 15 + dr) * 31;
#pragma unroll
      for (int c2 = 0; c2 < 2; ++c2)
#pragma unroll
        for (int e = 0; e < 4; ++e) {
          const int kcol = kc0 + c2 * 16 + fq * 4 + e;
          const bool valid = (kcol >= qc0) && (kcol < qc0 + 16);
          const int dcol = min(max(kcol - qcol + 15, 0), 30);
          const float sv = valid ? sacc[w * 2 + c2][e] * scale + brow[dcol] : -1e30f;
          sacc[w * 2 + c2][e] = sv; mx = fmaxf(mx, sv);
        }
    }
    mx = fmaxf(mx, __shfl_xor(mx, 16, 64)); mx = fmaxf(mx, __shfl_xor(mx, 32, 64));
    float sum = 0.f;
#pragma unroll
    for (int i = 0; i < 16; ++i)
#pragma unroll
      for (int e = 0; e < 4; ++e) { const float sv = sacc[i][e]; const float pe = (sv > -1e29f) ? __expf(sv - mx) : 0.f; sacc[i][e] = pe; sum += pe; }
    sum += __shfl_xor(sum, 16, 64); sum += __shfl_xor(sum, 32, 64);
    const float inv = 1.f / sum;
    f32x4 oacc[8];
#pragma unroll
    for (int c = 0; c < 8; ++c) oacc[c] = (f32x4){0.f, 0.f, 0.f, 0.f};
#pragma unroll
    for (int w = 0; w < 8; ++w) {
      const size_t vt0 = (size_t)(seqrow0 + r0 + w) * 64 + kc0;
#pragma unroll
      for (int i = 0; i < 8; ++i) {
        const int q = i * 64 + lane, row = q >> 4, ch = q & 15;
        const u32x4 d = *(const u32x4*)(P + (vt0 + row) * 8192 + 2048 + h * 128 + ch * 8);
        *(u32x4*)(vl + row * 288 + ch * 16) = d;
      }
      asm volatile("s_waitcnt lgkmcnt(0)" ::: "memory");
      const f32x4 a0 = sacc[w * 2], a1 = sacc[w * 2 + 1];
      u32x4 pw = {cvtpk(a0[0] * inv, a0[1] * inv), cvtpk(a0[2] * inv, a0[3] * inv), cvtpk(a1[0] * inv, a1[1] * inv), cvtpk(a1[2] * inv, a1[3] * inv)};
      const bf16x8 pa = *reinterpret_cast<bf16x8*>(&pw);
#define NA_PV(c) do { const s16x4 t0 = tr_read<(c) * 32>(vlb), t1 = tr_read<(c) * 32 + 16 * 288>(vlb); \
        asm volatile("s_waitcnt lgkmcnt(0)" ::: "memory"); __builtin_amdgcn_sched_barrier(0); \
        oacc[c] = __builtin_amdgcn_mfma_f32_16x16x32_bf16(pa, pk44(t0, t1), oacc[c], 0, 0, 0); } while (0)
      NA_PV(0); NA_PV(1); NA_PV(2); NA_PV(3); NA_PV(4); NA_PV(5); NA_PV(6); NA_PV(7);
#undef NA_PV
      asm volatile("s_waitcnt lgkmcnt(0)" ::: "memory");
    }
#pragma unroll
    for (int c = 0; c < 8; ++c)
#pragma unroll
      for (int e = 0; e < 4; ++e)
        MIX[((size_t)rowg * 64 + j * 16 + fq * 4 + e) * 2048 + h * 128 + c * 16 + fr] = f2bf(oacc[c][e]);
  }
}

template <bool OUT>
DEVI void ph_hgrn_pass(const Params& p, int mb, char* smem) {
  const u16* P = (const u16*)(p.ws + WS_P);
  float* E = (float*)(p.ws + WS_E); float* DEC = (float*)(p.ws + WS_DEC); float* OFB = (float*)(p.ws + WS_OFB);
  const int tid = tid_l(), cl = tid >> 7, v = tid & 127;
  float* lf = (float*)smem + cl * 4 * 8 * 128; float* lk = lf + 8 * 128; float* lq = lk + 8 * 128; float* lv = lq + 8 * 128;
#pragma unroll 1
  for (int cu = blockIdx.x; cu < 256; cu += gridDim.x) {
    const int chain = cu * 4 + cl; const int seg = chain >> 4, hd = chain & 15, h = hd >> 1, dir = hd & 1;
    float Sreg[128];
    float* Eb = E + (size_t)(seg * 16 + hd) * 16384 + v;
#pragma unroll
    for (int k = 0; k < 128; ++k) Sreg[k] = OUT ? Eb[k * 128] : 0.f;
    float lsum = 0.f;
#pragma unroll 1
    for (int tb = 0; tb < 256; tb += 8) {
      __syncthreads();
#pragma unroll
      for (int i = 0; i < 8; ++i) {
        const int tt = tb + i; const size_t tok = (size_t)seg * 256 + (dir ? 255 - tt : tt);
        const u16* pr = P + tok * 8192 + h * 128 + v;
        const float lg = bf2f(pr[4096 + dir * 1024]);
        lf[i * 128 + v] = __expf(lg); lk[i * 128 + v] = -expm1f(lg); lq[i * 128 + v] = bf2f(pr[3072]);
        lsum += lg; lv[i * 128 + v] = bf2f(pr[6144]);
      }
      __syncthreads();
#pragma unroll 1
      for (int i = 0; i < 8; ++i) {
        float o = 0.f;
        const float vi = lv[i * 128 + v];
        const f32x4* f4 = (const f32x4*)(lf + i * 128); const f32x4* k4 = (const f32x4*)(lk + i * 128); const f32x4* q4 = (const f32x4*)(lq + i * 128);
#pragma unroll
        for (int k = 0; k < 32; ++k) {
          const f32x4 ff = f4[k], kk = k4[k];
#pragma unroll
          for (int e = 0; e < 4; ++e) Sreg[k * 4 + e] = ff[e] * Sreg[k * 4 + e] + kk[e] * vi;
          if (OUT) { const f32x4 qq = q4[k];
#pragma unroll
            for (int e = 0; e < 4; ++e) o += qq[e] * Sreg[k * 4 + e]; }
        }
        if (OUT) { const int tt = tb + i; const size_t tok = (size_t)seg * 256 + (dir ? 255 - tt : tt);
          OFB[((size_t)dir * MBT + tok) * 1024 + h * 128 + v] = o; }
      }
    }
    if (!OUT) {
#pragma unroll
      for (int k = 0; k < 128; ++k) Eb[k * 128] = Sreg[k];
      DEC[(seg * 16 + hd) * 128 + v] = __expf(lsum);
    }
  }
}

DEVI void ph_hgrn_carry(const Params& p, int mb) {
  const int S = (mb < 2) ? 2048 : 16384; const int sps = S / 256;
  float* E = (float*)(p.ws + WS_E); const float* DEC = (const float*)(p.ws + WS_DEC);
#pragma unroll 1
  for (int e = blockIdx.x * NTHR + tid_l(); e < 16 * 16384; e += gridDim.x * NTHR) {
    const int hd = e >> 14, kv = e & 16383, k = kv >> 7, dir = hd & 1;
    float run = 0.f;
#pragma unroll 4
    for (int s = 0; s < 64; ++s) {
      const int seg = dir ? 63 - s : s;
      const bool first = dir ? (((seg + 1) % sps) == 0) : ((seg % sps) == 0);
      if (first) run = 0.f;
      const size_t ix = ((size_t)seg * 16 + hd) * 16384 + kv;
      const float tmp = E[ix]; E[ix] = run; run = DEC[(seg * 16 + hd) * 128 + k] * run + tmp;
    }
  }
}

DEVI void ph_hg_combine(const Params& p) {
  const u16* P = (const u16*)(p.ws + WS_P); const float* OFB = (const float*)(p.ws + WS_OFB);
  u16* MIX = (u16*)(p.ws + WS_MIX); const float* og = p.in[8];
#pragma unroll 1
  for (int it = blockIdx.x * NTHR + tid_l(); it < MBT * 128; it += gridDim.x * NTHR) {
    const int tok = it >> 7, ch = it & 127, col = ch * 8;
    const f32x4* a = (const f32x4*)(OFB + (size_t)tok * 1024 + col);
    const f32x4* b = (const f32x4*)(OFB + ((size_t)MBT + tok) * 1024 + col);
    const f32x4 a0 = a[0], a1 = a[1], b0 = b[0], b1 = b[1];
    float o[8] = {a0[0] + b0[0], a0[1] + b0[1], a0[2] + b0[2], a0[3] + b0[3], a1[0] + b1[0], a1[1] + b1[1], a1[2] + b1[2], a1[3] + b1[3]};
    float ss = 0.f;
#pragma unroll
    for (int j = 0; j < 8; ++j) ss += o[j] * o[j];
    ss += __shfl_xor(ss, 1, 64); ss += __shfl_xor(ss, 2, 64); ss += __shfl_xor(ss, 4, 64); ss += __shfl_xor(ss, 8, 64);
    const float rstd = rsqrtf(ss * (1.f / 128.f) + EPS);
    const u32x4 gw = *(const u32x4*)(P + (size_t)tok * 8192 + 7168 + col);
    float g[8];
#pragma unroll
    for (int j = 0; j < 4; ++j) { g[2*j] = bflo(gw[j]); g[2*j+1] = bfhi(gw[j]); }
    const float* gn = og + (col & 127);
#pragma unroll
    for (int j = 0; j < 8; ++j) o[j] = o[j] * rstd * gn[j] * g[j];
    u32x4 w = {cvtpk(o[0], o[1]), cvtpk(o[2], o[3]), cvtpk(o[4], o[5]), cvtpk(o[6], o[7])};
    *(u32x4*)(MIX + (size_t)tok * 2048 + 1024 + col) = w;
  }
}


DEVI unsigned fkey(float x) { const unsigned u = __float_as_uint(x); return (u & 0x80000000u) ? ~u : (u | 0x80000000u); }
template <int N>
DEVI void select16(const float (&v)[N], const int (&id)[N], float* outv, int* outi, int lane) {
  unsigned key[N];
#pragma unroll
  for (int n = 0; n < N; ++n) key[n] = fkey(v[n]);
  unsigned prefix = 0u;
#pragma unroll 1
  for (int bit = 31; bit >= 0; --bit) {
    const unsigned cand = prefix | (1u << bit);
    int cnt = 0;
#pragma unroll
    for (int n = 0; n < N; ++n) cnt += __popcll(__ballot(key[n] >= cand));
    if (cnt >= 16) prefix = cand;
  }
  int base = 0;
  const unsigned long long below = (1ull << lane) - 1ull;
#pragma unroll
  for (int n = 0; n < N; ++n) {
    const bool sel = key[n] >= prefix;
    const unsigned long long m = __ballot(sel);
    const int pos = base + __popcll(m & below);
    if (sel && pos < 16) { outv[pos] = v[n]; outi[pos] = id[n]; }
    base += __popcll(m);
  }
}

DEVI void ph_topk(const Params& p, int mb, char* smem) {
  const float* SC = (const float*)(p.ws + WS_P);
  int* IDX = (int*)(p.ws + WS_IDX) + (size_t)mb * MBT * 128; float* GATE = (float*)(p.ws + WS_GATE) + (size_t)mb * MBT * 128;
  const int tid = tid_l(), wid = tid >> 6, lane = tid & 63;
  float* wv = (float*)smem + wid * 128; int* wi = (int*)wv;
#pragma unroll 1
  for (int pair = blockIdx.x * 8 + wid; pair < MBT * 8; pair += gridDim.x * 8) {
    const int tok = pair >> 3, h = pair & 7;
    const float* sp = SC + (size_t)tok * 2048 + h * 256;
    { const float a[2] = {sp[lane], sp[lane + 64]}; const int ia[2] = {lane, lane + 64}; select16<2>(a, ia, wv, wi + 16, lane); }
    { const float b[2] = {sp[128 + lane], sp[192 + lane]}; const int ib[2] = {lane, lane + 64}; select16<2>(b, ib, wv + 32, wi + 48, lane); }
    const int i = lane >> 2, j0 = (lane & 3) * 4;
    const float s1 = wv[i]; const int i1 = wi[16 + i];
    float c[4]; int ci[4];
#pragma unroll
    for (int e = 0; e < 4; ++e) { c[e] = s1 + wv[32 + j0 + e]; ci[e] = i1 * 128 + wi[48 + j0 + e]; }
    select16<4>(c, ci, wv + 64, wi + 80, lane);
    float mx = -1e30f;
#pragma unroll
    for (int e = 0; e < 16; ++e) mx = fmaxf(mx, wv[64 + e]);
    float sum = 0.f;
#pragma unroll
    for (int e = 0; e < 16; ++e) sum += __expf(wv[64 + e] - mx);
    if (lane < 16) {
      GATE[(size_t)tok * 128 + h * 16 + lane] = __expf(wv[64 + lane] - mx) / sum;
      IDX[(size_t)tok * 128 + h * 16 + lane] = wi[80 + lane];
    }
  }
}

DEVI float gelu_exact(float a) { return 0.5f * a * (1.f + erff(a * 0.70710678118654752f)); }

using f32x2 = __attribute__((ext_vector_type(2))) float;
DEVI float wave_sum_dpp(float v) {
  v += __uint_as_float(__builtin_amdgcn_update_dpp(0, __float_as_uint(v), 0xB1, 0xF, 0xF, true));
  v += __uint_as_float(__builtin_amdgcn_update_dpp(0, __float_as_uint(v), 0x4E, 0xF, 0xF, true));
  v += __uint_as_float(__builtin_amdgcn_update_dpp(0, __float_as_uint(v), 0x141, 0xF, 0xF, true));
  v += __uint_as_float(__builtin_amdgcn_update_dpp(0, __float_as_uint(v), 0x140, 0xF, 0xF, true));
  v += __shfl_xor(v, 16, 64); v += __shfl_xor(v, 32, 64);
  return v;
}
DEVI void ex_load(u32x4 (&buf)[4][2], const unsigned char* tab, int i0, int i1, int gg, int lane) {
#pragma unroll
  for (int q = 0; q < 4; ++q) {
    const int e = gg * 4 + q;
    const int ia = __builtin_amdgcn_readlane(i0, e & 63), ib = __builtin_amdgcn_readlane(i1, e & 63);
    const int ie = (e < 64) ? ia : ib;
    const unsigned char* r = tab + (size_t)ie * 2048 + lane * 16;
    buf[q][0] = *(const u32x4*)r; buf[q][1] = *(const u32x4*)(r + 1024);
  }
}
DEVI void ex_dots(const u32x4 (&buf)[4][2], const f32x2 (&hx)[16], float& a_lo, float& a_hi, int gg, int lane) {
  float part[4];
#pragma unroll
  for (int q = 0; q < 4; ++q) {
    f32x2 s2 = {0.f, 0.f};
#pragma unroll
    for (int c = 0; c < 2; ++c)
#pragma unroll
      for (int k = 0; k < 4; ++k) {
        const f32x2 lo = __builtin_amdgcn_cvt_pk_f32_fp8((int)buf[q][c][k], false), hi = __builtin_amdgcn_cvt_pk_f32_fp8((int)buf[q][c][k], true);
        s2 += lo * hx[c * 8 + k * 2]; s2 += hi * hx[c * 8 + k * 2 + 1];
      }
    part[q] = s2[0] + s2[1];
    __builtin_amdgcn_sched_barrier(0);
  }
#pragma unroll
  for (int q = 0; q < 4; ++q) part[q] = wave_sum_dpp(part[q]);
#pragma unroll
  for (int q = 0; q < 4; ++q) { const int e = gg * 4 + q; if (lane == (e & 63)) { if (e < 64) a_lo = part[q]; else a_hi = part[q]; } }
}
DEVI void ex_acc(const u32x4 (&buf)[4][2], f32x2 (&acc)[16], float w0, float w1, int gg) {
#pragma unroll
  for (int q = 0; q < 4; ++q) {
    const int e = gg * 4 + q;
    const float wa = __uint_as_float(__builtin_amdgcn_readlane(__float_as_uint(w0), e & 63)), wb = __uint_as_float(__builtin_amdgcn_readlane(__float_as_uint(w1), e & 63));
    const float we = (e < 64) ? wa : wb;
    const f32x2 w2 = {we, we};
#pragma unroll
    for (int c = 0; c < 2; ++c)
#pragma unroll
      for (int k = 0; k < 4; ++k) {
        const f32x2 lo = __builtin_amdgcn_cvt_pk_f32_fp8((int)buf[q][c][k], false), hi = __builtin_amdgcn_cvt_pk_f32_fp8((int)buf[q][c][k], true);
        acc[c * 8 + k * 2] += w2 * lo; acc[c * 8 + k * 2 + 1] += w2 * hi;
      }
    __builtin_amdgcn_sched_barrier(0);
  }
}
DEVI void ph_experts(const Params& p, int layer) {
  const unsigned char* UB = p.ws + WS_UB + (size_t)layer * 16384 * 2048; const unsigned char* VB = p.ws + WS_VB + (size_t)layer * 16384 * 2048;
  const int* IDX = (const int*)(p.ws + WS_IDX); const float* GATE = (const float*)(p.ws + WS_GATE);
  const float* gain = p.in[19] + layer * DM;
  const int tid = tid_l(), lane = tid & 63, gw = blockIdx.x * 8 + (tid >> 6), nw = gridDim.x * 8;
#pragma unroll 1
  for (int tok = gw; tok < T_ALL; tok += nw) {
    float* xr = p.out + (size_t)tok * DM + lane * 16;
    f32x2 hx[16]; float ss = 0.f;
#pragma unroll
    for (int c = 0; c < 2; ++c)
#pragma unroll
      for (int k = 0; k < 4; ++k) {
        const f32x4 a = *(const f32x4*)(xr + c * 1024 + k * 4);
        hx[c * 8 + k * 2] = (f32x2){a[0], a[1]}; hx[c * 8 + k * 2 + 1] = (f32x2){a[2], a[3]};
        ss += a[0] * a[0] + a[1] * a[1] + a[2] * a[2] + a[3] * a[3];
      }
    const int i0 = IDX[(size_t)tok * 128 + lane], i1 = IDX[(size_t)tok * 128 + 64 + lane];
    const float g0 = GATE[(size_t)tok * 128 + lane], g1 = GATE[(size_t)tok * 128 + 64 + lane];
    u32x4 bA[4][2], bB[4][2];
    ex_load(bA, UB, i0, i1, 0, lane);
    ss = wave_sum_dpp(ss);
    const float rstd = rsqrtf(ss * (1.f / DM) + EPS);
#pragma unroll
    for (int c = 0; c < 2; ++c)
#pragma unroll
      for (int k = 0; k < 4; ++k) {
        const f32x4 g = *(const f32x4*)(gain + c * 1024 + lane * 16 + k * 4);
        hx[c * 8 + k * 2] *= (f32x2){rstd * g[0], rstd * g[1]}; hx[c * 8 + k * 2 + 1] *= (f32x2){rstd * g[2], rstd * g[3]};
      }
    float a_lo = 0.f, a_hi = 0.f;
#pragma unroll 1
    for (int g = 0; g < 32; g += 2) {
      ex_load(bB, UB, i0, i1, g + 1, lane);
      ex_dots(bA, hx, a_lo, a_hi, g, lane);
      ex_load(bA, (g + 2 < 32) ? UB : VB, i0, i1, (g + 2) & 31, lane);
      ex_dots(bB, hx, a_lo, a_hi, g + 1, lane);
    }
    const float w0 = g0 * gelu_exact(a_lo * (1.f / U_SCALE)) * (1.f / V_SCALE), w1 = g1 * gelu_exact(a_hi * (1.f / U_SCALE)) * (1.f / V_SCALE);
    f32x2 acc[16];
#pragma unroll
    for (int k = 0; k < 16; ++k) acc[k] = (f32x2){0.f, 0.f};
#pragma unroll 1
    for (int g = 0; g < 32; g += 2) {
      ex_load(bB, VB, i0, i1, g + 1, lane);
      ex_acc(bA, acc, w0, w1, g);
      if (g + 2 < 32) ex_load(bA, VB, i0, i1, g + 2, lane);
      ex_acc(bB, acc, w0, w1, g + 1);
    }
#pragma unroll
    for (int c = 0; c < 2; ++c)
#pragma unroll
      for (int k = 0; k < 4; ++k) {
        f32x4 a = *(const f32x4*)(xr + c * 1024 + k * 4);
        a[0] += acc[c * 8 + k * 2][0]; a[1] += acc[c * 8 + k * 2][1]; a[2] += acc[c * 8 + k * 2 + 1][0]; a[3] += acc[c * 8 + k * 2 + 1][1];
        *(f32x4*)(xr + c * 1024 + k * 4) = a;
      }
  }
}

DEVI void ph_l1_post1(const Params& p) {
  const u16* C = (const u16*)(p.ws + WS_E); u16* CQ = (u16*)(p.ws + WS_MIX); u16* CKV = CQ + (size_t)MBT * 768;
  const float* gq = p.in[12]; const float* gkv = p.in[13];
  const int tid = tid_l(), lane = tid & 63, gw = blockIdx.x * 8 + (tid >> 6), nw = gridDim.x * 8;
#pragma unroll 1
  for (int tok = gw; tok < MBT; tok += nw) {
    const u16* cr = C + (size_t)tok * ODD_IN_PAD;
    const u32x4 wa = *(const u32x4*)(cr + lane * 8);
    const u32x4 wb = (lane < 32) ? *(const u32x4*)(cr + 512 + lane * 8) : (u32x4){0u, 0u, 0u, 0u};
    const u32x4 wk = *(const u32x4*)(cr + 768 + lane * 8);
    float a[8], b[8], k[8]; float sq = 0.f, sk = 0.f;
#pragma unroll
    for (int j = 0; j < 4; ++j) { a[2*j] = bflo(wa[j]); a[2*j+1] = bfhi(wa[j]); b[2*j] = bflo(wb[j]); b[2*j+1] = bfhi(wb[j]); k[2*j] = bflo(wk[j]); k[2*j+1] = bfhi(wk[j]); }
#pragma unroll
    for (int j = 0; j < 8; ++j) { sq += a[j] * a[j] + b[j] * b[j]; sk += k[j] * k[j]; }
    sq = wave_sum(sq); sk = wave_sum(sk);
    const float rq = rsqrtf(sq * (1.f / 768.f) + EPS), rk = rsqrtf(sk * (1.f / 512.f) + EPS);
    { const float* g = gq + lane * 8; u32x4 o = {cvtpk(a[0]*rq*g[0], a[1]*rq*g[1]), cvtpk(a[2]*rq*g[2], a[3]*rq*g[3]), cvtpk(a[4]*rq*g[4], a[5]*rq*g[5]), cvtpk(a[6]*rq*g[6], a[7]*rq*g[7])};
      *(u32x4*)(CQ + (size_t)tok * 768 + lane * 8) = o; }
    if (lane < 32) { const float* g = gq + 512 + lane * 8; u32x4 o = {cvtpk(b[0]*rq*g[0], b[1]*rq*g[1]), cvtpk(b[2]*rq*g[2], b[3]*rq*g[3]), cvtpk(b[4]*rq*g[4], b[5]*rq*g[5]), cvtpk(b[6]*rq*g[6], b[7]*rq*g[7])};
      *(u32x4*)(CQ + (size_t)tok * 768 + 512 + lane * 8) = o; }
    { const float* g = gkv + lane * 8; u32x4 o = {cvtpk(k[0]*rk*g[0], k[1]*rk*g[1]), cvtpk(k[2]*rk*g[2], k[3]*rk*g[3]), cvtpk(k[4]*rk*g[4], k[5]*rk*g[5]), cvtpk(k[6]*rk*g[6], k[7]*rk*g[7])};
      *(u32x4*)(CKV + (size_t)tok * 512 + lane * 8) = o; }
  }
}

DEVI void ph_l1_post2(const Params& p, int mb) {
  u16* Q = (u16*)(p.ws + WS_P); const u16* KV = Q + (size_t)MBT * 3072; const u16* C = (const u16*)(p.ws + WS_E); u16* KB = (u16*)(p.ws + WS_OFB);
  const float* rc = (const float*)(p.ws + WS_ROPE); const float* rs = rc + 16384 * 32;
  const int S = (mb < 2) ? 2048 : 16384;
  const size_t total = (size_t)MBT * 16 * 2 * 32;
#pragma unroll 1
  for (size_t it = (size_t)blockIdx.x * NTHR + tid_l(); it < total; it += (size_t)gridDim.x * NTHR) {
    const int sub = (int)(it & 31); const size_t grp = it >> 5;
    const int which = (int)(grp & 1), head = (int)((grp >> 1) & 15); const size_t tok = grp >> 5;
    const int pos = (int)(tok % (size_t)S);
    const u16* np = which ? (KV + tok * 4096 + head * 256 + 4 * sub) : (Q + tok * 3072 + head * 192 + 4 * sub);
    const u16* rp = which ? (C + tok * ODD_IN_PAD + 1280 + sub) : (Q + tok * 3072 + head * 192 + 128 + sub);
    const u32x2 nw = *(const u32x2*)np;
    float n[4] = {bflo(nw[0]), bfhi(nw[0]), bflo(nw[1]), bfhi(nw[1])};
    float x1 = bf2f(rp[0]), x2 = bf2f(rp[32]);
    float ss = n[0]*n[0] + n[1]*n[1] + n[2]*n[2] + n[3]*n[3] + x1*x1 + x2*x2;
    ss += __shfl_xor(ss, 1, 64); ss += __shfl_xor(ss, 2, 64); ss += __shfl_xor(ss, 4, 64); ss += __shfl_xor(ss, 8, 64); ss += __shfl_xor(ss, 16, 64);
    const float rstd = rsqrtf(ss * (1.f / 192.f) + EPS);
    const float* g = which ? p.in[17] : p.in[16];
    const f32x4 gn = *(const f32x4*)(g + 4 * sub);
    const float y1 = x1 * rstd * g[128 + sub], y2 = x2 * rstd * g[160 + sub];
    const float c = rc[pos * 32 + sub], sn = rs[pos * 32 + sub];
    u16* dp = which ? (KB + tok * 3072 + head * 192) : (Q + tok * 3072 + head * 192);
    u32x2 o = {cvtpk(n[0]*rstd*gn[0], n[1]*rstd*gn[1]), cvtpk(n[2]*rstd*gn[2], n[3]*rstd*gn[3])};
    *(u32x2*)(dp + 4 * sub) = o;
    dp[128 + sub] = f2bf(y1 * c - y2 * sn);
    dp[160 + sub] = f2bf(y2 * c + y1 * sn);
  }
}

constexpr int A_NW = 8, A_QBLK = 32, A_KVBLK = 64;
constexpr float A_SCALE = 0.07216878364870322f;
constexpr int A_LDQ = 3072, A_LDK = 3072, A_LDV = 4096, A_LDO = 2048;
constexpr int A_SHM_V = 64 * 128 * 2, A_SHM_K = 64 * 192 * 2;
constexpr float A_THR = 8.f;
#define KSWZ2(row, colB) ((row) * 384 + ((colB) ^ ((((row) >> 1) & 7) << 4)))
#define SBAR() __builtin_amdgcn_sched_barrier(0)
DEVI int crow(int r, int hi) { return (r & 3) + 8 * (r >> 2) + 4 * hi; }
DEVI void a_partialSM(f32x16& p0, f32x16& p1, float& m_reg, float& mn, float& alpha) {
  constexpr float C = A_SCALE * 1.4426950408889634f;
  float pmax = p0[0];
#pragma unroll
  for (int r = 1; r < 16; ++r) pmax = fmaxf(pmax, p0[r]);
#pragma unroll
  for (int r = 0; r < 16; ++r) pmax = fmaxf(pmax, p1[r]);
  { auto rr = __builtin_amdgcn_permlane32_swap(__float_as_uint(pmax), __float_as_uint(pmax), false, false);
    pmax = fmaxf(__uint_as_float(rr[0]), __uint_as_float(rr[1])); }
  if (__builtin_expect(__all(pmax - m_reg <= A_THR / A_SCALE), 1)) { mn = m_reg; alpha = 1.f; }
  else { mn = fmaxf(m_reg, pmax); alpha = __builtin_amdgcn_exp2f((m_reg - mn) * C); m_reg = mn; }
  const float mnC = -mn * C;
#pragma unroll
  for (int r = 0; r < 16; ++r) p0[r] = fmaf(p0[r], C, mnC);
#pragma unroll
  for (int r = 0; r < 16; ++r) p1[r] = fmaf(p1[r], C, mnC);
#pragma unroll
  for (int r = 0; r < 16; ++r) p0[r] = __builtin_amdgcn_exp2f(p0[r]);
}
DEVI void a_finishSM(f32x16& p0, f32x16& p1, float alpha, float& l_reg, bf16x8& pa0, bf16x8& pa1, bf16x8& pa2, bf16x8& pa3) {
#pragma unroll
  for (int r = 0; r < 16; ++r) p1[r] = __builtin_amdgcn_exp2f(p1[r]);
  float ps = 0;
#pragma unroll
  for (int r = 0; r < 16; ++r) ps += p0[r];
#pragma unroll
  for (int r = 0; r < 16; ++r) ps += p1[r];
  { auto rr = __builtin_amdgcn_permlane32_swap(__float_as_uint(ps), __float_as_uint(ps), false, false);
    ps = __uint_as_float(rr[0]) + __uint_as_float(rr[1]); }
  l_reg = l_reg * alpha + ps;
#define PK4(P, BASE, OUT) do { unsigned a0 = cvtpk(P[BASE + 0], P[BASE + 1]), a1 = cvtpk(P[BASE + 2], P[BASE + 3]);   \
    unsigned b0 = cvtpk(P[BASE + 4], P[BASE + 5]), b1 = cvtpk(P[BASE + 6], P[BASE + 7]);                              \
    auto r0 = __builtin_amdgcn_permlane32_swap(a0, b0, false, false); auto r1 = __builtin_amdgcn_permlane32_swap(a1, b1, false, false); \
    u32x4 w = {r0[0], r1[0], r0[1], r1[1]}; OUT = *reinterpret_cast<bf16x8*>(&w); } while (0)
  PK4(p0, 0, pa0); PK4(p0, 8, pa1); PK4(p1, 0, pa2); PK4(p1, 8, pa3);
#undef PK4
}
DEVI void a_qkt(f32x16& p0, f32x16& p1, const char* Ks, const bf16x8* qr, int r32, int hi) {
  p0 = f32x16{}; p1 = f32x16{};
#pragma unroll
  for (int d0 = 0; d0 < 12; ++d0) { const int cb = (d0 * 16 + hi * 8) * 2;
    const bf16x8 b0 = *reinterpret_cast<const bf16x8*>(Ks + KSWZ2(r32, cb));
    const bf16x8 b1 = *reinterpret_cast<const bf16x8*>(Ks + KSWZ2(32 + r32, cb));
    p0 = __builtin_amdgcn_mfma_f32_32x32x16_bf16(b0, qr[d0], p0, 0, 0, 0);
    p1 = __builtin_amdgcn_mfma_f32_32x32x16_bf16(b1, qr[d0], p1, 0, 0, 0); }
}
DEVI int a_v_st(int k, int c) { const int kk = (k & ~0xC) | ((k & 4) << 1) | ((k & 8) >> 1); return ((kk >> 3) * 4 + (c >> 5)) * 512 + ((kk & 7) * 32 + (c & 31)) * 2; }
DEVI int a_v_rd_base(int lane) { return ((lane & 3) << 3) | (((lane >> 2) & 3) << 6) | (((lane >> 4) & 1) << 5) | (((lane >> 5) & 1) << 8); }
constexpr int a_v_rd_off(int d0, int ks, int half) { return d0 * 512 + ks * 4096 + half * 2048; }
template <int D0> DEVI void a_pv_one(f32x16& od, int vb, bf16x8 pa0, bf16x8 pa1, bf16x8 pa2, bf16x8 pa3) {
  const s16x4 l0 = tr_read<a_v_rd_off(D0, 0, 0)>(vb), h0 = tr_read<a_v_rd_off(D0, 0, 1)>(vb), l1 = tr_read<a_v_rd_off(D0, 1, 0)>(vb), h1 = tr_read<a_v_rd_off(D0, 1, 1)>(vb);
  const s16x4 l2 = tr_read<a_v_rd_off(D0, 2, 0)>(vb), h2 = tr_read<a_v_rd_off(D0, 2, 1)>(vb), l3 = tr_read<a_v_rd_off(D0, 3, 0)>(vb), h3 = tr_read<a_v_rd_off(D0, 3, 1)>(vb);
  asm volatile("s_waitcnt lgkmcnt(0)" ::: "memory"); SBAR();
  od = __builtin_amdgcn_mfma_f32_32x32x16_bf16(pa0, pk44(l0, h0), od, 0, 0, 0);
  od = __builtin_amdgcn_mfma_f32_32x32x16_bf16(pa1, pk44(l1, h1), od, 0, 0, 0);
  od = __builtin_amdgcn_mfma_f32_32x32x16_bf16(pa2, pk44(l2, h2), od, 0, 0, 0);
  od = __builtin_amdgcn_mfma_f32_32x32x16_bf16(pa3, pk44(l3, h3), od, 0, 0, 0);
}
DEVI void a_pv_d0(f32x16* o, int vb, bf16x8 pa0, bf16x8 pa1, bf16x8 pa2, bf16x8 pa3) {
  a_pv_one<0>(o[0], vb, pa0, pa1, pa2, pa3); a_pv_one<1>(o[1], vb, pa0, pa1, pa2, pa3); a_pv_one<2>(o[2], vb, pa0, pa1, pa2, pa3); a_pv_one<3>(o[3], vb, pa0, pa1, pa2, pa3);
}
template <int SDEPTH>
DEVI void attn_body(const u16* __restrict__ Qb, const u16* __restrict__ Kh, const u16* __restrict__ Vh, u16* __restrict__ Ob, int seq, char* lds) {
  const int tid = tid_l(), wid = tid >> 6, lane = tid & 63, r32 = lane & 31, hi = lane >> 5;
  char* V_lds = lds; char* K_lds = lds + 2 * A_SHM_V;
  float* ws = (float*)(lds + 2 * A_SHM_V + 2 * A_SHM_K) + wid * 64; float* li_l = ws; float* al_l = ws + 32;
  float m_reg = -1e30f, l_reg = 0; f32x16 o[4] = {}; bf16x8 qr[12];
  const u16* Qw = Qb + (long)(wid * A_QBLK + r32) * A_LDQ + hi * 8;
#pragma unroll
  for (int d0 = 0; d0 < 12; ++d0) qr[d0] = *reinterpret_cast<const bf16x8*>(Qw + d0 * 16);
  const int sr = tid >> 4, sc = (tid & 15) * 8, vst0 = a_v_st(sr, sc), vst1 = a_v_st(32 + sr, sc);
  const int kr = tid >> 3, kc = (tid & 7) * 8;
  const int kst = KSWZ2(kr, kc * 2);
  const unsigned voff = (unsigned)(sr * A_LDV + sc) * 2u, koff = (unsigned)(kr * A_LDK + kc) * 2u;
  const int vb0 = (int)(uintptr_t)V_lds + a_v_rd_base(lane);
  struct { bf16x8 vs0, vs1, ks0, ks1, ks2; } sr_[SDEPTH];
#define SLOAD(i, k0) do { const char* vb_ = (const char*)(Vh + (long)(k0) * A_LDV); const char* kb_ = (const char*)(Kh + (long)(k0) * A_LDK); \
    sr_[i].vs0 = *(const bf16x8*)(vb_ + voff); sr_[i].vs1 = *(const bf16x8*)(vb_ + 32 * A_LDV * 2 + voff); \
    sr_[i].ks0 = *(const bf16x8*)(kb_ + koff); sr_[i].ks1 = *(const bf16x8*)(kb_ + koff + 128); sr_[i].ks2 = *(const bf16x8*)(kb_ + koff + 256); } while (0)
#define SWRITE(b, i) do { *(bf16x8*)(V_lds + (b) * A_SHM_V + vst0) = sr_[i].vs0; *(bf16x8*)(V_lds + (b) * A_SHM_V + vst1) = sr_[i].vs1; \
    *(bf16x8*)(K_lds + (b) * A_SHM_K + kst) = sr_[i].ks0; *(bf16x8*)(K_lds + (b) * A_SHM_K + kst + 128) = sr_[i].ks1; *(bf16x8*)(K_lds + (b) * A_SHM_K + kst + 256) = sr_[i].ks2; } while (0)
#define SWAIT() do { if constexpr (SDEPTH == 2) asm volatile("s_waitcnt vmcnt(5)" ::: "memory"); else asm volatile("s_waitcnt vmcnt(0)" ::: "memory"); } while (0)
#define RESC(a) do { if (__any((a) < 1.f)) { if (hi == 0) al_l[r32] = (a); asm volatile("s_waitcnt lgkmcnt(0)" ::: "memory"); \
    _Pragma("unroll") for (int d = 0; d < 4; ++d) _Pragma("unroll") for (int r = 0; r < 16; ++r) o[d][r] *= al_l[crow(r, hi)]; } } while (0)
  f32x16 pA0, pA1, pB0, pB1; float mnA, mnB, alA, alB; bf16x8 pa0, pa1, pa2, pa3; const int NT = seq / A_KVBLK;
  constexpr int SE = 0, SO = SDEPTH - 1;
  __syncthreads();
  SLOAD(SE, 0); asm volatile("s_waitcnt vmcnt(0)" ::: "memory"); SWRITE(0, SE); __syncthreads();
  a_qkt(pA0, pA1, K_lds, qr, r32, hi); a_partialSM(pA0, pA1, m_reg, mnA, alA);
  SLOAD(SO, A_KVBLK); if constexpr (SDEPTH == 2) { if (2 < NT) SLOAD(SE, 2 * A_KVBLK); }
  SWAIT(); SWRITE(1, SO); __syncthreads();
#pragma unroll 1
  for (int j = 1; j + 1 < NT; j += 2) {
    SBAR(); a_qkt(pB0, pB1, K_lds + A_SHM_K, qr, r32, hi);
    a_finishSM(pA0, pA1, alA, l_reg, pa0, pa1, pa2, pa3); SBAR();
    SLOAD(SO, (j + SDEPTH) * A_KVBLK); SBAR();
    a_pv_d0(o, vb0, pa0, pa1, pa2, pa3); a_partialSM(pB0, pB1, m_reg, mnB, alB);
    __syncthreads(); SWAIT(); SWRITE(0, SE);
    RESC(alB); __syncthreads();
    SBAR(); a_qkt(pA0, pA1, K_lds, qr, r32, hi);
    a_finishSM(pB0, pB1, alB, l_reg, pa0, pa1, pa2, pa3); SBAR();
    if (SDEPTH == 1 || j + 3 < NT) SLOAD(SE, (j + 1 + SDEPTH) * A_KVBLK); SBAR();
    a_pv_d0(o, vb0 + A_SHM_V, pa0, pa1, pa2, pa3); a_partialSM(pA0, pA1, m_reg, mnA, alA);
    __syncthreads(); SWAIT(); SWRITE(1, SO);
    RESC(alA); __syncthreads();
  }
  SBAR(); a_qkt(pB0, pB1, K_lds + A_SHM_K, qr, r32, hi);
  a_finishSM(pA0, pA1, alA, l_reg, pa0, pa1, pa2, pa3); SBAR();
  a_pv_d0(o, vb0, pa0, pa1, pa2, pa3); a_partialSM(pB0, pB1, m_reg, mnB, alB);
  __syncthreads(); RESC(alB);
  a_finishSM(pB0, pB1, alB, l_reg, pa0, pa1, pa2, pa3); SBAR();
  a_pv_d0(o, vb0 + A_SHM_V, pa0, pa1, pa2, pa3);
  if (hi == 0) li_l[r32] = l_reg; asm volatile("s_waitcnt lgkmcnt(0)" ::: "memory");
  float rli[16];
#pragma unroll
  for (int r = 0; r < 16; ++r) rli[r] = __builtin_amdgcn_rcpf(li_l[crow(r, hi)]);
  u16* Ow = Ob + (long)(wid * A_QBLK) * A_LDO;
#pragma unroll
  for (int r = 0; r < 16; ++r) { const int orow = crow(r, hi);
#pragma unroll
    for (int d0 = 0; d0 < 4; ++d0) Ow[(long)orow * A_LDO + d0 * 32 + r32] = f2bf(o[d0][r] * rli[r]); }
#undef SLOAD
#undef SWRITE
#undef SWAIT
#undef RESC
}

DEVI void ph_attn(const Params& p, int mb, char* smem) {
  const u16* Q = (const u16*)(p.ws + WS_P); const u16* KV = Q + (size_t)MBT * 3072; const u16* KB = (const u16*)(p.ws + WS_OFB); u16* O = (u16*)(p.ws + WS_H);
  const int S = (mb < 2) ? 2048 : 16384; const int QB = S / 256;
  const int nunits = (MBT / 256) * 16;
  const bool swz = (gridDim.x == 256);
#pragma unroll 1
  for (int it = 0; it * (int)gridDim.x + (int)blockIdx.x < nunits; ++it) {
    int seq, head, qb;
    if (swz) { const int x = blockIdx.x & 7, slot = blockIdx.x >> 3; const int li = slot + 32 * it; const int gp = x + 8 * (li / QB); qb = li % QB; head = gp & 15; seq = gp >> 4; }
    else { const int u = it * gridDim.x + blockIdx.x; qb = u % QB; head = (u / QB) & 15; seq = u / (QB * 16); }
    const size_t t0 = (size_t)seq * S;
    attn_body<1>(Q + (t0 + (size_t)qb * 256) * 3072 + head * 192, KB + t0 * 3072 + head * 192, KV + t0 * 4096 + head * 256 + 128,
                 O + (t0 + (size_t)qb * 256) * 2048 + head * 128, S, smem);
  }
}

__global__ void __launch_bounds__(NTHR, 2) fwd(Params p) {
  extern __shared__ __attribute__((aligned(16))) char smem[];
  volatile LAS unsigned* ctl = (volatile LAS unsigned*)(smem + 131072);
  if (threadIdx.x < 16) ctl[threadIdx.x] = 0u;
  __syncthreads();
  XcdBarrier bar; bar.bar = (unsigned*)(p.ws + WS_BAR); bar.x = 0; bar.st = ctl;
  const bool multi = (p.step_hi - p.step_lo) > 1;
  if (multi) bar = xcd_barrier_post((unsigned*)(p.ws + WS_BAR), ctl);
  int step = 0;
#define STEP(code) do { if (step >= p.step_lo && step < p.step_hi) { code; if (step + 1 < p.step_hi) xcd_barrier(bar); } ++step; } while (0)

  STEP(ph_prologue(p, smem); ph_convert_uv(p));
#pragma unroll 1
  for (int mb = 0; mb < NMB; ++mb) {
    u16* H = (u16*)(p.ws + WS_H); u16* PP = (u16*)(p.ws + WS_P); u16* MIX = (u16*)(p.ws + WS_MIX);
    float* outmb = p.out + (size_t)mb * MBT * DM;
    STEP(ph_norm(xin_mb(p, mb), p.in[2], H, MBT));
    STEP(ph_gemm<EPI_BF16>(H, (const u16*)(p.ws + WS_WT_EVIN), MBT, 8192, 2048, GemmEpi{PP, nullptr, 8192}, smem));
    STEP(ph_l0_post(p));
    STEP(ph_na(p, mb, smem); __syncthreads(); ph_hgrn_pass<false>(p, mb, smem));
    STEP(ph_hgrn_carry(p, mb));
    STEP(ph_hgrn_pass<true>(p, mb, smem));
    STEP(ph_hg_combine(p));
    STEP(ph_gemm<EPI_RESID>(MIX, (const u16*)(p.ws + WS_WT_EVOUT), MBT, 2048, 2048, GemmEpi{outmb, xin_mb(p, mb), 2048}, smem));
    STEP(ph_norm(outmb, p.in[19], H, MBT));
    STEP(ph_gemm<EPI_F32>(H, (const u16*)(p.ws + WS_WEFF), MBT, 2048, 2048, GemmEpi{PP, nullptr, 2048}, smem));
    STEP(ph_topk(p, mb, smem));
  }
  STEP(ph_experts(p, 0));
#pragma unroll 1
  for (int mb = 0; mb < NMB; ++mb) {
    u16* H = (u16*)(p.ws + WS_H); u16* PP = (u16*)(p.ws + WS_P); u16* CQ = (u16*)(p.ws + WS_MIX);
    float* outmb = p.out + (size_t)mb * MBT * DM;
    STEP(ph_norm(outmb, p.in[10], H, MBT));
    STEP(ph_gemm<EPI_BF16>(H, (const u16*)(p.ws + WS_WT_ODIN), MBT, ODD_IN_PAD, 2048, GemmEpi{p.ws + WS_E, nullptr, ODD_IN_PAD}, smem));
    STEP(ph_l1_post1(p));
    STEP(ph_gemm<EPI_BF16>(CQ, (const u16*)(p.ws + WS_WT_UQ), MBT, 3072, 768, GemmEpi{PP, nullptr, 3072}, smem);
         ph_gemm<EPI_BF16>(CQ + (size_t)MBT * 768, (const u16*)(p.ws + WS_WT_UKV), MBT, 4096, 512, GemmEpi{PP + (size_t)MBT * 3072, nullptr, 4096}, smem));
    STEP(ph_l1_post2(p, mb));
    STEP(ph_attn(p, mb, smem));
    STEP(ph_gemm<EPI_RESID>(H, (const u16*)(p.ws + WS_WT_ODOUT), MBT, 2048, 2048, GemmEpi{outmb, outmb, 2048}, smem));
    STEP(ph_norm(outmb, p.in[19] + DM, H, MBT));
    STEP(ph_gemm<EPI_F32>(H, (const u16*)(p.ws + WS_WEFF) + (size_t)2048 * 2048, MBT, 2048, 2048, GemmEpi{PP, nullptr, 2048}, smem));
    STEP(ph_topk(p, mb, smem));
  }
  STEP(ph_experts(p, 1));
}

constexpr int N_STEPS = 1 + 4 * 11 + 1 + 4 * 10 + 1;

#ifndef MK_MULTI
#define MK_MULTI 0
#endif

extern "C" void kernel_launch(void* const* d_in, const int* in_sizes, int n_in, void* d_out, int out_size, void* d_ws, size_t ws_size, hipStream_t stream) {
  static int grid = 0;
  if (grid == 0) {
    if (n_in != 24 || out_size != T_ALL * DM || ws_size < WS_END) { fprintf(stderr, "kernel_launch: shape/ws mismatch n_in %d out %d ws %zu need %zu\n", n_in, out_size, ws_size, (size_t)WS_END); grid = -1; return; }
    int dev = 0, cus = 0, per_cu = 0;
    if (hipGetDevice(&dev) != hipSuccess || hipDeviceGetAttribute(&cus, hipDeviceAttributeMultiprocessorCount, dev) != hipSuccess) { grid = -1; return; }
    if (hipFuncSetAttribute((const void*)fwd, hipFuncAttributeMaxDynamicSharedMemorySize, LDS_BYTES) != hipSuccess) { fprintf(stderr, "kernel_launch: hipFuncSetAttribute failed\n"); grid = -1; return; }
    if (hipOccupancyMaxActiveBlocksPerMultiprocessor(&per_cu, (const void*)fwd, NTHR, LDS_BYTES) != hipSuccess || per_cu < 1) { fprintf(stderr, "kernel_launch: occupancy query says %d\n", per_cu); (void)hipGetLastError(); grid = -1; return; }
    grid = cus;
  }
  if (grid < 0) return;
  (void)hipMemsetAsync((char*)d_ws + WS_BAR, 0, XCD_BAR_WORDS * 4, stream);
  Params p{};
  for (int i = 0; i < 24; ++i) p.in[i] = (const float*)d_in[i];
  p.out = (float*)d_out; p.ws = (unsigned char*)d_ws;
#if MK_MULTI
  for (int s = 0; s < N_STEPS; ++s) { p.step_lo = s; p.step_hi = s + 1; hipLaunchKernelGGL(fwd, dim3(grid), dim3(NTHR), LDS_BYTES, stream, p); }
#else
  p.step_lo = 0; p.step_hi = N_STEPS;
  hipLaunchKernelGGL(fwd, dim3(grid), dim3(NTHR), LDS_BYTES, stream, p);
#endif
  const hipError_t le = hipPeekAtLastError();
  if (le != hipSuccess) fprintf(stderr, "kernel_launch: launch failed: %s\n", hipGetErrorName(le));
}

#ifdef PHASE_TEST
#define PT(name, body) __global__ void __launch_bounds__(NTHR, 2) name(Params p, int mb) { extern __shared__ __attribute__((aligned(16))) char smem[]; body; }
PT(t_prologue, ph_prologue(p, smem))
PT(t_convert, ph_convert_uv(p))
PT(t_norm, ph_norm(xin_mb(p, mb), p.in[2], (u16*)(p.ws + WS_H), MBT))
PT(t_gemm_bf16, ph_gemm<EPI_BF16>((u16*)(p.ws + WS_H), (const u16*)(p.ws + WS_WT_EVIN), MBT, 8192, 2048, GemmEpi{p.ws + WS_P, nullptr, 8192}, smem))
PT(t_gemm_resid, ph_gemm<EPI_RESID>((u16*)(p.ws + WS_H), (const u16*)(p.ws + WS_WT_EVIN), MBT, 2048, 2048, GemmEpi{p.out, p.in[0], 2048}, smem))
PT(t_l0post, ph_l0_post(p))
PT(t_na, ph_na(p, mb, smem))
PT(t_hg1, ph_hgrn_pass<false>(p, mb, smem))
PT(t_hg3, ph_hgrn_pass<true>(p, mb, smem))
PT(t_carry, ph_hgrn_carry(p, mb))
PT(t_comb, ph_hg_combine(p))
PT(t_topk, ph_topk(p, mb, smem))
PT(t_experts, ph_experts(p, mb))
PT(t_post1, ph_l1_post1(p))
PT(t_post2, ph_l1_post2(p, mb))
PT(t_attn, ph_attn(p, mb, smem))
PT(t_gemm_f32, ph_gemm<EPI_F32>((u16*)(p.ws + WS_H), (const u16*)(p.ws + WS_WT_EVIN), MBT, 2048, 2048, GemmEpi{p.ws + WS_P, nullptr, 2048}, smem))
#endif
```

```cpp
#include <hip/hip_runtime.h>
#include <stdint.h>
#include <stdio.h>

#define DEVI __device__ __forceinline__
typedef unsigned short u16;
typedef unsigned int u32;
using bf16x8 = __attribute__((ext_vector_type(8))) short;
using s16x4  = __attribute__((ext_vector_type(4))) short;
using f32x4  = __attribute__((ext_vector_type(4))) float;
using f32x16 = __attribute__((ext_vector_type(16))) float;
using u32x4  = __attribute__((ext_vector_type(4))) unsigned;
using u32x2  = __attribute__((ext_vector_type(2))) unsigned;

constexpr int DM = 2048;
constexpr int T_ALL = 65536;
constexpr int MBT = 16384;
constexpr int NMB = 4;
constexpr int NTHR = 512;
constexpr int EVEN_IN = 8192;
constexpr int ODD_IN = 1344, ODD_IN_PAD = 1536;
constexpr float EPS = 1e-6f;

constexpr size_t A256(size_t x) { return (x + 255) / 256 * 256; }
constexpr size_t WS_BAR      = 0;
constexpr size_t WS_WT_EVIN  = 16384;
constexpr size_t WS_WT_EVOUT = WS_WT_EVIN  + (size_t)8192 * 2048 * 2;
constexpr size_t WS_WT_ODIN  = WS_WT_EVOUT + (size_t)2048 * 2048 * 2;
constexpr size_t WS_WT_UQ    = WS_WT_ODIN  + (size_t)1536 * 2048 * 2;
constexpr size_t WS_WT_UKV   = WS_WT_UQ    + (size_t)3072 * 768 * 2;
constexpr size_t WS_WT_ODOUT = WS_WT_UKV   + (size_t)4096 * 512 * 2;
constexpr size_t WS_WEFF     = WS_WT_ODOUT + (size_t)2048 * 2048 * 2;
constexpr size_t WS_ROPE     = WS_WEFF     + (size_t)2 * 2048 * 2048 * 2;
constexpr size_t WS_UB       = WS_ROPE     + (size_t)16384 * 64 * 4;
constexpr size_t WS_VB       = WS_UB       + (size_t)2 * 16384 * 1024;
constexpr size_t WS_IDX      = WS_VB       + (size_t)2 * 16384 * 1024;
constexpr size_t WS_GATE     = WS_IDX      + (size_t)T_ALL * 128 * 4;
constexpr size_t WS_H        = WS_GATE     + (size_t)T_ALL * 128 * 4;
constexpr size_t WS_P        = WS_H        + (size_t)MBT * 2048 * 2;
constexpr size_t WS_MIX      = WS_P        + (size_t)MBT * 8192 * 2;
constexpr size_t WS_E        = WS_MIX      + (size_t)MBT * 2048 * 2;
constexpr size_t WS_DEC      = WS_E        + (size_t)MBT * 1536 * 2;
constexpr size_t WS_OFB      = WS_DEC      + (size_t)64 * 16 * 128 * 4;
constexpr size_t WS_X2B      = WS_OFB      + (size_t)MBT * 3072 * 2;
constexpr size_t WS_RS2      = WS_X2B      + (size_t)T_ALL * 2048 * 2;
constexpr size_t WS_END      = WS_RS2      + (size_t)T_ALL * 4;

constexpr int LDS_BYTES = 131072 + 2048 + 8192;
constexpr int LDS_TK = 131072 + 2048;

struct Params {
  const float* in[24];
  float* out;
  unsigned char* ws;
  int step_lo, step_hi;
  int wave_u, pad_;
};

#define XB_TMO      128
#define XB_XCNT(j)  (256  + 64 * (j))
#define XB_XSUB(j)  (1280 + 64 * (j))
#define XB_XGEN(j)  (2304 + 64 * (j))
#define XB_TOP      3328
#define XB_TOPGEN   3392
#define XCD_BAR_WORDS 3456
#define XB_SPIN_CAP (1u << 18)
#define LAS __attribute__((address_space(3)))

__device__ __forceinline__ unsigned xb_ld(unsigned* p)              { return __hip_atomic_load(p, __ATOMIC_RELAXED, __HIP_MEMORY_SCOPE_AGENT); }
__device__ __forceinline__ unsigned xb_add(unsigned* p, unsigned v) { return __hip_atomic_fetch_add(p, v, __ATOMIC_RELAXED, __HIP_MEMORY_SCOPE_AGENT); }
__device__ __forceinline__ unsigned xb_xcc_id() { return (unsigned)__builtin_amdgcn_s_getreg((3 << 11) | 20) & 0xFu; }
#define XB_SPIN(cond, bar) do { unsigned _sp = 0; while (cond) { __builtin_amdgcn_s_sleep(1); \
    if ((++_sp & 255u) == 0u) { if (xb_ld(&(bar)[XB_TMO])) break; if (_sp > XB_SPIN_CAP) { atomicAdd(&(bar)[XB_TMO], 1u); break; } } } } while (0)

__device__ __forceinline__ bool xb_thread0(int wave_u) { int l; asm volatile("v_mbcnt_lo_u32_b32 %0, -1, 0\n\tv_mbcnt_hi_u32_b32 %0, -1, %0" : "=v"(l)); return wave_u == 0 && l == 0; }
struct XcdBarrier {
    unsigned* bar; unsigned x; int wave_u;
    volatile LAS unsigned* st;
};
__device__ __forceinline__ XcdBarrier xcd_barrier_post(unsigned* bar, volatile LAS unsigned* st, int wave_u) {
    XcdBarrier b; b.bar = bar; b.x = xb_xcc_id(); b.st = st; b.wave_u = wave_u;
    if (xb_thread0(wave_u)) (void)xb_add(&bar[XB_XCNT(b.x)], 1u);
    return b;
}
__device__ __forceinline__ void xcd_barrier_complete(unsigned* bar, unsigned x, unsigned& nloc, unsigned& nx) {
    const unsigned G = gridDim.x * gridDim.y * gridDim.z;
    unsigned sum, cnt, mine, sp = 0u;
    for (;;) {
        sum = 0u; cnt = 0u; mine = 0u;
#pragma unroll
        for (unsigned j = 0; j < 16; ++j) { const unsigned c = xb_ld(&bar[XB_XCNT(j)]); sum += c; cnt += (c > 0u) ? 1u : 0u; mine = (j == x) ? c : mine; }
        if (sum == G) break;
        __builtin_amdgcn_s_sleep(1);
        if ((++sp & 255u) == 0u) { if (xb_ld(&bar[XB_TMO])) break; if (sp > XB_SPIN_CAP) { atomicAdd(&bar[XB_TMO], 1u); break; } }
    }
    nloc = mine > 0u ? mine : 1u; nx = cnt > 0u ? cnt : 1u;
}
__device__ __forceinline__ void xcd_barrier(const XcdBarrier& b) {
    asm volatile("s_waitcnt vmcnt(0)" ::: "memory");
    __syncthreads();
    if (xb_thread0(b.wave_u)) {
        unsigned* bar = b.bar;
        __builtin_amdgcn_s_waitcnt(0);
        unsigned nloc = b.st[0], nx = b.st[1];
        if (nloc == 0u) { xcd_barrier_complete(bar, b.x, nloc, nx); b.st[0] = nloc; b.st[1] = nx; }
        const unsigned old = xb_add(&bar[XB_XSUB(b.x)], 1u);
        const unsigned gen = old / nloc;
        if (old + 1u == (gen + 1u) * nloc) {
            __builtin_amdgcn_fence(__ATOMIC_RELEASE, "agent");
            asm volatile("s_waitcnt vmcnt(0)" ::: "memory");
            const unsigned og = xb_add(&bar[XB_TOP], 1u);
            const unsigned tg = og / nx;
            if (og + 1u == (tg + 1u) * nx) xb_add(&bar[XB_TOPGEN], 1u);
            else XB_SPIN(xb_ld(&bar[XB_TOPGEN]) == tg, bar);
            __builtin_amdgcn_fence(__ATOMIC_ACQUIRE, "agent");
            xb_add(&bar[XB_XGEN(b.x)], 1u);
            asm volatile("s_waitcnt vmcnt(0)" ::: "memory");
        } else {
            XB_SPIN(xb_ld(&bar[XB_XGEN(b.x)]) == gen, bar);
            __builtin_amdgcn_fence(__ATOMIC_ACQUIRE, "agent");
            asm volatile("s_waitcnt vmcnt(0)" ::: "memory");
        }
    }
    __syncthreads();
}

typedef __bf16 bf16x2_t __attribute__((ext_vector_type(2)));
using f32x2_t = __attribute__((ext_vector_type(2))) float;
DEVI unsigned cvtpk(float lo, float hi) { const f32x2_t v = {lo, hi}; const bf16x2_t r = __builtin_convertvector(v, bf16x2_t); return __builtin_bit_cast(unsigned, r); }
DEVI u16 f2bf(float x) { return (u16)(cvtpk(x, 0.f) & 0xffffu); }
DEVI float bf2f(u16 x) { return __uint_as_float(((unsigned)x) << 16); }
DEVI float bflo(unsigned w) { return __uint_as_float(w << 16); }
DEVI float bfhi(unsigned w) { return __uint_as_float(w & 0xffff0000u); }
DEVI int tid_w(int wave_u) { int l; asm volatile("v_mbcnt_lo_u32_b32 %0, -1, 0\n\tv_mbcnt_hi_u32_b32 %0, -1, %0" : "=v"(l)); return (wave_u << 6) | l; }
#define tid_l() tid_w(p.wave_u)
template <int K> DEVI float shx(float v) {
  static_assert(K == 1 || K == 2 || K == 4 || K == 8 || K == 16, "shx");
  if constexpr (K == 1) return __uint_as_float(__builtin_amdgcn_update_dpp(0, __float_as_uint(v), 0xB1, 0xF, 0xF, true));
  else if constexpr (K == 2) return __uint_as_float(__builtin_amdgcn_update_dpp(0, __float_as_uint(v), 0x4E, 0xF, 0xF, true));
  else return __int_as_float(__builtin_amdgcn_ds_swizzle(__float_as_int(v), (K << 10) | 0x1F));
}
DEVI float sum32(float v) { auto r = __builtin_amdgcn_permlane32_swap(__float_as_uint(v), __float_as_uint(v), false, false); return __uint_as_float(r[0]) + __uint_as_float(r[1]); }
DEVI float max32(float v) { auto r = __builtin_amdgcn_permlane32_swap(__float_as_uint(v), __float_as_uint(v), false, false); return fmaxf(__uint_as_float(r[0]), __uint_as_float(r[1])); }
DEVI float bperm(float v, int src_lane) { return __int_as_float(__builtin_amdgcn_ds_bpermute(src_lane << 2, __float_as_int(v))); }
DEVI float wave_sum(float v) {
  v += shx<1>(v); v += shx<2>(v); v += shx<4>(v); v += shx<8>(v); v += shx<16>(v);
  return sum32(v);
}

DEVI void transpose_tile(const Params& p, const float* __restrict__ src, const float* __restrict__ kgain, int K, int N, u16* __restrict__ dst, int tile, float* lds) {
  const int ntk = K / 64;
  const int tk = tile % ntk, tn = tile / ntk;
  const int k0 = tk * 64, n0 = tn * 64;
  const int tid = tid_l();
  __syncthreads();
#pragma unroll
  for (int i = 0; i < 8; ++i) {
    int e = tid + i * NTHR; int kk = e >> 6, nn = e & 63;
    float v = (n0 + nn < N) ? src[(size_t)(k0 + kk) * N + n0 + nn] : 0.f;
    lds[kk * 65 + nn] = v;
  }
  __syncthreads();
#pragma unroll
  for (int i = 0; i < 8; ++i) {
    int e = tid + i * NTHR; int nn = e >> 6, kk = e & 63;
    dst[(size_t)(n0 + nn) * K + k0 + kk] = f2bf(lds[kk * 65 + nn] * (kgain ? kgain[k0 + kk] : 1.f));
  }
}

DEVI void ph_prologue(const Params& p, char* smem) {
  float* lds = (float*)smem;
  const int G = gridDim.x, b = blockIdx.x, tid = tid_l();
#define TJOB(srcp, K_, N_, NP_, OFF_, KG_) do { const int nt_ = ((K_) / 64) * ((NP_) / 64); \
    _Pragma("unroll 1") for (int t = b; t < nt_; t += G) transpose_tile(p, srcp, KG_, K_, N_, (u16*)(p.ws + (OFF_)), t, lds); } while (0)
  TJOB(p.in[3],  2048, 8192, 8192, WS_WT_EVIN, (const float*)nullptr);
  TJOB(p.in[9],  2048, 2048, 2048, WS_WT_EVOUT, (const float*)nullptr);
  TJOB(p.in[11], 2048, ODD_IN, ODD_IN_PAD, WS_WT_ODIN, p.in[10]);
  TJOB(p.in[14], 768,  3072, 3072, WS_WT_UQ, (const float*)nullptr);
  TJOB(p.in[15], 512,  4096, 4096, WS_WT_UKV, (const float*)nullptr);
  TJOB(p.in[18], 2048, 2048, 2048, WS_WT_ODOUT, (const float*)nullptr);
#undef TJOB
  __syncthreads();
  {
    float* sk = lds;
    float* wq = lds + 128 * 129;
#pragma unroll 1
    for (int job = b; job < 2 * 16 * 32; job += G) {
      const int l = job / 512, hp = (job / 32) % 16, kt = job % 32, k0 = kt * 64;
      const float* SK = p.in[21] + ((size_t)(l * 16 + hp) * 128) * 128;
      const float* WQ = p.in[20] + (size_t)l * 2048 * 2048;
      __syncthreads();
      for (int e = tid; e < 128 * 128; e += NTHR) sk[(e >> 7) * 129 + (e & 127)] = SK[e];
      for (int e = tid; e < 64 * 128; e += NTHR) { int kk = e >> 7, d = e & 127; wq[kk * 129 + d] = WQ[(size_t)(k0 + kk) * 2048 + hp * 128 + d]; }
      __syncthreads();
      const int kk = tid & 63, ng = tid >> 6;
      const float gk = p.in[19][l * DM + k0 + kk];
      float acc[16];
#pragma unroll
      for (int i = 0; i < 16; ++i) acc[i] = 0.f;
#pragma unroll 4
      for (int d = 0; d < 128; ++d) {
        const float w = wq[kk * 129 + d];
#pragma unroll
        for (int i = 0; i < 16; ++i) acc[i] += sk[(ng * 16 + i) * 129 + d] * w;
      }
      u16* dst = (u16*)(p.ws + WS_WEFF) + (size_t)l * 2048 * 2048;
#pragma unroll
      for (int i = 0; i < 16; ++i) dst[(size_t)(hp * 128 + ng * 16 + i) * 2048 + k0 + kk] = f2bf(acc[i] * gk);
    }
  }
  {
    float* rc = (float*)(p.ws + WS_ROPE);
    for (int e = b * NTHR + tid; e < 16384 * 32; e += G * NTHR) {
      const int pos = e >> 5, i = e & 31;
      const float inv = 1.0f / powf(10000.f, (float)(2 * i) / 64.f);
      const float ang = (float)pos * inv;
      float s, c; sincosf(ang, &s, &c);
      rc[e] = c; rc[16384 * 32 + e] = s;
    }
  }
}

constexpr float U_SCALE = 90.f, V_SCALE = 22.5f;
constexpr int EROW = 1536, UROW = 1024;
using f32x16v = __attribute__((ext_vector_type(16))) float;
using f32x32v = __attribute__((ext_vector_type(32))) float;
using u32x6 = __attribute__((ext_vector_type(6))) unsigned;
DEVI void ph_convert_uv(const Params& p) {
  const size_t nitem = (size_t)2 * 2 * 16384 * 64;
#pragma unroll 1
  for (size_t i = (size_t)blockIdx.x * NTHR + tid_l(); i < nitem; i += (size_t)gridDim.x * NTHR) {
    const int l = (int)(i & 63); const size_t row = (i >> 6) & 32767; const bool isu = (i >> 21) == 0;
    const float* src = (isu ? p.in[22] : p.in[23]) + row * 2048 + l * 16;
    const float sc = isu ? U_SCALE : V_SCALE;
    f32x16v a, b;
#pragma unroll
    for (int k = 0; k < 4; ++k) {
      const f32x4 x0 = *(const f32x4*)(src + k * 4), x1 = *(const f32x4*)(src + 1024 + k * 4);
#pragma unroll
      for (int e = 0; e < 4; ++e) { a[k * 4 + e] = x0[e] * sc; b[k * 4 + e] = x1[e] * sc; }
    }
    {
      u32x4 w4;
#pragma unroll
      for (int d = 0; d < 4; ++d) {
        unsigned w = 0u;
        w = __builtin_amdgcn_cvt_scalef32_pk_fp4_f32(w, a[d * 4 + 0], b[d * 4 + 0], 1.0f, 0);
        w = __builtin_amdgcn_cvt_scalef32_pk_fp4_f32(w, a[d * 4 + 1], b[d * 4 + 1], 1.0f, 1);
        w = __builtin_amdgcn_cvt_scalef32_pk_fp4_f32(w, a[d * 4 + 2], b[d * 4 + 2], 1.0f, 2);
        w = __builtin_amdgcn_cvt_scalef32_pk_fp4_f32(w, a[d * 4 + 3], b[d * 4 + 3], 1.0f, 3);
        w4[d] = w;
      }
      *(u32x4*)(p.ws + (isu ? WS_UB : WS_VB) + row * UROW + l * 16) = w4;
    }
  }
}

DEVI void ph_copy_x(const Params& p) {
  const size_t n4 = (size_t)T_ALL * DM / 4, h4 = n4 / 2;
  const f32x4* a = (const f32x4*)p.in[0]; const f32x4* c = (const f32x4*)p.in[1];
  f32x4* o = (f32x4*)p.out;
  for (size_t i = (size_t)blockIdx.x * NTHR + threadIdx.x; i < n4; i += (size_t)gridDim.x * NTHR)
    o[i] = (i < h4) ? a[i] : c[i - h4];
}


constexpr int G_BK = 64, G_HALF = 128, G_HT = G_HALF * G_BK;
DEVI int g_lds_byte(int r, int c) {
  int st = (r >> 4) * 2 + (c >> 5), rr = r & 15, cc = c & 31, ob = rr * 64 + cc * 2;
  return st * 1024 + (ob ^ (((ob >> 9) & 1) << 5));
}
DEVI void g_stage_rc(int b, int& R, int& C) {
  int st = b / 1024, sb = b % 1024, swz = sb ^ (((sb >> 9) & 1) << 5);
  R = (st >> 1) * 16 + swz / 64; C = (st & 1) * 32 + (swz % 64) / 2;
}
enum { EPI_BF16 = 0, EPI_F32 = 1, EPI_RESID = 2, EPI_RESID_B = 3, EPI_BF16_RS = 4, EPI_RES_F2B = 5, EPI_RES_B2B = 6, EPI_TOPK = 7 };
struct GemmEpi { void* out; const float* resid; int ldc; u16* out2; const float* rs; };

DEVI void topk_from_lds(const Params& p, char* tile, int tok0, int head, int* IDX, float* GATE, char* smem);
template <int EPI>
DEVI void gemm_tile(const Params& p, const u16* __restrict__ A, const u16* __restrict__ Bt, const int K, const int brow, const int bcol, const GemmEpi ep, char* smem) {
  u16* shm = (u16*)smem;
#define SA(b,h) (shm+((b)*2+(h))*G_HT)
#define SB(b,h) (shm+(4+(b)*2+(h))*G_HT)
#define STAGE_X(T,P,BASE,br,kt) do{long _g=(long)(br)*K+(long)(kt)*G_BK; \
    for(int _i=0;_i<2;++_i){int _b=(T)*16+_i*8192;int _r,_c;g_stage_rc(_b,_r,_c); \
      __builtin_amdgcn_global_load_lds((const unsigned*)(BASE+_g+(long)_r*K+_c), \
        (LAS unsigned*)((char*)(P)+_b),16,0,0);}}while(0)
#define STAGE(P,BASE,br,kt) STAGE_X(tid0,P,BASE,br,kt)
#define LDA(dst,b,h) for(int m=0;m<4;++m)for(int k=0;k<2;++k) \
    dst[m][k]=*reinterpret_cast<const bf16x8*>((char*)SA(b,h)+g_lds_byte(wr*64+m*16+fr,k*32+fq*8))
#define LDB(dst,b,h) for(int n=0;n<2;++n)for(int k=0;k<2;++k) \
    dst[n][k]=*reinterpret_cast<const bf16x8*>((char*)SB(b,h)+g_lds_byte(wc*32+n*16+fr,k*32+fq*8))
#define MMA(ai,bj,At_,Bt_) do{__builtin_amdgcn_s_setprio(1); \
    for(int m=0;m<4;++m)for(int n=0;n<2;++n)for(int k=0;k<2;++k) \
      acc[ai][bj][m][n]=__builtin_amdgcn_mfma_f32_16x16x32_bf16(Bt_[n][k],At_[m][k],acc[ai][bj][m][n],0,0,0); \
    __builtin_amdgcn_s_setprio(0);}while(0)
#define WAIT_V(n) asm volatile("s_waitcnt vmcnt(" #n ")":::"memory")
#define WAIT_L(n) asm volatile("s_waitcnt lgkmcnt(" #n ")":::"memory")
#define BAR __builtin_amdgcn_s_barrier()
#define SCHED __builtin_amdgcn_sched_barrier(0)
  const int tid0=tid_l();
  int wid=tid0>>6,lane=tid0&63,wr=wid>>2,wc=wid&3,fr=lane&15,fq=lane>>4;
  f32x4 acc[2][2][4][2]={};
  bf16x8 At[4][2],B0[2][2],B1[2][2];
  const int nt=K/G_BK;
  STAGE(SB(0,0),Bt,bcol,0); STAGE(SA(0,0),A,brow,0);
  STAGE(SB(0,1),Bt,bcol+G_HALF,0); STAGE(SA(0,1),A,brow+G_HALF,0);
  if(wr==1)BAR;
  WAIT_V(4); BAR;
  STAGE(SB(1,0),Bt,bcol,1); STAGE(SA(1,0),A,brow,1); STAGE(SB(1,1),Bt,bcol+G_HALF,1);
  WAIT_V(6); BAR;
#pragma unroll 1
  for(int t=0;t<nt-2;t+=2){
    LDB(B0,0,0); SCHED; LDA(At,0,0); STAGE(SA(1,1),A,brow+G_HALF,t+1);
    WAIT_L(8); BAR; WAIT_L(0); MMA(0,0,At,B0); BAR; SCHED;
    LDB(B1,0,1); STAGE(SB(0,0),Bt,bcol,t+2);
    BAR; WAIT_L(0); MMA(0,1,At,B1); BAR;
    LDA(At,0,1); STAGE(SA(0,0),A,brow,t+2);
    BAR; WAIT_L(0); MMA(1,0,At,B0); BAR; SCHED;
    STAGE(SB(0,1),Bt,bcol+G_HALF,t+2);
    WAIT_V(6); BAR; MMA(1,1,At,B1); BAR;
    LDB(B0,1,0); SCHED; LDA(At,1,0); STAGE(SA(0,1),A,brow+G_HALF,t+2);
    WAIT_L(8); BAR; WAIT_L(0); MMA(0,0,At,B0); BAR; SCHED;
    LDB(B1,1,1); STAGE(SB(1,0),Bt,bcol,t+3);
    BAR; WAIT_L(0); MMA(0,1,At,B1); BAR;
    LDA(At,1,1); STAGE(SA(1,0),A,brow,t+3);
    BAR; WAIT_L(0); MMA(1,0,At,B0); BAR; SCHED;
    STAGE(SB(1,1),Bt,bcol+G_HALF,t+3);
    WAIT_V(6); BAR; MMA(1,1,At,B1); BAR;
  }
  int tz=tid_l(); wid=tz>>6; lane=tz&63; wr=wid>>2; wc=wid&3; fr=lane&15; fq=lane>>4;
  { LDB(B0,0,0); WAIT_V(0); LDA(At,0,0); STAGE_X(tz,SA(1,1),A,brow+G_HALF,nt-1);
    BAR; WAIT_L(0); MMA(0,0,At,B0); BAR;
    LDB(B1,0,1); BAR; WAIT_L(0); MMA(0,1,At,B1); BAR;
    LDA(At,0,1); WAIT_V(4); BAR; WAIT_L(0); MMA(1,0,At,B0); MMA(1,1,At,B1); BAR; }
  { LDB(B0,1,0); LDA(At,1,0); WAIT_V(2); BAR; WAIT_L(0); MMA(0,0,At,B0); BAR;
    LDB(B1,1,1); WAIT_V(0); BAR; WAIT_L(0); MMA(0,1,At,B1); BAR;
    LDA(At,1,1); BAR; WAIT_L(0); MMA(1,0,At,B0); MMA(1,1,At,B1); BAR; }
  if(wr==0)BAR;
  if constexpr (EPI==EPI_TOPK) {
#if defined(PROBE_KIND) && PROBE_KIND == 10
    const unsigned long long tp0_ = __builtin_amdgcn_s_memrealtime();
#endif
#pragma unroll
    for(int ai=0;ai<2;++ai){
      __syncthreads();
#pragma unroll
      for(int m=0;m<4;++m){
        const int r=wr*64+m*16+fr;
#pragma unroll
        for(int bj=0;bj<2;++bj)
#pragma unroll
        for(int n=0;n<2;++n){
          const int ch=(bj*G_HALF+wc*32+n*16+fq*4)>>2;
          *(f32x4*)(smem+r*1024+((ch^(r&15))<<4))=acc[ai][bj][m][n];
        }
      }
      __syncthreads();
      topk_from_lds(p,smem,brow+ai*G_HALF,bcol>>8,(int*)ep.out,(float*)ep.out2,smem);
    }
    __syncthreads();
#if defined(PROBE_KIND) && PROBE_KIND == 10
    if (tid_l() == 0) { volatile LAS unsigned long long* a_ = (volatile LAS unsigned long long*)(smem + 131072 + 256); *a_ = *a_ + (__builtin_amdgcn_s_memrealtime() - tp0_); }
#endif
    return;
  }
#pragma unroll
  for(int ai=0;ai<2;++ai)
#pragma unroll
  for(int m=0;m<4;++m){
    const long row=brow+ai*G_HALF+wr*64+m*16+fr;
#pragma unroll
    for(int bj=0;bj<2;++bj)
#pragma unroll
    for(int n=0;n<2;++n){
      const int col=bcol+bj*G_HALF+wc*32+n*16+fq*4;
      const f32x4 v=acc[ai][bj][m][n];
      if constexpr (EPI==EPI_BF16) {
        u32x2 w={cvtpk(v[0],v[1]),cvtpk(v[2],v[3])};
        *(u32x2*)((u16*)ep.out+row*ep.ldc+col)=w;
      } else if constexpr (EPI==EPI_BF16_RS) {
        const float sc=ep.rs[row];
        u32x2 w={cvtpk(v[0]*sc,v[1]*sc),cvtpk(v[2]*sc,v[3]*sc)};
        *(u32x2*)((u16*)ep.out+row*ep.ldc+col)=w;
      } else if constexpr (EPI==EPI_RESID_B) {
        const f32x4 r=*(const f32x4*)(ep.resid+row*ep.ldc+col);
        const f32x4 y=r+v;
        *(f32x4*)((float*)ep.out+row*ep.ldc+col)=y;
        u32x2 w={cvtpk(y[0],y[1]),cvtpk(y[2],y[3])};
        *(u32x2*)(ep.out2+row*ep.ldc+col)=w;
      } else if constexpr (EPI==EPI_RES_F2B) {
        const f32x4 r=*(const f32x4*)(ep.resid+row*ep.ldc+col);
        const f32x4 y=r+v;
        *(u32x2*)(ep.out2+row*ep.ldc+col)=(u32x2){cvtpk(y[0],y[1]),cvtpk(y[2],y[3])};
      } else if constexpr (EPI==EPI_RES_B2B) {
        const u32x2 rb=*(const u32x2*)(ep.out2+row*ep.ldc+col);
        *(u32x2*)(ep.out2+row*ep.ldc+col)=(u32x2){cvtpk(bflo(rb[0])+v[0],bfhi(rb[0])+v[1]),cvtpk(bflo(rb[1])+v[2],bfhi(rb[1])+v[3])};
      } else if constexpr (EPI==EPI_F32) {
        *(f32x4*)((float*)ep.out+row*ep.ldc+col)=v;
      } else {
        const f32x4 r=*(const f32x4*)(ep.resid+row*ep.ldc+col);
        *(f32x4*)((float*)ep.out+row*ep.ldc+col)=r+v;
      }
    }
  }
#undef SA
#undef SB
#undef STAGE_X
#undef STAGE
#undef LDA
#undef LDB
#undef MMA
#undef BAR
#undef SCHED
}
DEVI void g_tile_map(int t, int nM, int nN, int& pm, int& pn) {
  const int nwg = nM * nN;
  int wgid = t;
  { int q = nwg / 8, r = nwg % 8, xcd = wgid % 8, off = wgid / 8;
    wgid = (xcd < r ? xcd * (q + 1) : r * (q + 1) + (xcd - r) * q) + off; }
  const int WGM = 8;
  int nig = WGM * nN, gid = wgid / nig, fm = gid * WGM, gsz = min(nM - fm, WGM);
  pm = fm + ((wgid % nig) % gsz); pn = (wgid % nig) / gsz;
}
template <int EPI>
DEVI void ph_gemm(const Params& p, const u16* A, const u16* Bt, int M, int N, int K, GemmEpi ep, char* smem) {
  const int nM = M / 256, nN = N / 256, ntile = nM * nN;
#pragma unroll 1
  for (int t = blockIdx.x; t < ntile; t += gridDim.x) {
    int pm, pn; g_tile_map(t, nM, nN, pm, pn);
    gemm_tile<EPI>(p, A, Bt, K, pm * 256, pn * 256, ep, smem);
  }
}

DEVI int g_perm32(int rho) { const int n = rho >> 4, i = rho & 15; return 8 * (i >> 2) + 4 * n + (i & 3); }
template <int EPI>
DEVI void g_epi_perm(const f32x4 (&acc)[2][2][4][2], const GemmEpi& ep, const int brow, const int bcol, const int wr, const int wc, const int fr, const int fq) {
#pragma unroll
  for (int ai = 0; ai < 2; ++ai)
#pragma unroll
  for (int m = 0; m < 4; ++m) {
    const long row = brow + ai * G_HALF + wr * 64 + m * 16 + fr;
    float sc = 1.f;
    if constexpr (EPI == EPI_BF16_RS) sc = ep.rs[row];
#pragma unroll
    for (int bj = 0; bj < 2; ++bj) {
      const int col = bcol + wc * 64 + bj * 32 + fq * 8;
      f32x4 v0 = acc[ai][bj][m][0], v1 = acc[ai][bj][m][1];
      if constexpr (EPI == EPI_BF16) {
        *(u32x4*)((u16*)ep.out + row * ep.ldc + col) = (u32x4){cvtpk(v0[0], v0[1]), cvtpk(v0[2], v0[3]), cvtpk(v1[0], v1[1]), cvtpk(v1[2], v1[3])};
      } else if constexpr (EPI == EPI_BF16_RS) {
        *(u32x4*)((u16*)ep.out + row * ep.ldc + col) = (u32x4){cvtpk(v0[0] * sc, v0[1] * sc), cvtpk(v0[2] * sc, v0[3] * sc), cvtpk(v1[0] * sc, v1[1] * sc), cvtpk(v1[2] * sc, v1[3] * sc)};
      } else if constexpr (EPI == EPI_RES_F2B) {
        const f32x4 r0 = *(const f32x4*)(ep.resid + row * ep.ldc + col), r1 = *(const f32x4*)(ep.resid + row * ep.ldc + col + 4);
        v0 += r0; v1 += r1;
        *(u32x4*)(ep.out2 + row * ep.ldc + col) = (u32x4){cvtpk(v0[0], v0[1]), cvtpk(v0[2], v0[3]), cvtpk(v1[0], v1[1]), cvtpk(v1[2], v1[3])};
      } else {
        const u32x4 rb = *(const u32x4*)(ep.out2 + row * ep.ldc + col);
        *(u32x4*)(ep.out2 + row * ep.ldc + col) = (u32x4){cvtpk(bflo(rb[0]) + v0[0], bfhi(rb[0]) + v0[1]), cvtpk(bflo(rb[1]) + v0[2], bfhi(rb[1]) + v0[3]),
                                                          cvtpk(bflo(rb[2]) + v1[0], bfhi(rb[2]) + v1[1]), cvtpk(bflo(rb[3]) + v1[2], bfhi(rb[3]) + v1[3])};
      }
    }
    if constexpr (EPI == EPI_RES_F2B || EPI == EPI_RES_B2B) asm volatile("" ::: "memory");
  }
}
template <int EPI>
DEVI void ph_gemm_stream(const Params& p, const u16* __restrict__ A, const u16* __restrict__ Bt, const int M, const int N, const int K, const GemmEpi ep, char* smem) {
  const int nM = M / 256, nN = N / 256, ntile = nM * nN, G = gridDim.x;
  if ((int)blockIdx.x >= ntile) return;
  LAS unsigned char* lds = (LAS unsigned char*)smem;
  const int tid = tid_l(), wid = p.wave_u, lane = tid & 63, wr = wid >> 2, wc = wid & 3, fr = lane & 15, fq = lane >> 4;
  const int nt = K / G_BK;
  constexpr int HTB = G_HT * 2;
  unsigned voffA[2], voffB[2];
#pragma unroll
  for (int i = 0; i < 2; ++i) { int R, C; g_stage_rc(tid * 16 + i * 8192, R, C); const int Rb = (R >> 5) * 64 + g_perm32(R & 31);
    voffA[i] = (unsigned)(R * K + C) * 2u; voffB[i] = (unsigned)(Rb * K + C) * 2u; }
  const size_t kstep = (size_t)(G_BK * 2), hstep = (size_t)G_HALF * K * 2, tstep = 2 * hstep, hstepB = (size_t)32 * K * 2;
  const unsigned ldsw = (unsigned)wid * 1024u;
  const int aoff = g_lds_byte(wr * 64 + fr, fq * 8), boff = g_lds_byte(wc * 32 + fr, fq * 8);
#define QSA(b, h) (((b) * 2 + (h)) * HTB)
#define QSB(b, h) ((4 + (b) * 2 + (h)) * HTB)
#define QSTAGE(bufoff, gbase, voff) do { _Pragma("unroll") for (int _i = 0; _i < 2; ++_i) \
    __builtin_amdgcn_global_load_lds((const unsigned*)((const char*)(gbase) + (voff)[_i]), (LAS unsigned*)(lds + (bufoff) + ldsw + _i * 8192), 16, 0, 0); } while (0)
#define QLDA(dst, b, h) do { _Pragma("unroll") for (int m = 0; m < 4; ++m) _Pragma("unroll") for (int k = 0; k < 2; ++k) dst[m][k] = *(const LAS bf16x8*)(lds + QSA(b, h) + aoff + m * 2048 + k * 1024); } while (0)
#define QLDB(dst, b, h) do { _Pragma("unroll") for (int n = 0; n < 2; ++n) _Pragma("unroll") for (int k = 0; k < 2; ++k) dst[n][k] = *(const LAS bf16x8*)(lds + QSB(b, h) + boff + n * 2048 + k * 1024); } while (0)
#define QMMA(ai, bj, At_, Bt_) do { __builtin_amdgcn_s_setprio(1); _Pragma("unroll") for (int m = 0; m < 4; ++m) _Pragma("unroll") for (int n = 0; n < 2; ++n) _Pragma("unroll") for (int k = 0; k < 2; ++k) \
    acc[ai][bj][m][n] = __builtin_amdgcn_mfma_f32_16x16x32_bf16(Bt_[n][k], At_[m][k], acc[ai][bj][m][n], 0, 0, 0); __builtin_amdgcn_s_setprio(0); } while (0)
#define QWAIT_V(n) asm volatile("s_waitcnt vmcnt(" #n ")" ::: "memory")
#define QWAIT_L(n) asm volatile("s_waitcnt lgkmcnt(" #n ")" ::: "memory")
#define QBAR __builtin_amdgcn_s_barrier()
#define QSCHED __builtin_amdgcn_sched_barrier(0)
  int ui = 0, cpm, cpn, npm = 0, npn = 0;
  g_tile_map(blockIdx.x, nM, nN, cpm, cpn);
  f32x4 acc[2][2][4][2];
#pragma unroll
  for (int a = 0; a < 2; ++a)
#pragma unroll
  for (int b = 0; b < 2; ++b)
#pragma unroll
  for (int m = 0; m < 4; ++m)
#pragma unroll
  for (int n = 0; n < 2; ++n) acc[a][b][m][n] = (f32x4){0.f, 0.f, 0.f, 0.f};
  bf16x8 At[4][2], B0[2][2], B1[2][2];
  const char* cA = (const char*)A + (size_t)cpm * tstep; const char* cB = (const char*)Bt + (size_t)cpn * tstep;
  __syncthreads();
  QSTAGE(QSB(0, 0), cB, voffB); QSTAGE(QSA(0, 0), cA, voffA); QSTAGE(QSB(0, 1), cB + hstepB, voffB); QSTAGE(QSA(0, 1), cA + hstep, voffA);
  if (wr == 1) QBAR;
  QWAIT_V(4); QBAR;
  QSTAGE(QSB(1, 0), cB + kstep, voffB); QSTAGE(QSA(1, 0), cA + kstep, voffA); QSTAGE(QSB(1, 1), cB + hstepB + kstep, voffB);
  QWAIT_V(6); QBAR;
#pragma unroll 1
  for (;;) {
    const int tn = (int)blockIdx.x + (ui + 1) * G;
    const bool has_next = tn < ntile;
    if (has_next) g_tile_map(tn, nM, nN, npm, npn);
    const char* nA = has_next ? (const char*)A + (size_t)npm * tstep : cA; const char* nB = has_next ? (const char*)Bt + (size_t)npn * tstep : cB;
#pragma unroll 1
    for (int t = 0; t < nt; t += 2) {
      const bool last = (t == nt - 2);
      const char* a1 = cA + (size_t)(t + 1) * kstep;
      const char* a2 = last ? nA : cA + (size_t)(t + 2) * kstep; const char* b2 = last ? nB : cB + (size_t)(t + 2) * kstep;
      const char* a3 = a2 + kstep; const char* b3 = b2 + kstep;
      QLDB(B0, 0, 0); QSCHED; QLDA(At, 0, 0); QSTAGE(QSA(1, 1), a1 + hstep, voffA);
      QWAIT_L(8); QBAR; QWAIT_L(0); QMMA(0, 0, At, B0); QBAR; QSCHED;
      QLDB(B1, 0, 1); QSTAGE(QSB(0, 0), b2, voffB);
      QBAR; QWAIT_L(0); QMMA(0, 1, At, B1); QBAR;
      QLDA(At, 0, 1); QSTAGE(QSA(0, 0), a2, voffA);
      QBAR; QWAIT_L(0); QMMA(1, 0, At, B0); QBAR; QSCHED;
      QSTAGE(QSB(0, 1), b2 + hstepB, voffB);
      QWAIT_V(6); QBAR; QMMA(1, 1, At, B1); QBAR;
      QLDB(B0, 1, 0); QSCHED; QLDA(At, 1, 0); QSTAGE(QSA(0, 1), a2 + hstep, voffA);
      QWAIT_L(8); QBAR; QWAIT_L(0); QMMA(0, 0, At, B0); QBAR; QSCHED;
      QLDB(B1, 1, 1); QSTAGE(QSB(1, 0), b3, voffB);
      QBAR; QWAIT_L(0); QMMA(0, 1, At, B1); QBAR;
      QLDA(At, 1, 1); QSTAGE(QSA(1, 0), a3, voffA);
      QBAR; QWAIT_L(0); QMMA(1, 0, At, B0); QBAR; QSCHED;
      QSTAGE(QSB(1, 1), b3 + hstepB, voffB);
      QWAIT_V(6); QBAR; QMMA(1, 1, At, B1); QBAR;
    }
    g_epi_perm<EPI>(acc, ep, cpm * 256, cpn * 256, wr, wc, fr, fq);
    if (!has_next) break;
#pragma unroll
    for (int a = 0; a < 2; ++a)
#pragma unroll
    for (int b = 0; b < 2; ++b)
#pragma unroll
    for (int m = 0; m < 4; ++m)
#pragma unroll
    for (int n = 0; n < 2; ++n) acc[a][b][m][n] = (f32x4){0.f, 0.f, 0.f, 0.f};
    cpm = npm; cpn = npn; cA = nA; cB = nB; ++ui;
  }
  QWAIT_V(0);
  if (wr == 0) QBAR;
  QBAR;
#undef QSA
#undef QSB
#undef QSTAGE
#undef QLDA
#undef QLDB
#undef QMMA
#undef QWAIT_V
#undef QWAIT_L
#undef QBAR
#undef QSCHED
}

DEVI void ph_norm(const Params& p, const float* __restrict__ x, const float* __restrict__ gain, u16* __restrict__ out, int nrows) {
  const int tid = tid_l(); const int lane = tid & 63, gw = blockIdx.x * 8 + (tid >> 6), nw = gridDim.x * 8;
  f32x4 g[8];
#pragma unroll
  for (int c = 0; c < 8; ++c) g[c] = *(const f32x4*)(gain + c * 256 + lane * 4);
  f32x4 v[8], vn[8];
  if (gw < nrows) {
#pragma unroll
    for (int c = 0; c < 8; ++c) v[c] = *(const f32x4*)(x + (size_t)gw * DM + c * 256 + lane * 4);
  }
#pragma unroll 1
  for (int r = gw; r < nrows; r += nw) {
    if (r + nw < nrows) {
#pragma unroll
      for (int c = 0; c < 8; ++c) vn[c] = *(const f32x4*)(x + (size_t)(r + nw) * DM + c * 256 + lane * 4);
    }
    float ss = 0.f;
#pragma unroll
    for (int c = 0; c < 8; ++c) ss += v[c][0]*v[c][0] + v[c][1]*v[c][1] + v[c][2]*v[c][2] + v[c][3]*v[c][3];
    ss = wave_sum(ss);
    const float rstd = rsqrtf(ss * (1.f / DM) + EPS);
#pragma unroll
    for (int c = 0; c < 8; ++c) {
      u32x2 w = {cvtpk(v[c][0] * rstd * g[c][0], v[c][1] * rstd * g[c][1]), cvtpk(v[c][2] * rstd * g[c][2], v[c][3] * rstd * g[c][3])};
      *(u32x2*)(out + (size_t)r * DM + c * 256 + lane * 4) = w;
    }
#pragma unroll
    for (int c = 0; c < 8; ++c) v[c] = vn[c];
  }
}

DEVI const float* xin_mb(const Params& p, int mb) { return (mb < 2 ? p.in[0] : p.in[1]) + (size_t)(mb & 1) * MBT * DM; }
DEVI float frcp(float x) { return __builtin_amdgcn_rcpf(x); }
DEVI float sigmoidf_(float x) { return frcp(1.f + __expf(-x)); }

DEVI void l0_post_item(u32x4 w, int seg, int ch, const float* qg, const float* kg, const float* lbl, u32x4& o) {
  float v[8];
#pragma unroll
  for (int j = 0; j < 4; ++j) { v[2*j] = bflo(w[j]); v[2*j+1] = bfhi(w[j]); }
  if (seg <= 1) {
    float ss = 0.f;
#pragma unroll
    for (int j = 0; j < 8; ++j) ss += v[j] * v[j];
    ss += shx<1>(ss); ss += shx<2>(ss); ss += shx<4>(ss); ss += shx<8>(ss);
    const float rstd = rsqrtf(ss * (1.f / 128.f) + EPS);
    const float* g = (seg == 0 ? qg : kg) + (ch & 15) * 8;
#pragma unroll
    for (int j = 0; j < 8; ++j) v[j] = v[j] * rstd * g[j];
  } else if (seg == 3 || seg == 7) {
#pragma unroll
    for (int j = 0; j < 8; ++j) v[j] = v[j] * sigmoidf_(v[j]);
  } else {
    const int dir = seg - 4; const int k0 = (ch & 127) * 8;
#pragma unroll
    for (int j = 0; j < 8; ++j) {
      const float l0 = lbl[(dir * 2 + 0) * 1024 + k0 + j], l1 = lbl[(dir * 2 + 1) * 1024 + k0 + j];
      const float lb = 1.f / (1.f + __expf(l1 - l0));
      const float f = lb + (1.f - lb) * (1.f / (1.f + __expf(-v[j])));
      v[j] = __logf(f);
    }
  }
  o = (u32x4){cvtpk(v[0], v[1]), cvtpk(v[2], v[3]), cvtpk(v[4], v[5]), cvtpk(v[6], v[7])};
}
DEVI void ph_l0_post(const Params& p) {
  u16* P = (u16*)(p.ws + WS_P);
  const float* qg = p.in[4]; const float* kg = p.in[5]; const float* lbl = p.in[7];
  const size_t total = (size_t)MBT * 768, gs = (size_t)gridDim.x * NTHR;
#pragma unroll 1
  for (size_t it0 = (size_t)blockIdx.x * NTHR + tid_l(); it0 < total; it0 += 4 * gs) {
    u32x4 w[4]; u16* ptr[4]; int seg[4], ch[4]; bool ok[4];
#pragma unroll
    for (int j = 0; j < 4; ++j) {
      const size_t it = it0 + j * gs; ok[j] = it < total;
      const unsigned tok = (unsigned)it / 768u; const int r = (int)((unsigned)it - tok * 768u); const int s6 = r >> 7; ch[j] = r & 127;
      seg[j] = s6 + (s6 >= 2) + (s6 >= 5);
      ptr[j] = P + (size_t)tok * 8192 + seg[j] * 1024 + ch[j] * 8;
      if (ok[j]) w[j] = *(const u32x4*)ptr[j];
    }
#pragma unroll
    for (int j = 0; j < 4; ++j) if (ok[j]) { u32x4 o; l0_post_item(w[j], seg[j], ch[j], qg, kg, lbl, o); *(u32x4*)ptr[j] = o; }
  }
}

template <int OFF> DEVI s16x4 tr_read(int vb) {
  return __builtin_amdgcn_ds_read_tr16_b64_v4i16((LAS s16x4*)(unsigned)(vb + OFF));
}
template <int OFF> DEVI s16x4 tr_read_asm(int vb) {
  s16x4 r; asm volatile("ds_read_b64_tr_b16 %0, %1 offset:%2" : "=&v"(r) : "v"(vb), "i"(OFF) : "memory"); return r;
}
template <int OFF0, int OFF1> DEVI bf16x8 tr_read2w(int vb) {
  const s16x4 a = tr_read<OFF0>(vb), b = tr_read<OFF1>(vb);
  return (bf16x8){a[0], a[1], a[2], a[3], b[0], b[1], b[2], b[3]};
}
DEVI bf16x8 pk44(s16x4 l, s16x4 h) { return (bf16x8){l[0], l[1], l[2], l[3], h[0], h[1], h[2], h[3]}; }

DEVI void ph_na(const Params& p, int mb, char* smem) {
  const u16* P = (const u16*)(p.ws + WS_P);
  u16* MIX = (u16*)(p.ws + WS_MIX);
  const float* rpb = p.in[6];
  const int S = (mb < 2) ? 2048 : 16384; const int rows = S / 64;
  const int nunits = (MBT / 64) * 4;
#pragma unroll 1
  for (int u = blockIdx.x; u < nunits; u += gridDim.x) {
    const int tid = tid_l(), wid = tid >> 6, lane = tid & 63, fr = lane & 15, fq = lane >> 4;
    char* vl = smem + wid * 9216;
    const int vlb = (int)(uintptr_t)vl + (fq * 4 + (fr >> 2)) * 288 + (fr & 3) * 8;
    const int hp = u & 3, rowg = u >> 2;
    const int j = wid & 3, h = hp * 2 + (wid >> 2);
    const int seqrow0 = (rowg / rows) * rows;
    const int r = rowg - seqrow0;
    const int r0 = min(max(r - 4, 0), rows - 8);
    const int kc0 = min(max(j * 16 - 8, 0), 32);
    const size_t qtok = (size_t)rowg * 64 + j * 16 + fr;
    bf16x8 kbuf[3][2][4];
#define NA_KLOAD(b_, w_) do { _Pragma("unroll") for (int c2_ = 0; c2_ < 2; ++c2_) { \
      const u16* kp_ = P + ((size_t)(seqrow0 + r0 + (w_)) * 64 + kc0 + c2_ * 16 + fr) * 8192 + 1024 + h * 128 + fq * 8; \
      _Pragma("unroll") for (int ks_ = 0; ks_ < 4; ++ks_) kbuf[b_][c2_][ks_] = *(const bf16x8*)(kp_ + ks_ * 32); } } while (0)
    NA_KLOAD(0, 0); NA_KLOAD(1, 1);
    bf16x8 qf[4];
    {
      u32x4 qw[4]; float ssq = 0.f;
#pragma unroll
      for (int ks = 0; ks < 4; ++ks) { qw[ks] = *(const u32x4*)(P + qtok * 8192 + h * 128 + ks * 32 + fq * 8);
#pragma unroll
        for (int e = 0; e < 4; ++e) { const float a = bflo(qw[ks][e]), b = bfhi(qw[ks][e]); ssq += a * a + b * b; } }
      ssq += shx<16>(ssq); ssq = sum32(ssq);
      const float rq = rsqrtf(ssq * (1.f / 128.f) + EPS);
#pragma unroll
      for (int ks = 0; ks < 4; ++ks) {
        const float* gq = p.in[4] + ks * 32 + fq * 8; const float* gk = p.in[5] + ks * 32 + fq * 8;
        u32x4 o;
#pragma unroll
        for (int e = 0; e < 4; ++e) o[e] = cvtpk(bflo(qw[ks][e]) * rq * gq[2 * e] * gk[2 * e], bfhi(qw[ks][e]) * rq * gq[2 * e + 1] * gk[2 * e + 1]);
        qf[ks] = *reinterpret_cast<bf16x8*>(&o);
      }
    }
    f32x4 sacc[16];
#pragma unroll
    for (int i = 0; i < 16; ++i) sacc[i] = (f32x4){0.f, 0.f, 0.f, 0.f};
#pragma unroll
    for (int w = 0; w < 8; ++w) {
      if (w + 2 < 8) NA_KLOAD((w + 2) % 3, w + 2);
      __builtin_amdgcn_sched_barrier(0);
#pragma unroll
      for (int c2 = 0; c2 < 2; ++c2) {
        float ssk = 0.f;
#pragma unroll
        for (int ks = 0; ks < 4; ++ks) {
          const bf16x8 a = kbuf[w % 3][c2][ks];
          sacc[w * 2 + c2] = __builtin_amdgcn_mfma_f32_16x16x32_bf16(a, qf[ks], sacc[w * 2 + c2], 0, 0, 0);
          const u32x4 aw = *reinterpret_cast<const u32x4*>(&a);
#pragma unroll
          for (int e = 0; e < 4; ++e) { const float x = bflo(aw[e]), y = bfhi(aw[e]); ssk += x * x + y * y; }
        }
        ssk += shx<16>(ssk); ssk = sum32(ssk);
        const float rk = rsqrtf(ssk * (1.f / 128.f) + EPS);
#pragma unroll
        for (int e = 0; e < 4; ++e) sacc[w * 2 + c2][e] *= bperm(rk, fq * 4 + e);
        asm volatile("" : "+v"(sacc[w * 2 + c2]));
        if (c2 == 1) __builtin_amdgcn_sched_barrier(0);
      }
    }
#undef NA_KLOAD
    u32x4 vreg[2][8];
#define NA_VLOAD(b_, w_) do { const size_t vt0_ = (size_t)(seqrow0 + r0 + (w_)) * 64 + kc0; _Pragma("unroll") for (int i = 0; i < 8; ++i) { \
      const int q_ = i * 64 + lane; vreg[b_][i] = *(const u32x4*)(P + (vt0_ + (q_ >> 4)) * 8192 + 2048 + h * 128 + (q_ & 15) * 8); } } while (0)
    NA_VLOAD(0, 0); NA_VLOAD(1, 1);
    const float scale = 0.08838834764831845f;
    const int qcol = j * 16 + fr; const int qc0 = min(max(qcol - 8, 0), 48);
    float mx = -1e30f;
#pragma unroll
    for (int w = 0; w < 8; ++w) {
      const int dr = r0 + w - r + 7;
      const float* brow = rpb + (h * 15 + dr) * 31;
#pragma unroll
      for (int c2 = 0; c2 < 2; ++c2)
#pragma unroll
        for (int e = 0; e < 4; ++e) {
          const int kcol = kc0 + c2 * 16 + fq * 4 + e;
          const bool valid = (kcol >= qc0) && (kcol < qc0 + 16);
          const int dcol = min(max(kcol - qcol + 15, 0), 30);
          const float sv = valid ? sacc[w * 2 + c2][e] * scale + brow[dcol] : -1e30f;
          sacc[w * 2 + c2][e] = sv; mx = fmaxf(mx, sv);
        }
    }
    mx = fmaxf(mx, shx<16>(mx)); mx = max32(mx);
    float sum = 0.f;
#pragma unroll
    for (int i = 0; i < 16; ++i)
#pragma unroll
      for (int e = 0; e < 4; ++e) { const float sv = sacc[i][e]; const float pe = (sv > -1e29f) ? __expf(sv - mx) : 0.f; sacc[i][e] = pe; sum += pe; }
    sum += shx<16>(sum); sum = sum32(sum);
    const float inv = frcp(sum);
    bf16x8 paw[8];
#pragma unroll
    for (int w = 0; w < 8; ++w) {
      const f32x4 a0 = sacc[w * 2], a1 = sacc[w * 2 + 1];
      u32x4 pw = {cvtpk(a0[0] * inv, a0[1] * inv), cvtpk(a0[2] * inv, a0[3] * inv), cvtpk(a1[0] * inv, a1[1] * inv), cvtpk(a1[2] * inv, a1[3] * inv)};
      paw[w] = *reinterpret_cast<bf16x8*>(&pw);
    }
    f32x4 oacc[8];
#pragma unroll
    for (int c = 0; c < 8; ++c) oacc[c] = (f32x4){0.f, 0.f, 0.f, 0.f};
#pragma unroll
    for (int w = 0; w < 8; ++w) {
      __builtin_amdgcn_sched_barrier(0);
#pragma unroll
      for (int i = 0; i < 8; ++i) { const int q = i * 64 + lane; *(u32x4*)(vl + (q >> 4) * 288 + (q & 15) * 16) = vreg[w & 1][i]; }
      if (w + 2 < 8) NA_VLOAD(w & 1, w + 2);
      asm volatile("s_waitcnt lgkmcnt(0)" ::: "memory"); __builtin_amdgcn_sched_barrier(0);
      const bf16x8 pa = paw[w];
#define NA_PV(c) do { const bf16x8 bt_ = tr_read2w<(c) * 32, (c) * 32 + 16 * 288>(vlb); __builtin_amdgcn_sched_barrier(0); \
        oacc[c] = __builtin_amdgcn_mfma_f32_16x16x32_bf16(pa, bt_, oacc[c], 0, 0, 0); } while (0)
      NA_PV(0); NA_PV(1); NA_PV(2); NA_PV(3); NA_PV(4); NA_PV(5); NA_PV(6); NA_PV(7);
#undef NA_PV
      asm volatile("" : "+v"(oacc[0]), "+v"(oacc[1]), "+v"(oacc[2]), "+v"(oacc[3]), "+v"(oacc[4]), "+v"(oacc[5]), "+v"(oacc[6]), "+v"(oacc[7]));
    }
#pragma unroll
    for (int c = 0; c < 8; ++c)
#pragma unroll
      for (int e = 0; e < 4; ++e)
        MIX[((size_t)rowg * 64 + j * 16 + fq * 4 + e) * 2048 + h * 128 + c * 16 + fr] = f2bf(oacc[c][e]);
  }
}

constexpr int HS = 1024, HNSEG = MBT / HS, HROW = 288;
template <bool OUT>
DEVI void ph_hgrn_pass(const Params& p, int mb, char* smem) {
  const u16* P = (const u16*)(p.ws + WS_P);
  float* E = (float*)(p.ws + WS_E); float* DEC = (float*)(p.ws + WS_DEC); u16* OFB = (u16*)(p.ws + WS_OFB);
  const int tid = tid_l(), wid = tid >> 6, lane = tid & 63, fr = lane & 15, fq = lane >> 4;
  const int pk = wid * 16 + fr;
  constexpr int HSET = 28672;
  const int vvb_0  = (int)(uintptr_t)(smem + 18432) + (fq * 4 + (fr >> 2)) * HROW + (wid * 16 + (fr & 3) * 4) * 2;
  const int vvb2_0 = (int)(uintptr_t)(smem + 18432) + (fq * 8 + (fr >> 2)) * HROW + (wid * 16 + (fr & 3) * 4) * 2;
  const int kdb_0  = (int)(uintptr_t)(smem + 9216) + (fq * 8 + (fr >> 2)) * HROW + ((fr & 3) * 4) * 2;
#pragma unroll 1
  for (int chain = blockIdx.x; chain < HNSEG * 16; chain += gridDim.x) {
    const int seg = chain >> 4, hd = chain & 15, h = hd >> 1, dir = hd & 1;
    const size_t tok0 = (size_t)seg * HS;
    float* Eb = E + (size_t)(seg * 16 + hd) * 16384 + wid * 16 + fr;
    f32x4 S[8];
#pragma unroll
    for (int kt = 0; kt < 8; ++kt)
#pragma unroll
      for (int r = 0; r < 4; ++r) S[kt][r] = OUT ? Eb[(kt * 16 + fq * 4 + r) * 128] : 0.f;
    __syncthreads();
    float lsum = 0.f;
    const float* lbl = p.in[7];
    const float lbv = 1.f / (1.f + __expf(lbl[(dir * 2 + 1) * 1024 + h * 128 + pk] - lbl[(dir * 2 + 0) * 1024 + h * 128 + pk]));
    u16 rl[8], rq[8]; u32x4 rv;
#define H_LOADRAW(c) do { _Pragma("unroll") for (int i = 0; i < 8; ++i) { const int tg = (c) * 32 + fq * 8 + i; \
      const u16* pr = P + (tok0 + (dir ? HS - 1 - tg : tg)) * 8192 + h * 128 + pk; rl[i] = pr[4096 + dir * 1024]; if (OUT) rq[i] = pr[3072]; } \
      { const int tg = (c) * 32 + (tid >> 4); rv = *(const u32x4*)(P + (tok0 + (dir ? HS - 1 - tg : tg)) * 8192 + 6144 + h * 128 + (tid & 15) * 8); } } while (0)
    H_LOADRAW(0);
    auto H_PRE = [&](const int c) {
      char* const sb = smem + (c & 1) * HSET; char* QD = sb; char* KD = sb + 9216; char* VV = sb + 18432; float* EB = (float*)(sb + 27648);
      float kkv[8], bl[8]; float cs = 0.f;
#pragma unroll
      for (int i = 0; i < 8; ++i) {
        const float ez = __expf(-bf2f(rl[i])); const float sg = frcp(1.f + ez);
        kkv[i] = (1.f - lbv) * ez * sg;
        cs += __log2f(lbv + (1.f - lbv) * sg); bl[i] = cs;
      }
      const float t0 = bperm(cs, fr), t1 = bperm(cs, fr + 16), t2 = bperm(cs, fr + 32), t3 = bperm(cs, fr + 48);
      const float off = (fq > 0 ? t0 : 0.f) + (fq > 1 ? t1 : 0.f) + (fq > 2 ? t2 : 0.f);
      const float btot = t0 + t1 + t2 + t3;
      lsum += btot;
#pragma unroll
      for (int i = 0; i < 8; ++i) {
        const int tau = fq * 8 + i; const float bb = off + bl[i];
        *(u16*)(KD + tau * HROW + pk * 2) = f2bf(kkv[i] * __builtin_amdgcn_exp2f(fminf(-bb, 100.f)));
        if (OUT) { const float zq = bf2f(rq[i]); *(u16*)(QD + tau * HROW + pk * 2) = f2bf(zq * frcp(1.f + __expf(-zq)) * __builtin_amdgcn_exp2f(bb)); }
      }
      if (fq == 0) EB[pk] = __builtin_amdgcn_exp2f(btot);
      *(u32x4*)(VV + (tid >> 4) * HROW + (tid & 15) * 16) = rv;
      if (c + 1 < HS / 32) H_LOADRAW(c + 1);
    };
    H_PRE(0);
#pragma unroll 1
    for (int c = 0; c < HS / 32; ++c) {
      char* const sb = smem + (c & 1) * HSET; char* QD = sb; char* KD = sb + 9216; float* EB = (float*)(sb + 27648);
      const int vvb = vvb_0 + (c & 1) * HSET, vvb2 = vvb2_0 + (c & 1) * HSET, kdb = kdb_0 + (c & 1) * HSET;
      __syncthreads();
      if (OUT) {
        f32x4 at00 = {0.f, 0.f, 0.f, 0.f}, at01 = at00, at11 = at00;
#pragma unroll
        for (int ks = 0; ks < 4; ++ks) {
          const bf16x8 k0 = *(const bf16x8*)(KD + fr * HROW + ks * 64 + fq * 16), k1 = *(const bf16x8*)(KD + (16 + fr) * HROW + ks * 64 + fq * 16);
          const bf16x8 q0 = *(const bf16x8*)(QD + fr * HROW + ks * 64 + fq * 16), q1 = *(const bf16x8*)(QD + (16 + fr) * HROW + ks * 64 + fq * 16);
          at00 = __builtin_amdgcn_mfma_f32_16x16x32_bf16(k0, q0, at00, 0, 0, 0);
          at01 = __builtin_amdgcn_mfma_f32_16x16x32_bf16(k0, q1, at01, 0, 0, 0);
          at11 = __builtin_amdgcn_mfma_f32_16x16x32_bf16(k1, q1, at11, 0, 0, 0);
        }
#pragma unroll
        for (int r = 0; r < 4; ++r) { const bool keep = (fq * 4 + r) <= fr; at00[r] = keep ? at00[r] : 0.f; at11[r] = keep ? at11[r] : 0.f; }
        u32x4 w0 = {cvtpk(at00[0], at00[1]), cvtpk(at00[2], at00[3]), 0u, 0u};
        u32x4 w1 = {cvtpk(at01[0], at01[1]), cvtpk(at01[2], at01[3]), cvtpk(at11[0], at11[1]), cvtpk(at11[2], at11[3])};
        const bf16x8 pa0 = *reinterpret_cast<bf16x8*>(&w0), pa1 = *reinterpret_cast<bf16x8*>(&w1);
        const bf16x8 bv = tr_read2w<0, 16 * HROW>(vvb);
        f32x4 o0 = {0.f, 0.f, 0.f, 0.f}, o1 = o0;
        o0 = __builtin_amdgcn_mfma_f32_16x16x32_bf16(pa0, bv, o0, 0, 0, 0);
        o1 = __builtin_amdgcn_mfma_f32_16x16x32_bf16(pa1, bv, o1, 0, 0, 0);
#pragma unroll
        for (int ks = 0; ks < 4; ++ks) {
          const f32x4 sa = S[2 * ks], sb = S[2 * ks + 1];
          u32x4 sw = {cvtpk(sa[0], sa[1]), cvtpk(sa[2], sa[3]), cvtpk(sb[0], sb[1]), cvtpk(sb[2], sb[3])};
          const bf16x8 sop = *reinterpret_cast<bf16x8*>(&sw);
          const char* qa = QD + fr * HROW + (ks * 32 + fq * 4) * 2;
          const u32x2 a0l = *(const u32x2*)(qa), a0h = *(const u32x2*)(qa + 32);
          const u32x2 a1l = *(const u32x2*)(qa + 16 * HROW), a1h = *(const u32x2*)(qa + 16 * HROW + 32);
          u32x4 aw0 = {a0l[0], a0l[1], a0h[0], a0h[1]}, aw1 = {a1l[0], a1l[1], a1h[0], a1h[1]};
          o0 = __builtin_amdgcn_mfma_f32_16x16x32_bf16(*reinterpret_cast<bf16x8*>(&aw0), sop, o0, 0, 0, 0);
          o1 = __builtin_amdgcn_mfma_f32_16x16x32_bf16(*reinterpret_cast<bf16x8*>(&aw1), sop, o1, 0, 0, 0);
        }
#pragma unroll
        for (int r = 0; r < 4; ++r) {
          const int tg0 = c * 32 + fq * 4 + r, tg1 = tg0 + 16;
          OFB[((size_t)dir * MBT + tok0 + (dir ? HS - 1 - tg0 : tg0)) * 1024 + h * 128 + wid * 16 + fr] = f2bf(o0[r]);
          OFB[((size_t)dir * MBT + tok0 + (dir ? HS - 1 - tg1 : tg1)) * 1024 + h * 128 + wid * 16 + fr] = f2bf(o1[r]);
        }
      }
      {
        const bf16x8 vop = tr_read2w<0, 4 * HROW>(vvb2);
#define H_UPD(kt) do { const bf16x8 aop_ = tr_read2w<(kt) * 32, (kt) * 32 + 4 * HROW>(kdb); \
          S[kt] = __builtin_amdgcn_mfma_f32_16x16x32_bf16(aop_, vop, S[kt], 0, 0, 0); } while (0)
        H_UPD(0); H_UPD(1); H_UPD(2); H_UPD(3); H_UPD(4); H_UPD(5); H_UPD(6); H_UPD(7);
#undef H_UPD
#pragma unroll
        for (int kt = 0; kt < 8; ++kt) { const f32x4 e = *(const f32x4*)(EB + kt * 16 + fq * 4); S[kt] *= e; }
      }
      if (c + 1 < HS / 32) H_PRE(c + 1);
    }
#undef H_LOADRAW
    if (!OUT) {
#pragma unroll
      for (int kt = 0; kt < 8; ++kt)
#pragma unroll
        for (int r = 0; r < 4; ++r) Eb[(kt * 16 + fq * 4 + r) * 128] = S[kt][r];
      if (fq == 0) DEC[(seg * 16 + hd) * 128 + pk] = __builtin_amdgcn_exp2f(lsum);
    }
  }
}

DEVI void ph_hgrn_carry(const Params& p, int mb) {
  const int S = (mb < 2) ? 2048 : 16384; const int sps = S / HS;
  float* E = (float*)(p.ws + WS_E); const float* DEC = (const float*)(p.ws + WS_DEC);
#pragma unroll 1
  for (int e = blockIdx.x * NTHR + tid_l(); e < 16 * 16384; e += gridDim.x * NTHR) {
    const int hd = e >> 14, kv = e & 16383, k = kv >> 7, dir = hd & 1;
    float run = 0.f;
#pragma unroll 4
    for (int s = 0; s < HNSEG; ++s) {
      const int seg = dir ? HNSEG - 1 - s : s;
      const bool first = dir ? (((seg + 1) % sps) == 0) : ((seg % sps) == 0);
      if (first) run = 0.f;
      const size_t ix = ((size_t)seg * 16 + hd) * 16384 + kv;
      const float tmp = E[ix]; E[ix] = run; run = DEC[(seg * 16 + hd) * 128 + k] * run + tmp;
    }
  }
}

DEVI void ph_hg_combine(const Params& p) {
  const u16* P = (const u16*)(p.ws + WS_P); const u16* OFB = (const u16*)(p.ws + WS_OFB);
  u16* MIX = (u16*)(p.ws + WS_MIX); const float* og = p.in[8];
#pragma unroll 1
  for (int it = blockIdx.x * NTHR + tid_l(); it < MBT * 128; it += gridDim.x * NTHR) {
    const int tok = it >> 7, ch = it & 127, col = ch * 8;
    const u32x4 aw = *(const u32x4*)(OFB + (size_t)tok * 1024 + col), bw = *(const u32x4*)(OFB + ((size_t)MBT + tok) * 1024 + col);
    float o[8];
#pragma unroll
    for (int j = 0; j < 4; ++j) { o[2 * j] = bflo(aw[j]) + bflo(bw[j]); o[2 * j + 1] = bfhi(aw[j]) + bfhi(bw[j]); }
    float ss = 0.f;
#pragma unroll
    for (int j = 0; j < 8; ++j) ss += o[j] * o[j];
    ss += shx<1>(ss); ss += shx<2>(ss); ss += shx<4>(ss); ss += shx<8>(ss);
    const float rstd = rsqrtf(ss * (1.f / 128.f) + EPS);
    const u32x4 gw = *(const u32x4*)(P + (size_t)tok * 8192 + 7168 + col);
    float g[8];
#pragma unroll
    for (int j = 0; j < 4; ++j) { g[2*j] = bflo(gw[j]); g[2*j+1] = bfhi(gw[j]); }
#pragma unroll
    for (int j = 0; j < 8; ++j) g[j] = g[j] * sigmoidf_(g[j]);
    const float* gn = og + (col & 127);
#pragma unroll
    for (int j = 0; j < 8; ++j) o[j] = o[j] * rstd * gn[j] * g[j];
    u32x4 w = {cvtpk(o[0], o[1]), cvtpk(o[2], o[3]), cvtpk(o[4], o[5]), cvtpk(o[6], o[7])};
    *(u32x4*)(MIX + (size_t)tok * 2048 + 1024 + col) = w;
  }
}


DEVI unsigned fkey(float x) { const unsigned u = __float_as_uint(x); return (u & 0x80000000u) ? ~u : (u | 0x80000000u); }
DEVI unsigned wave_umax(unsigned v) {
  v = max(v, (unsigned)__builtin_amdgcn_update_dpp(0, v, 0xB1, 0xF, 0xF, true));
  v = max(v, (unsigned)__builtin_amdgcn_update_dpp(0, v, 0x4E, 0xF, 0xF, true));
  v = max(v, (unsigned)__builtin_amdgcn_update_dpp(0, v, 0x141, 0xF, 0xF, true));
  v = max(v, (unsigned)__builtin_amdgcn_update_dpp(0, v, 0x140, 0xF, 0xF, true));
  v = max(v, (unsigned)__builtin_amdgcn_ds_swizzle((int)v, (16 << 10) | 0x1F));
  auto r = __builtin_amdgcn_permlane32_swap(v, v, false, false);
  return (unsigned)__builtin_amdgcn_readfirstlane((int)max(r[0], r[1]));
}
template <int C, int N>
DEVI int radix_counts(const unsigned (&key)[C][N], const unsigned (&cand)[C], int (&cnt)[C]) {
  unsigned long long m[C][N];
#pragma unroll
  for (int c = 0; c < C; ++c)
#pragma unroll
    for (int n = 0; n < N; ++n) m[c][n] = __ballot(key[c][n] >= cand[c]);
  __builtin_amdgcn_sched_barrier(0);
#pragma unroll
  for (int c = 0; c < C; ++c) { cnt[c] = 0;
#pragma unroll
    for (int n = 0; n < N; ++n) cnt[c] += __popcll(m[c][n]); }
  return 0;
}
template <int C, int N>
DEVI void radix16(const unsigned (&key)[C][N], unsigned (&prefix)[C]) {
  int cacc[C]; int cnt[C]; unsigned cand[C];
  bool generic = false;
#pragma unroll
  for (int c = 0; c < C; ++c) {
    unsigned mk = key[c][0];
#pragma unroll
    for (int n = 1; n < N; ++n) mk = max(mk, key[c][n]);
    const unsigned M = wave_umax(mk);
    generic = generic || (M < 0x80800000u);
    prefix[c] = M & 0xFF800000u; cacc[c] = 0;
  }
  if (!generic) {
#pragma unroll 1
    for (int t = 0; t < 12; ++t) {
      radix_counts<C, N>(key, prefix, cnt);
      bool ok = true;
#pragma unroll
      for (int c = 0; c < C; ++c) { cacc[c] = cnt[c]; if (cnt[c] < 16) { ok = false; if (prefix[c] > 0x80800000u) prefix[c] -= 0x00800000u; else generic = true; } }
      if (ok || generic) break;
      if (t == 11) generic = true;
    }
  }
  int start = 22;
  if (generic) { start = 31;
#pragma unroll
    for (int c = 0; c < C; ++c) { prefix[c] = 0u; cacc[c] = 64 * N; } }
#pragma unroll 1
  for (int bit0 = start; bit0 >= 0; bit0 -= 2) {
    bool alldone = true;
#pragma unroll
    for (int c = 0; c < C; ++c) alldone = alldone && (cacc[c] == 16);
    if (alldone) break;
#pragma unroll
    for (int u = 0; u < 2; ++u) {
      const int bit = bit0 - u;
      const unsigned bmask = bit >= 0 ? (1u << bit) : 0u;
#pragma unroll
      for (int c = 0; c < C; ++c) cand[c] = prefix[c] | bmask;
      radix_counts<C, N>(key, cand, cnt);
#pragma unroll
      for (int c = 0; c < C; ++c) if (cnt[c] >= 16) { prefix[c] = cand[c]; cacc[c] = cnt[c]; }
      __builtin_amdgcn_sched_barrier(0);
    }
  }
}
template <int N>
DEVI void compact16(const unsigned (&key)[N], unsigned prefix, const float (&v)[N], const int (&id)[N], float* outv, int* outi, int lane) {
  int base = 0;
  const unsigned long long below = (1ull << lane) - 1ull;
#pragma unroll
  for (int n = 0; n < N; ++n) {
    const bool sel = key[n] >= prefix;
    const unsigned long long m = __ballot(sel);
    const int pos = base + __popcll(m & below);
    if (sel && pos < 16) { outv[pos] = v[n]; outi[pos] = id[n]; }
    base += __popcll(m);
  }
}

DEVI void ph_topk(const Params& p, int mb, char* smem) {
  const float* SC = (const float*)(p.ws + WS_P);
  int* IDX = (int*)(p.ws + WS_IDX) + (size_t)mb * MBT * 128; float* GATE = (float*)(p.ws + WS_GATE) + (size_t)mb * MBT * 128;
  const int tid = tid_l(), wid = tid >> 6, lane = tid & 63;
  float* wv = (float*)smem + wid * 256; int* wi = (int*)wv;
  const int npair2 = MBT * 8 / 2;
  const int stride = gridDim.x * 8;
  float cur[2][4], nxt[2][4];
  int it = blockIdx.x * 8 + wid;
  const int sti = lane < 16 ? 0 : lane < 24 ? 1 : lane < 29 ? 2 : lane < 33 ? 3 : lane < 36 ? 4 : lane < 38 ? 5 : lane < 40 ? 6 : lane < 42 ? 7 : lane < 50 ? lane - 34 : 0;
  const int stj = lane < 16 ? lane : lane < 24 ? lane - 16 : lane < 29 ? lane - 24 : lane < 33 ? lane - 29 : lane < 36 ? lane - 33 : lane < 38 ? lane - 36 : lane < 40 ? lane - 38 : lane < 42 ? lane - 40 : 0;
#define TK_LOAD(dst, item) do { const int tok_ = (item) >> 2, h_ = (item) & 3; _Pragma("unroll") for (int q = 0; q < 2; ++q) { \
      const float* sp_ = SC + (size_t)tok_ * 2048 + (h_ + 4 * q) * 256 + lane; dst[q][0] = sp_[0]; dst[q][1] = sp_[64]; dst[q][2] = sp_[128]; dst[q][3] = sp_[192]; } } while (0)
  if (it < npair2) TK_LOAD(cur, it);
#pragma unroll 1
  for (; it < npair2; it += stride) {
    if (it + stride < npair2) TK_LOAD(nxt, it + stride);
    const int tok = it >> 2, h0 = it & 3;
    unsigned key[4][2], pre[4];
#pragma unroll
    for (int q = 0; q < 2; ++q) { key[2 * q][0] = fkey(cur[q][0]); key[2 * q][1] = fkey(cur[q][1]); key[2 * q + 1][0] = fkey(cur[q][2]); key[2 * q + 1][1] = fkey(cur[q][3]); }
    radix16<4, 2>(key, pre);
    const int ia[2] = {lane, lane + 64};
#pragma unroll
    for (int q = 0; q < 2; ++q) {
      const float a[2] = {cur[q][0], cur[q][1]}, bb[2] = {cur[q][2], cur[q][3]};
      compact16<2>(key[2 * q], pre[2 * q], a, ia, wv + q * 128, wi + q * 128 + 16, lane);
      compact16<2>(key[2 * q + 1], pre[2 * q + 1], bb, ia, wv + q * 128 + 32, wi + q * 128 + 48, lane);
    }
    { const int g = lane >> 4, r = lane & 15; const int base = (g >> 1) * 128 + (g & 1) * 32;
      const float myv = wv[base + r]; const int myi = wi[base + 16 + r];
      int rank = 0;
#pragma unroll
      for (int j = 0; j < 16; ++j) { const float o = wv[base + j]; rank += ((o > myv) || (o == myv && j < r)) ? 1 : 0; }
      wv[base + rank] = myv; wi[base + 16 + rank] = myi; }
    float cv[2][1]; int ci[2][1]; unsigned ck[2][1], cp[2];
#pragma unroll
    for (int q = 0; q < 2; ++q) {
      const float s1 = wv[q * 128 + sti], s2 = wv[q * 128 + 32 + stj];
      cv[q][0] = (lane < 50) ? s1 + s2 : -__builtin_inff();
      ci[q][0] = wi[q * 128 + 16 + sti] * 128 + wi[q * 128 + 48 + stj];
      ck[q][0] = fkey(cv[q][0]);
    }
    radix16<2, 1>(ck, cp);
#pragma unroll
    for (int q = 0; q < 2; ++q) {
      compact16<1>(ck[q], cp[q], cv[q], ci[q], wv + q * 128 + 64, wi + q * 128 + 80, lane);
      if (lane < 16) {
        const int h = h0 + 4 * q;
        GATE[(size_t)tok * 128 + h * 16 + lane] = wv[q * 128 + 64 + lane];
        IDX[(size_t)tok * 128 + h * 16 + lane] = wi[q * 128 + 80 + lane];
      }
    }
#pragma unroll
    for (int q = 0; q < 2; ++q)
#pragma unroll
      for (int e = 0; e < 4; ++e) cur[q][e] = nxt[q][e];
  }
#undef TK_LOAD
}

constexpr int TKA_I[14] = {0, 0, 0, 0, 0, 0, 0, 0, 0, 0, 0, 0, 0, 2}, TKA_J[14] = {1, 2, 3, 4, 5, 6, 7, 8, 9, 10, 11, 12, 0, 2};
constexpr int TKB_I[14] = {0, 0, 0, 1, 1, 1, 1, 1, 1, 2, 2, 0, 1, 3}, TKB_J[14] = {13, 14, 15, 2, 3, 4, 5, 6, 7, 3, 4, 0, 1, 3};
DEVI float tk_other32(float v, bool hi32) { auto r = __builtin_amdgcn_permlane32_swap(__float_as_uint(v), __float_as_uint(v), false, false); return __uint_as_float(hi32 ? r[0] : r[1]); }
DEVI void tk_merge16(float (&m)[16], const float (&pt)[16]) {
#pragma unroll
  for (int i = 0; i < 16; ++i) m[i] = fmaxf(m[i], pt[15 - i]);
#pragma unroll
  for (int sft = 8; sft >= 1; sft >>= 1)
#pragma unroll
    for (int i = 0; i < 16; ++i) if ((i & sft) == 0) { const float a = m[i], b = m[i | sft]; m[i] = fmaxf(a, b); m[i | sft] = fminf(a, b); }
}
DEVI void topk_from_lds(const Params& p, char* tile, int tok0, int head, int* IDX, float* GATE, char* smem) {
  const int tid = tid_l(), wid = tid >> 6, lane = tid & 63;
  const int r = lane & 15, q = lane >> 4, h = q & 1, tr = q >> 1;
  char* rowp = tile + (wid * 16 + r) * 1024;
  char* listp = rowp + r * 16;
  bool dup_any = false;
  {
    float x[64];
#pragma unroll
    for (int k = 0; k < 16; ++k) { const f32x4 v = *(const f32x4*)(rowp + (((q * 16 + k) ^ r) << 4)); x[4 * k] = v[0]; x[4 * k + 1] = v[1]; x[4 * k + 2] = v[2]; x[4 * k + 3] = v[3]; }
    float t[16];
#pragma unroll
    for (int i = 0; i < 16; ++i) t[i] = -__builtin_inff();
#pragma unroll
    for (int j = 0; j < 64; ++j) {
#pragma unroll
      for (int i = (j < 15 ? j : 15); i >= 1; --i) t[i] = __builtin_amdgcn_fmed3f(x[j], t[i - 1], t[i]);
      t[0] = fmaxf(t[0], x[j]);
    }
    float pt[16], m[16];
#pragma unroll
    for (int i = 0; i < 16; ++i) { pt[i] = shx<16>(t[i]); m[i] = t[i]; }
    tk_merge16(m, pt);
    const float thr = m[15];
    int a_own = 0, a_par = 0;
#pragma unroll
    for (int i = 0; i < 16; ++i) { a_own += (t[i] >= thr) ? 1 : 0; a_par += (pt[i] >= thr) ? 1 : 0; }
    float* lv = (float*)listp + tr * 32; int* li = (int*)lv + 16;
    if (!__any(a_own + a_par > 16)) {
      int cnt = h ? a_par : 0;
#pragma unroll
      for (int j = 0; j < 64; ++j) if (x[j] >= thr && cnt < 16) { lv[cnt] = x[j]; li[cnt] = h * 64 + j; ++cnt; }
    } else {
      int g_own = 0, g_par = 0;
#pragma unroll
      for (int i = 0; i < 16; ++i) { g_own += (t[i] > thr) ? 1 : 0; g_par += (pt[i] > thr) ? 1 : 0; }
      const int need = 16 - g_own - g_par;
      const int e0 = h ? (a_par - g_par) : (a_own - g_own);
      const int tk0 = min(e0, need), tk = h ? need - tk0 : tk0;
      int cnt = h ? g_par + tk0 : 0, ties = 0;
#pragma unroll
      for (int j = 0; j < 64; ++j) {
        const float v = x[j]; const bool eq = (v == thr) && (ties < tk);
        if ((v > thr || eq) && cnt < 16) { lv[cnt] = v; li[cnt] = h * 64 + j; ++cnt; }
        ties += eq ? 1 : 0;
      }
    }
    bool dup = false;
#pragma unroll
    for (int i = 0; i < 15; ++i) dup = dup || (m[i] == m[i + 1]);
    dup_any = __any(dup);
    if (!dup_any) {
      asm volatile("s_waitcnt lgkmcnt(0)" ::: "memory");
      float ev[8]; int ec[8];
#pragma unroll
      for (int k = 0; k < 8; ++k) { ev[k] = lv[h * 8 + k]; ec[k] = li[h * 8 + k]; }
      asm volatile("s_waitcnt lgkmcnt(0)" ::: "memory");
#pragma unroll
      for (int k = 0; k < 8; ++k) {
        int rank = 0;
#pragma unroll
        for (int i = 0; i < 16; ++i) rank += (m[i] > ev[k]) ? 1 : 0;
        lv[rank] = ev[k]; li[rank] = ec[k];
      }
    }
  }
  asm volatile("s_waitcnt lgkmcnt(0)" ::: "memory");
#pragma unroll 1
  for (int itr = 0; itr < (dup_any ? 8 : 0); ++itr) {
    const int tk_r = itr * 2 + (q >> 1);
    float* L = (float*)(tile + (wid * 16 + tk_r) * 1024 + tk_r * 16) + (q & 1) * 32; int* Li = (int*)L + 16;
    const float myv = L[r]; const int myi = Li[r];
    int rank = 0;
#pragma unroll
    for (int j = 0; j < 16; ++j) { const float o = L[j]; rank += ((o > myv) || (o == myv && j < r)) ? 1 : 0; }
    L[rank] = myv; Li[rank] = myi;
  }
  asm volatile("s_waitcnt lgkmcnt(0)" ::: "memory");
  {
    const float* Lo = (const float*)listp + tr * 32; const float* Lx = (const float*)listp + (1 - tr) * 32;
    float ov[16], xv[16]; int oi[16], xi[16];
#pragma unroll
    for (int k = 0; k < 4; ++k) {
      const f32x4 a = *(const f32x4*)(Lo + 4 * k), b = *(const f32x4*)(Lx + 4 * k);
      const u32x4 c = *(const u32x4*)(Lo + 16 + 4 * k), d = *(const u32x4*)(Lx + 16 + 4 * k);
#pragma unroll
      for (int e = 0; e < 4; ++e) { ov[4 * k + e] = a[e]; xv[4 * k + e] = b[e]; oi[4 * k + e] = (int)c[e]; xi[4 * k + e] = (int)d[e]; }
    }
    float c[14]; int ce[14];
#pragma unroll
    for (int n = 0; n < 14; ++n) {
      const float so = h ? ov[TKB_I[n]] : ov[TKA_I[n]], sx = h ? xv[TKB_J[n]] : xv[TKA_J[n]];
      const int eo = h ? oi[TKB_I[n]] : oi[TKA_I[n]], ex = h ? xi[TKB_J[n]] : xi[TKA_J[n]];
      const bool dead = (n >= 12 && tr) || (n == 11 && h);
      c[n] = dead ? -__builtin_inff() : so + sx;
      ce[n] = tr ? ex * 128 + eo : eo * 128 + ex;
    }
    float m[16], pt[16];
#pragma unroll
    for (int i = 0; i < 16; ++i) m[i] = -__builtin_inff();
#pragma unroll
    for (int n = 0; n < 14; ++n) {
#pragma unroll
      for (int i = (n < 15 ? n : 15); i >= 1; --i) m[i] = __builtin_amdgcn_fmed3f(c[n], m[i - 1], m[i]);
      m[0] = fmaxf(m[0], c[n]);
    }
#pragma unroll
    for (int i = 0; i < 16; ++i) pt[i] = shx<16>(m[i]);
    tk_merge16(m, pt);
    const bool hi32 = tr != 0;
#pragma unroll
    for (int i = 0; i < 16; ++i) pt[i] = tk_other32(m[i], hi32);
    tk_merge16(m, pt);
    const float thr = m[15];
    int gt = 0, eq = 0;
#pragma unroll
    for (int n = 0; n < 14; ++n) { gt += (c[n] > thr) ? 1 : 0; eq += (c[n] == thr) ? 1 : 0; }
    const int pk = gt | (eq << 8);
    const int pk1 = __float_as_int(shx<16>(__int_as_float(pk)));
    const int pk2 = __float_as_int(tk_other32(__int_as_float(pk + pk1), hi32));
    const int tot = pk + pk1 + pk2;
    const int before = (h ? pk1 : 0) + (tr ? pk2 : 0);
    const int need = 16 - (tot & 0xff), eq_before = before >> 8;
    const int tk = max(0, min(eq, need - eq_before));
    int pos = (before & 0xff) + min(eq_before, need), ties = 0;
    const size_t ob = ((size_t)tok0 + wid * 16 + r) * 128 + head * 16;
#pragma unroll
    for (int n = 0; n < 14; ++n) {
      const float v = c[n]; const bool iseq = (v == thr) && (ties < tk);
      if ((v > thr || iseq) && pos < 16) { GATE[ob + pos] = v; IDX[ob + pos] = ce[n]; ++pos; }
      ties += iseq ? 1 : 0;
    }
  }
}

DEVI float gelu_exact(float a) { return 0.5f * a * (1.f + erff(a * 0.70710678118654752f)); }

using f32x2 = __attribute__((ext_vector_type(2))) float;
DEVI float wave_sum_dpp(float v) {
  v += __uint_as_float(__builtin_amdgcn_update_dpp(0, __float_as_uint(v), 0xB1, 0xF, 0xF, true));
  v += __uint_as_float(__builtin_amdgcn_update_dpp(0, __float_as_uint(v), 0x4E, 0xF, 0xF, true));
  v += __uint_as_float(__builtin_amdgcn_update_dpp(0, __float_as_uint(v), 0x141, 0xF, 0xF, true));
  v += __uint_as_float(__builtin_amdgcn_update_dpp(0, __float_as_uint(v), 0x140, 0xF, 0xF, true));
  v += shx<16>(v); v = sum32(v);
  return v;
}
constexpr int EXG = 8;
DEVI float row16_sum(float v) {
  v += __uint_as_float(__builtin_amdgcn_update_dpp(0, __float_as_uint(v), 0xB1, 0xF, 0xF, true));
  v += __uint_as_float(__builtin_amdgcn_update_dpp(0, __float_as_uint(v), 0x4E, 0xF, 0xF, true));
  v += __uint_as_float(__builtin_amdgcn_update_dpp(0, __float_as_uint(v), 0x141, 0xF, 0xF, true));
  v += __uint_as_float(__builtin_amdgcn_update_dpp(0, __float_as_uint(v), 0x140, 0xF, 0xF, true));
  return v;
}
DEVI float row16_max(float v) {
  v = fmaxf(v, __uint_as_float(__builtin_amdgcn_update_dpp(0, __float_as_uint(v), 0xB1, 0xF, 0xF, true)));
  v = fmaxf(v, __uint_as_float(__builtin_amdgcn_update_dpp(0, __float_as_uint(v), 0x4E, 0xF, 0xF, true)));
  v = fmaxf(v, __uint_as_float(__builtin_amdgcn_update_dpp(0, __float_as_uint(v), 0x141, 0xF, 0xF, true)));
  v = fmaxf(v, __uint_as_float(__builtin_amdgcn_update_dpp(0, __float_as_uint(v), 0x140, 0xF, 0xF, true)));
  return v;
}
DEVI void ex_load(u32x2 (&buf)[EXG][3], const unsigned char* tab, int i0, int i1, int gg, int lane) {
#pragma unroll
  for (int q = 0; q < EXG; ++q) {
    const int e = gg * EXG + q;
    const int ia = __builtin_amdgcn_readlane(i0, e & 63), ib = __builtin_amdgcn_readlane(i1, e & 63);
    const int ie = (e < 64) ? ia : ib;
    const unsigned char* r = tab + (size_t)ie * EROW + lane * 8;
    buf[q][0] = *(const u32x2*)r; buf[q][1] = *(const u32x2*)(r + 512); buf[q][2] = *(const u32x2*)(r + 1024);
  }
}
DEVI f32x32v ex_dec(const u32x2 (&w)[3]) {
  const u32x6 x = {w[0][0], w[0][1], w[1][0], w[1][1], w[2][0], w[2][1]};
  return __builtin_amdgcn_cvt_scalef32_pk32_f32_fp6(x, 1.0f);
}
DEVI void exu_load(u32x4 (&buf)[EXG], const unsigned char* tab, int i0, int i1, int gg, int lane) {
#pragma unroll
  for (int q = 0; q < EXG; ++q) {
    const int e = gg * EXG + q;
    const int ia = __builtin_amdgcn_readlane(i0, e & 63), ib = __builtin_amdgcn_readlane(i1, e & 63);
    const int ie = (e < 64) ? ia : ib;
    buf[q] = *(const u32x4*)(tab + (size_t)ie * UROW + lane * 16);
  }
}
DEVI void ex_dots(const u32x4 (&buf)[EXG], const f32x2 (&hx)[16], float& a_lo, float& a_hi, int gg, int lane) {
  float part[EXG];
#pragma unroll
  for (int q = 0; q < EXG; ++q) {
    f32x2 s2 = {0.f, 0.f};
#pragma unroll
    for (int d = 0; d < 4; ++d) {
      s2 += __builtin_amdgcn_cvt_scalef32_pk_f32_fp4(buf[q][d], 1.0f, 0) * hx[d * 4 + 0];
      s2 += __builtin_amdgcn_cvt_scalef32_pk_f32_fp4(buf[q][d], 1.0f, 1) * hx[d * 4 + 1];
      s2 += __builtin_amdgcn_cvt_scalef32_pk_f32_fp4(buf[q][d], 1.0f, 2) * hx[d * 4 + 2];
      s2 += __builtin_amdgcn_cvt_scalef32_pk_f32_fp4(buf[q][d], 1.0f, 3) * hx[d * 4 + 3];
    }
    part[q] = s2[0] + s2[1];
    __builtin_amdgcn_sched_barrier(0);
  }
#pragma unroll
  for (int q = 0; q < EXG; ++q) part[q] = wave_sum_dpp(part[q]);
#pragma unroll
  for (int q = 0; q < EXG; ++q) { const int e = gg * EXG + q; if (lane == (e & 63)) { if (e < 64) a_lo = part[q]; else a_hi = part[q]; } }
}
DEVI void ex_acc(const u32x4 (&buf)[EXG], f32x2 (&acc)[16], float w0, float w1, int gg) {
#pragma unroll
  for (int q = 0; q < EXG; ++q) {
    const int e = gg * EXG + q;
    const float wa = __uint_as_float(__builtin_amdgcn_readlane(__float_as_uint(w0), e & 63)), wb = __uint_as_float(__builtin_amdgcn_readlane(__float_as_uint(w1), e & 63));
    const float we = (e < 64) ? wa : wb;
    const f32x2 w2 = {we, we};
#pragma unroll
    for (int d = 0; d < 4; ++d) {
      acc[d * 4 + 0] += w2 * __builtin_amdgcn_cvt_scalef32_pk_f32_fp4(buf[q][d], 1.0f, 0);
      acc[d * 4 + 1] += w2 * __builtin_amdgcn_cvt_scalef32_pk_f32_fp4(buf[q][d], 1.0f, 1);
      acc[d * 4 + 2] += w2 * __builtin_amdgcn_cvt_scalef32_pk_f32_fp4(buf[q][d], 1.0f, 2);
      acc[d * 4 + 3] += w2 * __builtin_amdgcn_cvt_scalef32_pk_f32_fp4(buf[q][d], 1.0f, 3);
    }
    __builtin_amdgcn_sched_barrier(0);
  }
}
DEVI void ph_experts(const Params& p, int layer) {
  const unsigned char* UB = p.ws + WS_UB + (size_t)layer * 16384 * UROW; const unsigned char* VB = p.ws + WS_VB + (size_t)layer * 16384 * UROW;
  const int* IDX = (const int*)(p.ws + WS_IDX); const float* GATE = (const float*)(p.ws + WS_GATE);
  const float* gain = p.in[19] + layer * DM;
  const int tid = tid_l(), lane = tid & 63, gw = blockIdx.x * 8 + (tid >> 6), nw = gridDim.x * 8;
  constexpr int NG = 128 / EXG;
#pragma unroll 1
  for (int tok = gw; tok < T_ALL; tok += nw) {
    const u16* xin = (layer == 0 ? (const u16*)p.out : (const u16*)(p.ws + WS_X2B)) + (size_t)tok * DM + lane * 16;
    f32x2 hx[16]; float xs0[16], xs1[16]; float ss = 0.f;
#pragma unroll
    for (int k = 0; k < 2; ++k) {
      const u32x4 a0 = *(const u32x4*)(xin + k * 8), a1 = *(const u32x4*)(xin + 1024 + k * 8);
#pragma unroll
      for (int e = 0; e < 4; ++e) {
        xs0[k * 8 + 2 * e] = bflo(a0[e]); xs0[k * 8 + 2 * e + 1] = bfhi(a0[e]); xs1[k * 8 + 2 * e] = bflo(a1[e]); xs1[k * 8 + 2 * e + 1] = bfhi(a1[e]);
      }
    }
#pragma unroll
    for (int j = 0; j < 16; ++j) { hx[j] = (f32x2){xs0[j], xs1[j]}; ss += xs0[j] * xs0[j] + xs1[j] * xs1[j]; }
    const int i0 = IDX[(size_t)tok * 128 + lane], i1 = IDX[(size_t)tok * 128 + 64 + lane];
    const float sraw0 = GATE[(size_t)tok * 128 + lane], sraw1 = GATE[(size_t)tok * 128 + 64 + lane];
    u32x4 uA[EXG], uB[EXG];
    exu_load(uA, UB, i0, i1, 0, lane);
    ss = wave_sum_dpp(ss);
    const float rstd = rsqrtf(ss * (1.f / DM) + EPS);
#pragma unroll
    for (int k = 0; k < 4; ++k) {
      const f32x4 g0v = *(const f32x4*)(gain + lane * 16 + k * 4), g1v = *(const f32x4*)(gain + 1024 + lane * 16 + k * 4);
#pragma unroll
      for (int e = 0; e < 4; ++e) hx[k * 4 + e] *= (f32x2){rstd * g0v[e], rstd * g1v[e]};
    }
    float g0, g1;
    { const float s0 = sraw0 * rstd, s1 = sraw1 * rstd;
      const float e0 = __expf(s0 - row16_max(s0)), e1 = __expf(s1 - row16_max(s1));
      g0 = e0 * frcp(row16_sum(e0)); g1 = e1 * frcp(row16_sum(e1)); }
    float a_lo = 0.f, a_hi = 0.f;
#pragma unroll 1
    for (int g = 0; g < NG; g += 2) {
      exu_load(uB, UB, i0, i1, g + 1, lane);
      ex_dots(uA, hx, a_lo, a_hi, g, lane);
      exu_load(uA, (g + 2 < NG) ? UB : VB, i0, i1, (g + 2) & (NG - 1), lane);
      ex_dots(uB, hx, a_lo, a_hi, g + 1, lane);
    }
    const float w0 = g0 * gelu_exact(a_lo * (1.f / U_SCALE)) * (1.f / V_SCALE), w1 = g1 * gelu_exact(a_hi * (1.f / U_SCALE)) * (1.f / V_SCALE);
    f32x2 acc[16];
#pragma unroll
    for (int k = 0; k < 16; ++k) acc[k] = (f32x2){0.f, 0.f};
#pragma unroll 1
    for (int g = 0; g < NG; g += 2) {
      exu_load(uB, VB, i0, i1, g + 1, lane);
      ex_acc(uA, acc, w0, w1, g);
      if (g + 2 < NG) exu_load(uA, VB, i0, i1, g + 2, lane);
      ex_acc(uB, acc, w0, w1, g + 1);
    }
    float y0[16], y1[16]; float ss2 = 0.f;
#pragma unroll
    for (int k = 0; k < 2; ++k) {
      const u32x4 a0 = *(const u32x4*)(xin + k * 8), a1 = *(const u32x4*)(xin + 1024 + k * 8);
#pragma unroll
      for (int e = 0; e < 4; ++e) {
        y0[k * 8 + 2 * e] = bflo(a0[e]) + acc[k * 8 + 2 * e][0]; y0[k * 8 + 2 * e + 1] = bfhi(a0[e]) + acc[k * 8 + 2 * e + 1][0];
        y1[k * 8 + 2 * e] = bflo(a1[e]) + acc[k * 8 + 2 * e][1]; y1[k * 8 + 2 * e + 1] = bfhi(a1[e]) + acc[k * 8 + 2 * e + 1][1];
      }
    }
    if (layer == 0) {
      u16* xb = (u16*)(p.ws + WS_X2B) + (size_t)tok * DM + lane * 16;
#pragma unroll
      for (int k = 0; k < 2; ++k) {
        *(u32x4*)(xb + k * 8) = (u32x4){cvtpk(y0[k*8+0], y0[k*8+1]), cvtpk(y0[k*8+2], y0[k*8+3]), cvtpk(y0[k*8+4], y0[k*8+5]), cvtpk(y0[k*8+6], y0[k*8+7])};
        *(u32x4*)(xb + 1024 + k * 8) = (u32x4){cvtpk(y1[k*8+0], y1[k*8+1]), cvtpk(y1[k*8+2], y1[k*8+3]), cvtpk(y1[k*8+4], y1[k*8+5]), cvtpk(y1[k*8+6], y1[k*8+7])};
      }
#pragma unroll
      for (int j = 0; j < 16; ++j) ss2 += y0[j] * y0[j] + y1[j] * y1[j];
      ss2 = wave_sum_dpp(ss2); if (lane == 0) ((float*)(p.ws + WS_RS2))[tok] = rsqrtf(ss2 * (1.f / DM) + EPS);
    } else {
      float* yo = p.out + (size_t)tok * DM + lane * 16;
#pragma unroll
      for (int k = 0; k < 4; ++k) {
        *(f32x4*)(yo + k * 4) = (f32x4){y0[k*4+0], y0[k*4+1], y0[k*4+2], y0[k*4+3]};
        *(f32x4*)(yo + 1024 + k * 4) = (f32x4){y1[k*4+0], y1[k*4+1], y1[k*4+2], y1[k*4+3]};
      }
    }
  }
}

DEVI void ph_l1_post1(const Params& p) {
  const u16* C = (const u16*)(p.ws + WS_E); u16* CQ = (u16*)(p.ws + WS_MIX); u16* CKV = CQ + (size_t)MBT * 768;
  const float* gq = p.in[12]; const float* gkv = p.in[13];
  const int tid = tid_l(), lane = tid & 63, gw = blockIdx.x * 8 + (tid >> 6), nw = gridDim.x * 8;
#pragma unroll 1
  for (int tok = gw; tok < MBT; tok += nw) {
    const u16* cr = C + (size_t)tok * ODD_IN_PAD;
    const u32x4 wa = *(const u32x4*)(cr + lane * 8);
    const u32x4 wb = (lane < 32) ? *(const u32x4*)(cr + 512 + lane * 8) : (u32x4){0u, 0u, 0u, 0u};
    const u32x4 wk = *(const u32x4*)(cr + 768 + lane * 8);
    float a[8], b[8], k[8]; float sq = 0.f, sk = 0.f;
#pragma unroll
    for (int j = 0; j < 4; ++j) { a[2*j] = bflo(wa[j]); a[2*j+1] = bfhi(wa[j]); b[2*j] = bflo(wb[j]); b[2*j+1] = bfhi(wb[j]); k[2*j] = bflo(wk[j]); k[2*j+1] = bfhi(wk[j]); }
#pragma unroll
    for (int j = 0; j < 8; ++j) { sq += a[j] * a[j] + b[j] * b[j]; sk += k[j] * k[j]; }
    sq = wave_sum(sq); sk = wave_sum(sk);
    const float rq = rsqrtf(sq * (1.f / 768.f) + EPS), rk = rsqrtf(sk * (1.f / 512.f) + EPS);
    { const float* g = gq + lane * 8; u32x4 o = {cvtpk(a[0]*rq*g[0], a[1]*rq*g[1]), cvtpk(a[2]*rq*g[2], a[3]*rq*g[3]), cvtpk(a[4]*rq*g[4], a[5]*rq*g[5]), cvtpk(a[6]*rq*g[6], a[7]*rq*g[7])};
      *(u32x4*)(CQ + (size_t)tok * 768 + lane * 8) = o; }
    if (lane < 32) { const float* g = gq + 512 + lane * 8; u32x4 o = {cvtpk(b[0]*rq*g[0], b[1]*rq*g[1]), cvtpk(b[2]*rq*g[2], b[3]*rq*g[3]), cvtpk(b[4]*rq*g[4], b[5]*rq*g[5]), cvtpk(b[6]*rq*g[6], b[7]*rq*g[7])};
      *(u32x4*)(CQ + (size_t)tok * 768 + 512 + lane * 8) = o; }
    { const float* g = gkv + lane * 8; u32x4 o = {cvtpk(k[0]*rk*g[0], k[1]*rk*g[1]), cvtpk(k[2]*rk*g[2], k[3]*rk*g[3]), cvtpk(k[4]*rk*g[4], k[5]*rk*g[5]), cvtpk(k[6]*rk*g[6], k[7]*rk*g[7])};
      *(u32x4*)(CKV + (size_t)tok * 512 + lane * 8) = o; }
  }
}

DEVI void ph_l1_post2(const Params& p, int mb) {
  u16* Q = (u16*)(p.ws + WS_P); const u16* KV = Q + (size_t)MBT * 3072; const u16* C = (const u16*)(p.ws + WS_E); u16* KB = (u16*)(p.ws + WS_OFB);
  const float* rc = (const float*)(p.ws + WS_ROPE); const float* rs = rc + 16384 * 32;
  const int S = (mb < 2) ? 2048 : 16384;
  const unsigned total = (unsigned)MBT * 16 * 16, gs = gridDim.x * NTHR;
#pragma unroll 1
  for (unsigned it0 = blockIdx.x * NTHR + tid_l(); it0 < total; it0 += 4 * gs) {
    u32x4 nw[4]; unsigned r1[4], r2[4]; bool ok[4];
#pragma unroll
    for (int j = 0; j < 4; ++j) {
      const unsigned it = it0 + j * gs; ok[j] = it < total;
      const int sub = (int)(it & 15); const unsigned grp = it >> 4;
      const int which = 1, head = (int)(grp & 15); const size_t tok = grp >> 4;
      const u16* np = which ? (KV + tok * 4096 + head * 256 + 8 * sub) : (Q + tok * 3072 + head * 192 + 8 * sub);
      const u16* rp = which ? (C + tok * ODD_IN_PAD + 1280 + 2 * sub) : (Q + tok * 3072 + head * 192 + 128 + 2 * sub);
      if (ok[j]) { nw[j] = *(const u32x4*)np; r1[j] = *(const unsigned*)rp; r2[j] = *(const unsigned*)(rp + 32); } else { nw[j] = (u32x4){0u, 0u, 0u, 0u}; r1[j] = 0u; r2[j] = 0u; }
    }
#pragma unroll
    for (int j = 0; j < 4; ++j) {
      const unsigned it = it0 + j * gs;
      const int sub = (int)(it & 15); const unsigned grp = it >> 4;
      const int which = 1, head = (int)(grp & 15); const size_t tok = grp >> 4;
      const int pos = (int)(tok % (size_t)S);
      float n[8];
#pragma unroll
      for (int e = 0; e < 4; ++e) { n[2 * e] = bflo(nw[j][e]); n[2 * e + 1] = bfhi(nw[j][e]); }
      const float xa0 = bflo(r1[j]), xa1 = bfhi(r1[j]), xb0 = bflo(r2[j]), xb1 = bfhi(r2[j]);
      float ss = xa0 * xa0 + xa1 * xa1 + xb0 * xb0 + xb1 * xb1;
#pragma unroll
      for (int e = 0; e < 8; ++e) ss += n[e] * n[e];
      ss += shx<1>(ss); ss += shx<2>(ss); ss += shx<4>(ss); ss += shx<8>(ss);
      const float rstd = rsqrtf(ss * (1.f / 192.f) + EPS);
      const float* g = which ? p.in[17] : p.in[16];
      const f32x4 g0 = *(const f32x4*)(g + 8 * sub), g1 = *(const f32x4*)(g + 8 * sub + 4);
      const float ya0 = xa0 * rstd * g[128 + 2 * sub], ya1 = xa1 * rstd * g[129 + 2 * sub], yb0 = xb0 * rstd * g[160 + 2 * sub], yb1 = xb1 * rstd * g[161 + 2 * sub];
      const float c0 = rc[pos * 32 + 2 * sub], c1 = rc[pos * 32 + 2 * sub + 1], s0 = rs[pos * 32 + 2 * sub], s1 = rs[pos * 32 + 2 * sub + 1];
      u16* dp = which ? (KB + tok * 3072 + head * 192) : (Q + tok * 3072 + head * 192);
      if (ok[j]) {
        u32x4 o = {cvtpk(n[0]*rstd*g0[0], n[1]*rstd*g0[1]), cvtpk(n[2]*rstd*g0[2], n[3]*rstd*g0[3]), cvtpk(n[4]*rstd*g1[0], n[5]*rstd*g1[1]), cvtpk(n[6]*rstd*g1[2], n[7]*rstd*g1[3])};
        *(u32x4*)(dp + 8 * sub) = o;
        *(unsigned*)(dp + 128 + 2 * sub) = cvtpk(ya0 * c0 - yb0 * s0, ya1 * c1 - yb1 * s1);
        *(unsigned*)(dp + 160 + 2 * sub) = cvtpk(yb0 * c0 + ya0 * s0, yb1 * c1 + ya1 * s1);
      }
    }
  }
}

constexpr int A_NW = 8, A_QBLK = 32, A_KVBLK = 64;
constexpr float A_SCALE = 0.07216878364870322f;
constexpr int A_LDQ = 3072, A_LDK = 3072, A_LDV = 4096, A_LDO = 2048;
constexpr int A_SHM_V = 64 * 128 * 2, A_SHM_K = 64 * 192 * 2;
constexpr float A_THR = 8.f;
#define KSWZ2(row, colB) ((row) * 384 + ((colB) ^ ((((row) >> 1) & 7) << 4)))
#define SBAR() __builtin_amdgcn_sched_barrier(0)
DEVI int crow(int r, int hi) { return (r & 3) + 8 * (r >> 2) + 4 * hi; }
DEVI void a_partialSM(f32x16& p0, f32x16& p1, float& m_reg, float& mn, float& alpha) {
  constexpr float C = A_SCALE * 1.4426950408889634f;
  float pmax = p0[0];
#pragma unroll
  for (int r = 1; r < 16; ++r) pmax = fmaxf(pmax, p0[r]);
#pragma unroll
  for (int r = 0; r < 16; ++r) pmax = fmaxf(pmax, p1[r]);
  { auto rr = __builtin_amdgcn_permlane32_swap(__float_as_uint(pmax), __float_as_uint(pmax), false, false);
    pmax = fmaxf(__uint_as_float(rr[0]), __uint_as_float(rr[1])); }
  if (__builtin_expect(__all(pmax - m_reg <= A_THR / A_SCALE), 1)) { mn = m_reg; alpha = 1.f; }
  else { mn = fmaxf(m_reg, pmax); alpha = __builtin_amdgcn_exp2f((m_reg - mn) * C); m_reg = mn; }
  const float mnC = -mn * C;
#pragma unroll
  for (int r = 0; r < 16; ++r) p0[r] = fmaf(p0[r], C, mnC);
#pragma unroll
  for (int r = 0; r < 16; ++r) p1[r] = fmaf(p1[r], C, mnC);
#pragma unroll
  for (int r = 0; r < 16; ++r) p0[r] = __builtin_amdgcn_exp2f(p0[r]);
}
DEVI void a_finishSM(f32x16& p0, f32x16& p1, float alpha, float& l_reg, bf16x8& pa0, bf16x8& pa1, bf16x8& pa2, bf16x8& pa3) {
#pragma unroll
  for (int r = 0; r < 16; ++r) p1[r] = __builtin_amdgcn_exp2f(p1[r]);
  float ps = 0;
#pragma unroll
  for (int r = 0; r < 16; ++r) ps += p0[r];
#pragma unroll
  for (int r = 0; r < 16; ++r) ps += p1[r];
  { auto rr = __builtin_amdgcn_permlane32_swap(__float_as_uint(ps), __float_as_uint(ps), false, false);
    ps = __uint_as_float(rr[0]) + __uint_as_float(rr[1]); }
  l_reg = l_reg * alpha + ps;
#define PK4(P, BASE, OUT) do { unsigned a0 = cvtpk(P[BASE + 0], P[BASE + 1]), a1 = cvtpk(P[BASE + 2], P[BASE + 3]);   \
    unsigned b0 = cvtpk(P[BASE + 4], P[BASE + 5]), b1 = cvtpk(P[BASE + 6], P[BASE + 7]);                              \
    auto r0 = __builtin_amdgcn_permlane32_swap(a0, b0, false, false); auto r1 = __builtin_amdgcn_permlane32_swap(a1, b1, false, false); \
    u32x4 w = {r0[0], r1[0], r0[1], r1[1]}; OUT = *reinterpret_cast<bf16x8*>(&w); } while (0)
  PK4(p0, 0, pa0); PK4(p0, 8, pa1); PK4(p1, 0, pa2); PK4(p1, 8, pa3);
#undef PK4
}
DEVI void a_partialSM_nm(f32x16& p0) {
#pragma unroll
  for (int r = 0; r < 16; ++r) p0[r] = __builtin_amdgcn_exp2f(p0[r]);
}
DEVI void a_finishSM_nm(f32x16& p0, f32x16& p1, float& l_reg, bf16x8& pa0, bf16x8& pa1, bf16x8& pa2, bf16x8& pa3) {
#pragma unroll
  for (int r = 0; r < 16; ++r) p1[r] = __builtin_amdgcn_exp2f(p1[r]);
  float ps = 0;
#pragma unroll
  for (int r = 0; r < 16; ++r) ps += p0[r];
#pragma unroll
  for (int r = 0; r < 16; ++r) ps += p1[r];
  l_reg += ps;
#define PK4(P, BASE, OUT) do { unsigned a0 = cvtpk(P[BASE + 0], P[BASE + 1]), a1 = cvtpk(P[BASE + 2], P[BASE + 3]);   \
    unsigned b0 = cvtpk(P[BASE + 4], P[BASE + 5]), b1 = cvtpk(P[BASE + 6], P[BASE + 7]);                              \
    auto r0 = __builtin_amdgcn_permlane32_swap(a0, b0, false, false); auto r1 = __builtin_amdgcn_permlane32_swap(a1, b1, false, false); \
    u32x4 w = {r0[0], r1[0], r0[1], r1[1]}; OUT = *reinterpret_cast<bf16x8*>(&w); } while (0)
  PK4(p0, 0, pa0); PK4(p0, 8, pa1); PK4(p1, 0, pa2); PK4(p1, 8, pa3);
#undef PK4
}
DEVI void a_qkt(f32x16& p0, f32x16& p1, const char* Ks, const bf16x8* qr, int r32, int hi) {
  p0 = f32x16{}; p1 = f32x16{};
  bf16x8 b0 = *reinterpret_cast<const bf16x8*>(Ks + KSWZ2(r32, (hi * 8) * 2));
  bf16x8 b1 = *reinterpret_cast<const bf16x8*>(Ks + KSWZ2(32 + r32, (hi * 8) * 2));
#pragma unroll
  for (int d0 = 0; d0 < 12; ++d0) {
    bf16x8 n0 = b0, n1 = b1;
    if (d0 + 1 < 12) { const int cb = ((d0 + 1) * 16 + hi * 8) * 2;
      n0 = *reinterpret_cast<const bf16x8*>(Ks + KSWZ2(r32, cb));
      n1 = *reinterpret_cast<const bf16x8*>(Ks + KSWZ2(32 + r32, cb)); }
    __builtin_amdgcn_sched_barrier(0);
    p0 = __builtin_amdgcn_mfma_f32_32x32x16_bf16(b0, qr[d0], p0, 0, 0, 0);
    p1 = __builtin_amdgcn_mfma_f32_32x32x16_bf16(b1, qr[d0], p1, 0, 0, 0);
    __builtin_amdgcn_sched_barrier(0);
    b0 = n0; b1 = n1;
  }
}
DEVI int a_v_st(int k, int c) { const int kk = (k & ~0xC) | ((k & 4) << 1) | ((k & 8) >> 1); return ((kk >> 3) * 4 + (c >> 5)) * 512 + ((kk & 7) * 32 + (c & 31)) * 2; }
DEVI int a_v_rd_base(int lane) { return ((lane & 3) << 3) | (((lane >> 2) & 3) << 6) | (((lane >> 4) & 1) << 5) | (((lane >> 5) & 1) << 8); }
constexpr int a_v_rd_off(int d0, int ks, int half) { return d0 * 512 + ks * 4096 + half * 2048; }
template <int D0> DEVI void a_pv_one(f32x16& od, int vb, bf16x8 pa0, bf16x8 pa1, bf16x8 pa2, bf16x8 pa3) {
  const s16x4 l0 = tr_read_asm<a_v_rd_off(D0, 0, 0)>(vb), h0 = tr_read_asm<a_v_rd_off(D0, 0, 1)>(vb), l1 = tr_read_asm<a_v_rd_off(D0, 1, 0)>(vb), h1 = tr_read_asm<a_v_rd_off(D0, 1, 1)>(vb);
  const s16x4 l2 = tr_read_asm<a_v_rd_off(D0, 2, 0)>(vb), h2 = tr_read_asm<a_v_rd_off(D0, 2, 1)>(vb), l3 = tr_read_asm<a_v_rd_off(D0, 3, 0)>(vb), h3 = tr_read_asm<a_v_rd_off(D0, 3, 1)>(vb);
  asm volatile("s_waitcnt lgkmcnt(0)" ::: "memory"); SBAR();
  od = __builtin_amdgcn_mfma_f32_32x32x16_bf16(pa0, pk44(l0, h0), od, 0, 0, 0);
  od = __builtin_amdgcn_mfma_f32_32x32x16_bf16(pa1, pk44(l1, h1), od, 0, 0, 0);
  od = __builtin_amdgcn_mfma_f32_32x32x16_bf16(pa2, pk44(l2, h2), od, 0, 0, 0);
  od = __builtin_amdgcn_mfma_f32_32x32x16_bf16(pa3, pk44(l3, h3), od, 0, 0, 0);
}
DEVI void a_pv_d0(f32x16* o, int vb, bf16x8 pa0, bf16x8 pa1, bf16x8 pa2, bf16x8 pa3) {
  a_pv_one<0>(o[0], vb, pa0, pa1, pa2, pa3); a_pv_one<1>(o[1], vb, pa0, pa1, pa2, pa3); a_pv_one<2>(o[2], vb, pa0, pa1, pa2, pa3); a_pv_one<3>(o[3], vb, pa0, pa1, pa2, pa3);
}
template <int SDEPTH, bool NOMAX>
DEVI void attn_body(const Params& p, const u16* __restrict__ Qb, const u16* __restrict__ Kh, const u16* __restrict__ Vh, u16* __restrict__ Ob, int seq, int qpos0, char* lds) {
  const int tid = tid_l(), wid = tid >> 6, lane = tid & 63, r32 = lane & 31, hi = lane >> 5;
  char* V_lds = lds; char* K_lds = lds + 2 * A_SHM_V;
  float* ws = (float*)(lds + 2 * A_SHM_V + 2 * A_SHM_K) + wid * 64; float* li_l = ws; float* al_l = ws + 32;
  float m_reg = -1e30f, l_reg = 0; f32x16 o[4] = {}; bf16x8 qr[12];
  const u16* Qw = Qb + (long)(wid * A_QBLK + r32) * A_LDQ + hi * 8;
#pragma unroll
  for (int d0 = 0; d0 < 12; ++d0) qr[d0] = *reinterpret_cast<const bf16x8*>(Qw + d0 * 16);
  {
    float ss = 0.f;
#pragma unroll
    for (int d0 = 0; d0 < 12; ++d0)
#pragma unroll
      for (int e = 0; e < 8; ++e) { const float f = __uint_as_float((unsigned)(unsigned short)qr[d0][e] << 16); ss += f * f; }
    ss = sum32(ss);
    const float rstd = rsqrtf(ss * (1.f / 192.f) + EPS) * (NOMAX ? A_SCALE * 1.4426950408889634f : 1.f);
    const float* g = p.in[16] + hi * 8;
    const int pos = qpos0 + wid * A_QBLK + r32;
    const float* rcq = (const float*)(p.ws + WS_ROPE) + pos * 32 + hi * 8; const float* rsq = rcq + 16384 * 32;
#pragma unroll
    for (int d0 = 0; d0 < 8; ++d0) {
      const f32x4 g0 = *(const f32x4*)(g + d0 * 16), g1 = *(const f32x4*)(g + d0 * 16 + 4);
      float f[8];
#pragma unroll
      for (int e = 0; e < 8; ++e) f[e] = __uint_as_float((unsigned)(unsigned short)qr[d0][e] << 16);
      u32x4 o = {cvtpk(f[0]*rstd*g0[0], f[1]*rstd*g0[1]), cvtpk(f[2]*rstd*g0[2], f[3]*rstd*g0[3]), cvtpk(f[4]*rstd*g1[0], f[5]*rstd*g1[1]), cvtpk(f[6]*rstd*g1[2], f[7]*rstd*g1[3])};
      qr[d0] = *reinterpret_cast<bf16x8*>(&o);
    }
#pragma unroll
    for (int d0 = 8; d0 < 10; ++d0) {
      float ya[8], yb[8], cc[8], sn[8];
#pragma unroll
      for (int e = 0; e < 8; ++e) {
        ya[e] = __uint_as_float((unsigned)(unsigned short)qr[d0][e] << 16) * rstd * g[d0 * 16 + e];
        yb[e] = __uint_as_float((unsigned)(unsigned short)qr[d0 + 2][e] << 16) * rstd * g[(d0 + 2) * 16 + e];
        cc[e] = rcq[(d0 - 8) * 16 + e]; sn[e] = rsq[(d0 - 8) * 16 + e];
      }
      u32x4 oa = {cvtpk(ya[0]*cc[0] - yb[0]*sn[0], ya[1]*cc[1] - yb[1]*sn[1]), cvtpk(ya[2]*cc[2] - yb[2]*sn[2], ya[3]*cc[3] - yb[3]*sn[3]),
                  cvtpk(ya[4]*cc[4] - yb[4]*sn[4], ya[5]*cc[5] - yb[5]*sn[5]), cvtpk(ya[6]*cc[6] - yb[6]*sn[6], ya[7]*cc[7] - yb[7]*sn[7])};
      u32x4 ob = {cvtpk(yb[0]*cc[0] + ya[0]*sn[0], yb[1]*cc[1] + ya[1]*sn[1]), cvtpk(yb[2]*cc[2] + ya[2]*sn[2], yb[3]*cc[3] + ya[3]*sn[3]),
                  cvtpk(yb[4]*cc[4] + ya[4]*sn[4], yb[5]*cc[5] + ya[5]*sn[5]), cvtpk(yb[6]*cc[6] + ya[6]*sn[6], yb[7]*cc[7] + ya[7]*sn[7])};
      qr[d0] = *reinterpret_cast<bf16x8*>(&oa); qr[d0 + 2] = *reinterpret_cast<bf16x8*>(&ob);
    }
  }
  const int sr = tid >> 4, sc = (tid & 15) * 8, vst0 = a_v_st(sr, sc), vst1 = a_v_st(32 + sr, sc);
  const int kr = tid >> 3, kc = (tid & 7) * 8;
  const int kst = KSWZ2(kr, kc * 2);
  const unsigned voff = (unsigned)(sr * A_LDV + sc) * 2u, koff = (unsigned)(kr * A_LDK + kc) * 2u;
  const int vb0 = (int)(uintptr_t)V_lds + a_v_rd_base(lane);
  struct { bf16x8 vs0, vs1, ks0, ks1, ks2; } sr_[SDEPTH];
#define SLOAD(i, k0) do { const char* vb_ = (const char*)(Vh + (long)(k0) * A_LDV); const char* kb_ = (const char*)(Kh + (long)(k0) * A_LDK); \
    sr_[i].vs0 = *(const bf16x8*)(vb_ + voff); sr_[i].vs1 = *(const bf16x8*)(vb_ + 32 * A_LDV * 2 + voff); \
    sr_[i].ks0 = *(const bf16x8*)(kb_ + koff); sr_[i].ks1 = *(const bf16x8*)(kb_ + koff + 128); sr_[i].ks2 = *(const bf16x8*)(kb_ + koff + 256); } while (0)
#define SWRITE(b, i) do { *(bf16x8*)(V_lds + (b) * A_SHM_V + vst0) = sr_[i].vs0; *(bf16x8*)(V_lds + (b) * A_SHM_V + vst1) = sr_[i].vs1; \
    *(bf16x8*)(K_lds + (b) * A_SHM_K + kst) = sr_[i].ks0; *(bf16x8*)(K_lds + (b) * A_SHM_K + kst + 128) = sr_[i].ks1; *(bf16x8*)(K_lds + (b) * A_SHM_K + kst + 256) = sr_[i].ks2; } while (0)
#define SWAIT() do { if constexpr (SDEPTH == 2) asm volatile("s_waitcnt vmcnt(5)" ::: "memory"); else asm volatile("s_waitcnt vmcnt(0)" ::: "memory"); } while (0)
#define RESC(a) do { if constexpr (!NOMAX) { if (__any((a) < 1.f)) { if (hi == 0) al_l[r32] = (a); asm volatile("s_waitcnt lgkmcnt(0)" ::: "memory"); \
    _Pragma("unroll") for (int d = 0; d < 4; ++d) _Pragma("unroll") for (int r = 0; r < 16; ++r) o[d][r] *= al_l[crow(r, hi)]; } } } while (0)
#define PSM(P0, P1, MN, AL) do { if constexpr (NOMAX) a_partialSM_nm(P0); else a_partialSM(P0, P1, m_reg, MN, AL); } while (0)
#define FSM(P0, P1, AL) do { if constexpr (NOMAX) a_finishSM_nm(P0, P1, l_reg, pa0, pa1, pa2, pa3); else a_finishSM(P0, P1, AL, l_reg, pa0, pa1, pa2, pa3); } while (0)
  f32x16 pA0, pA1, pB0, pB1; float mnA = 0.f, mnB = 0.f, alA = 1.f, alB = 1.f; bf16x8 pa0, pa1, pa2, pa3; const int NT = seq / A_KVBLK;
  constexpr int SE = 0, SO = SDEPTH - 1;
  __syncthreads();
  SLOAD(SE, 0); asm volatile("s_waitcnt vmcnt(0)" ::: "memory"); SWRITE(0, SE); __syncthreads();
  a_qkt(pA0, pA1, K_lds, qr, r32, hi); PSM(pA0, pA1, mnA, alA);
  SLOAD(SO, A_KVBLK); if constexpr (SDEPTH == 2) { if (2 < NT) SLOAD(SE, 2 * A_KVBLK); }
  SWAIT(); SWRITE(1, SO); __syncthreads();
#pragma unroll 1
  for (int j = 1; j + 1 < NT; j += 2) {
    SBAR(); a_qkt(pB0, pB1, K_lds + A_SHM_K, qr, r32, hi);
    FSM(pA0, pA1, alA); SBAR();
    SLOAD(SO, (j + SDEPTH) * A_KVBLK); SBAR();
    a_pv_d0(o, vb0, pa0, pa1, pa2, pa3); PSM(pB0, pB1, mnB, alB);
    __syncthreads(); SWAIT(); SWRITE(0, SE);
    RESC(alB); __syncthreads();
    SBAR(); a_qkt(pA0, pA1, K_lds, qr, r32, hi);
    FSM(pB0, pB1, alB); SBAR();
    if (SDEPTH == 1 || j + 3 < NT) SLOAD(SE, (j + 1 + SDEPTH) * A_KVBLK); SBAR();
    a_pv_d0(o, vb0 + A_SHM_V, pa0, pa1, pa2, pa3); PSM(pA0, pA1, mnA, alA);
    __syncthreads(); SWAIT(); SWRITE(1, SO);
    RESC(alA); __syncthreads();
  }
  SBAR(); a_qkt(pB0, pB1, K_lds + A_SHM_K, qr, r32, hi);
  FSM(pA0, pA1, alA); SBAR();
  a_pv_d0(o, vb0, pa0, pa1, pa2, pa3); PSM(pB0, pB1, mnB, alB);
  __syncthreads(); RESC(alB);
  FSM(pB0, pB1, alB); SBAR();
  a_pv_d0(o, vb0 + A_SHM_V, pa0, pa1, pa2, pa3);
  if constexpr (NOMAX) l_reg = sum32(l_reg);
  if (hi == 0) li_l[r32] = l_reg; asm volatile("s_waitcnt lgkmcnt(0)" ::: "memory");
  float rli[16];
#pragma unroll
  for (int r = 0; r < 16; ++r) rli[r] = __builtin_amdgcn_rcpf(li_l[crow(r, hi)]);
  u16* Ow = Ob + (long)(wid * A_QBLK) * A_LDO;
  char* opatch = lds + 2 * A_SHM_V + 2 * A_SHM_K + 2048 + wid * (16 * 272);
#pragma unroll
  for (int k = 0; k < 2; ++k) {
#pragma unroll
    for (int r = 8 * k; r < 8 * k + 8; ++r) { const int prow = crow(r, hi) - 16 * k;
#pragma unroll
      for (int d0 = 0; d0 < 4; ++d0) *(u16*)(opatch + prow * 272 + (d0 * 32 + r32) * 2) = f2bf(o[d0][r] * rli[r]); }
    asm volatile("s_waitcnt lgkmcnt(0)" ::: "memory");
#pragma unroll
    for (int i = 0; i < 4; ++i) { const int c = lane + 64 * i, prow = c >> 4, cc = c & 15;
      const u32x4 w = *(const u32x4*)(opatch + prow * 272 + cc * 16);
      *(u32x4*)(Ow + (long)(16 * k + prow) * A_LDO + cc * 8) = w; }
    asm volatile("s_waitcnt lgkmcnt(0)" ::: "memory");
  }
#undef SLOAD
#undef SWRITE
#undef SWAIT
#undef RESC
#undef PSM
#undef FSM
}

DEVI void ph_attn(const Params& p, int mb, char* smem) {
  const u16* Q = (const u16*)(p.ws + WS_P); const u16* KV = Q + (size_t)MBT * 3072; const u16* KB = (const u16*)(p.ws + WS_OFB); u16* O = (u16*)(p.ws + WS_H);
  const int S = (mb < 2) ? 2048 : 16384; const int QB = S / 256;
  const int nunits = (MBT / 256) * 16;
  const bool swz = (gridDim.x == 256);
  bool nomax;
  { const int l_ = tid_l() & 63; float gq = 0.f, gk = 0.f;
#pragma unroll
    for (int i = 0; i < 3; ++i) { gq = fmaxf(gq, fabsf(p.in[16][l_ + 64 * i])); gk = fmaxf(gk, fabsf(p.in[17][l_ + 64 * i])); }
    const float Gq = __uint_as_float(wave_umax(__float_as_uint(gq))), Gk = __uint_as_float(wave_umax(__float_as_uint(gk)));
    nomax = (13.856406f * 1.4426950f * 1.02f * Gq * Gk) <= 100.f; }
#pragma unroll 1
  for (int it = 0; it * (int)gridDim.x + (int)blockIdx.x < nunits; ++it) {
    int seq, head, qb;
    if (swz) { const int x = blockIdx.x & 7, slot = blockIdx.x >> 3; const int li = slot + 32 * it; const int gp = x + 8 * (li / QB); qb = li % QB; head = gp & 15; seq = gp >> 4; }
    else { const int u = it * gridDim.x + blockIdx.x; qb = u % QB; head = (u / QB) & 15; seq = u / (QB * 16); }
    const size_t t0 = (size_t)seq * S;
    if (nomax) attn_body<1, true>(p, Q + (t0 + (size_t)qb * 256) * 3072 + head * 192, KB + t0 * 3072 + head * 192, KV + t0 * 4096 + head * 256 + 128,
                                  O + (t0 + (size_t)qb * 256) * 2048 + head * 128, S, qb * 256, smem);
    else attn_body<1, false>(p, Q + (t0 + (size_t)qb * 256) * 3072 + head * 192, KB + t0 * 3072 + head * 192, KV + t0 * 4096 + head * 256 + 128,
                             O + (t0 + (size_t)qb * 256) * 2048 + head * 128, S, qb * 256, smem);
  }
}

__global__ void __launch_bounds__(NTHR, 2) fwd(Params pk) {
  extern __shared__ __attribute__((aligned(16))) char smem[];
  Params p = pk; p.wave_u = __builtin_amdgcn_readfirstlane((int)(threadIdx.x >> 6));
  volatile LAS unsigned* ctl = (volatile LAS unsigned*)(smem + 131072);
  if (threadIdx.x < 16) ctl[threadIdx.x] = 0u;
#if defined(PROBE_KIND) && PROBE_KIND == 10
  if (threadIdx.x < 2) ctl[64 + threadIdx.x] = 0u;
#endif
  __syncthreads();
  XcdBarrier bar; bar.bar = (unsigned*)(p.ws + WS_BAR); bar.x = 0; bar.st = ctl; bar.wave_u = p.wave_u;
  const bool multi = (p.step_hi - p.step_lo) > 1;
  if (multi) bar = xcd_barrier_post((unsigned*)(p.ws + WS_BAR), ctl, p.wave_u);
  int step = 0;
#ifndef PROBE_KIND
#define PROBE_KIND -1
#endif
  unsigned long long probe_acc = 0ull;
#define STEPK(kind, code) do { if (step >= p.step_lo && step < p.step_hi) { unsigned long long t0_ = 0ull; if ((kind) == PROBE_KIND) t0_ = __builtin_amdgcn_s_memrealtime(); \
    code; if (step + 1 < p.step_hi) xcd_barrier(bar); if ((kind) == PROBE_KIND) probe_acc += __builtin_amdgcn_s_memrealtime() - t0_; } ++step; } while (0)

  STEPK(7, ph_prologue(p, smem); ph_convert_uv(p));
#pragma unroll 1
  for (int mb = 0; mb < NMB; ++mb) {
    u16* H = (u16*)(p.ws + WS_H); u16* PP = (u16*)(p.ws + WS_P); u16* MIX = (u16*)(p.ws + WS_MIX);
    float* outmb = p.out + (size_t)mb * MBT * DM;
    STEPK(8, ph_norm(p, xin_mb(p, mb), p.in[2], H, MBT));
    STEPK(1, ph_gemm_stream<EPI_BF16>(p, H, (const u16*)(p.ws + WS_WT_EVIN), MBT, 8192, 2048, GemmEpi{PP, nullptr, 8192, nullptr, nullptr}, smem));
    STEPK(6, ph_na(p, mb, smem); __syncthreads(); ph_hgrn_pass<false>(p, mb, smem));
    STEPK(4, ph_hgrn_carry(p, mb));
    STEPK(4, ph_hgrn_pass<true>(p, mb, smem));
    STEPK(4, ph_hg_combine(p));
    u16* x1b = (u16*)p.out + (size_t)mb * MBT * DM;
    STEPK(1, ph_gemm_stream<EPI_RES_F2B>(p, MIX, (const u16*)(p.ws + WS_WT_EVOUT), MBT, 2048, 2048, GemmEpi{nullptr, xin_mb(p, mb), 2048, x1b, nullptr}, smem));
    STEPK(1, ph_gemm<EPI_TOPK>(p, x1b, (const u16*)(p.ws + WS_WEFF), MBT, 2048, 2048,
                               GemmEpi{(int*)(p.ws + WS_IDX) + (size_t)mb * MBT * 128, nullptr, 2048, (u16*)((float*)(p.ws + WS_GATE) + (size_t)mb * MBT * 128), nullptr}, smem));
  }
  STEPK(2, ph_experts(p, 0));
#pragma unroll 1
  for (int mb = 0; mb < NMB; ++mb) {
    u16* H = (u16*)(p.ws + WS_H); u16* PP = (u16*)(p.ws + WS_P); u16* CQ = (u16*)(p.ws + WS_MIX);
    float* outmb = p.out + (size_t)mb * MBT * DM;
    STEPK(1, ph_gemm_stream<EPI_BF16_RS>(p, (const u16*)(p.ws + WS_X2B) + (size_t)mb * MBT * DM, (const u16*)(p.ws + WS_WT_ODIN), MBT, ODD_IN_PAD, 2048,
                                  GemmEpi{p.ws + WS_E, nullptr, ODD_IN_PAD, nullptr, (const float*)(p.ws + WS_RS2) + (size_t)mb * MBT}, smem));
    STEPK(9, ph_l1_post1(p));
    STEPK(1, ph_gemm_stream<EPI_BF16>(p, CQ, (const u16*)(p.ws + WS_WT_UQ), MBT, 3072, 768, GemmEpi{PP, nullptr, 3072, nullptr, nullptr}, smem);
         ph_gemm_stream<EPI_BF16>(p, CQ + (size_t)MBT * 768, (const u16*)(p.ws + WS_WT_UKV), MBT, 4096, 512, GemmEpi{PP + (size_t)MBT * 3072, nullptr, 4096, nullptr, nullptr}, smem));
    STEPK(9, ph_l1_post2(p, mb));
    STEPK(3, ph_attn(p, mb, smem));
    u16* x23b = (u16*)(p.ws + WS_X2B) + (size_t)mb * MBT * DM;
    STEPK(1, ph_gemm_stream<EPI_RES_B2B>(p, H, (const u16*)(p.ws + WS_WT_ODOUT), MBT, 2048, 2048, GemmEpi{nullptr, nullptr, 2048, x23b, nullptr}, smem));
    STEPK(1, ph_gemm<EPI_TOPK>(p, x23b, (const u16*)(p.ws + WS_WEFF) + (size_t)2048 * 2048, MBT, 2048, 2048,
                               GemmEpi{(int*)(p.ws + WS_IDX) + (size_t)mb * MBT * 128, nullptr, 2048, (u16*)((float*)(p.ws + WS_GATE) + (size_t)mb * MBT * 128), nullptr}, smem));
  }
  STEPK(2, ph_experts(p, 1));
#if PROBE_KIND == 10
  __syncthreads(); probe_acc = *(volatile LAS unsigned long long*)(smem + 131072 + 256);
#endif
  if (PROBE_KIND >= 0 && blockIdx.x == 0) { const unsigned long long t0_ = __builtin_amdgcn_s_memrealtime(); while (__builtin_amdgcn_s_memrealtime() - t0_ < probe_acc) __builtin_amdgcn_s_sleep(32); }
}

constexpr int N_STEPS = 1 + 4 * 8 + 1 + 4 * 7 + 1;

#ifndef MK_MULTI
#define MK_MULTI 0
#endif

extern "C" void kernel_launch(void* const* d_in, const int* in_sizes, int n_in, void* d_out, int out_size, void* d_ws, size_t ws_size, hipStream_t stream) {
  static int grid = 0;
  if (grid == 0) {
    if (n_in != 24 || out_size != T_ALL * DM || ws_size < WS_END) { fprintf(stderr, "kernel_launch: shape/ws mismatch n_in %d out %d ws %zu need %zu\n", n_in, out_size, ws_size, (size_t)WS_END); grid = -1; return; }
    int dev = 0, cus = 0, per_cu = 0;
    if (hipGetDevice(&dev) != hipSuccess || hipDeviceGetAttribute(&cus, hipDeviceAttributeMultiprocessorCount, dev) != hipSuccess) { grid = -1; return; }
    if (hipFuncSetAttribute((const void*)fwd, hipFuncAttributeMaxDynamicSharedMemorySize, LDS_BYTES) != hipSuccess) { fprintf(stderr, "kernel_launch: hipFuncSetAttribute failed\n"); grid = -1; return; }
    if (hipOccupancyMaxActiveBlocksPerMultiprocessor(&per_cu, (const void*)fwd, NTHR, LDS_BYTES) != hipSuccess || per_cu < 1) { fprintf(stderr, "kernel_launch: occupancy query says %d\n", per_cu); (void)hipGetLastError(); grid = -1; return; }
    grid = cus;
  }
  if (grid < 0) return;
  (void)hipMemsetAsync((char*)d_ws + WS_BAR, 0, XCD_BAR_WORDS * 4, stream);
  Params p{};
  for (int i = 0; i < 24; ++i) p.in[i] = (const float*)d_in[i];
  p.out = (float*)d_out; p.ws = (unsigned char*)d_ws;
#if MK_MULTI
  for (int s = 0; s < N_STEPS; ++s) { p.step_lo = s; p.step_hi = s + 1; hipLaunchKernelGGL(fwd, dim3(grid), dim3(NTHR), LDS_BYTES, stream, p); }
#else
  p.step_lo = 0; p.step_hi = N_STEPS;
  hipLaunchKernelGGL(fwd, dim3(grid), dim3(NTHR), LDS_BYTES, stream, p);
#endif
  const hipError_t le = hipPeekAtLastError();
  if (le != hipSuccess) fprintf(stderr, "kernel_launch: launch failed: %s\n", hipGetErrorName(le));
}

#ifdef PHASE_TEST
#define PT(name, body) __global__ void __launch_bounds__(NTHR, 2) name(Params pk, int mb) { extern __shared__ __attribute__((aligned(16))) char smem[]; Params p = pk; p.wave_u = __builtin_amdgcn_readfirstlane((int)(threadIdx.x >> 6)); body; }
PT(t_prologue, ph_prologue(p, smem))
PT(t_convert, ph_convert_uv(p))
PT(t_norm, ph_norm(p, xin_mb(p, mb), p.in[2], (u16*)(p.ws + WS_H), MBT))
PT(t_gemm_bf16, ph_gemm<EPI_BF16>(p, (u16*)(p.ws + WS_H), (const u16*)(p.ws + WS_WT_EVIN), MBT, 8192, 2048, GemmEpi{p.ws + WS_P, nullptr, 8192, nullptr, nullptr}, smem))
PT(t_gemm_resid, ph_gemm<EPI_RESID>(p, (u16*)(p.ws + WS_H), (const u16*)(p.ws + WS_WT_EVIN), MBT, 2048, 2048, GemmEpi{p.out, p.in[0], 2048, nullptr, nullptr}, smem))
PT(t_l0post, ph_l0_post(p))
PT(t_na, ph_na(p, mb, smem))
PT(t_hg1, ph_hgrn_pass<false>(p, mb, smem))
PT(t_hg3, ph_hgrn_pass<true>(p, mb, smem))
PT(t_carry, ph_hgrn_carry(p, mb))
PT(t_comb, ph_hg_combine(p))
PT(t_topk, ph_topk(p, mb, smem))
PT(t_experts, ph_experts(p, mb))
PT(t_post1, ph_l1_post1(p))
PT(t_post2, ph_l1_post2(p, mb))
PT(t_attn, ph_attn(p, mb, smem))
PT(t_gemm_f32, ph_gemm<EPI_F32>(p, (u16*)(p.ws + WS_H), (const u16*)(p.ws + WS_WT_EVIN), MBT, 2048, 2048, GemmEpi{p.ws + WS_P, nullptr, 2048, nullptr, nullptr}, smem))
#endif
```

```cpp
#include <hip/hip_runtime.h>
#include <stdint.h>
#include <stdio.h>

#define DEVI __device__ __forceinline__
typedef unsigned short u16;
typedef unsigned int u32;
using bf16x8 = __attribute__((ext_vector_type(8))) short;
using s16x4  = __attribute__((ext_vector_type(4))) short;
using f32x4  = __attribute__((ext_vector_type(4))) float;
using f32x16 = __attribute__((ext_vector_type(16))) float;
using u32x4  = __attribute__((ext_vector_type(4))) unsigned;
using u32x2  = __attribute__((ext_vector_type(2))) unsigned;

constexpr int DM = 2048;
constexpr int T_ALL = 65536;
constexpr int MBT = 16384;
constexpr int NMB = 4;
constexpr int NTHR = 512;
constexpr int EVEN_IN = 8192;
constexpr int ODD_IN = 1344, ODD_IN_PAD = 1536;
constexpr float EPS = 1e-6f;

constexpr size_t A256(size_t x) { return (x + 255) / 256 * 256; }
constexpr size_t WS_BAR      = 0;
constexpr size_t WS_WT_EVIN  = 16384;
constexpr size_t WS_WT_EVOUT = WS_WT_EVIN  + (size_t)8192 * 2048 * 2;
constexpr size_t WS_WT_ODIN  = WS_WT_EVOUT + (size_t)2048 * 2048 * 2;
constexpr size_t WS_WT_UQ    = WS_WT_ODIN  + (size_t)1536 * 2048 * 2;
constexpr size_t WS_WT_UKV   = WS_WT_UQ    + (size_t)3072 * 768 * 2;
constexpr size_t WS_WT_ODOUT = WS_WT_UKV   + (size_t)4096 * 512 * 2;
constexpr size_t WS_WEFF     = WS_WT_ODOUT + (size_t)2048 * 2048 * 2;
constexpr size_t WS_ROPE     = WS_WEFF     + (size_t)2 * 2048 * 2048 * 2;
constexpr size_t WS_UB       = WS_ROPE     + (size_t)16384 * 64 * 4;
constexpr size_t WS_VB       = WS_UB       + (size_t)2 * 16384 * 1024;
constexpr size_t WS_IDX      = WS_VB       + (size_t)2 * 16384 * 1024;
constexpr size_t WS_GATE     = WS_IDX      + (size_t)T_ALL * 128 * 4;
constexpr size_t WS_H        = WS_GATE     + (size_t)T_ALL * 128 * 4;
constexpr size_t WS_P        = WS_H        + (size_t)MBT * 2048 * 2;
constexpr size_t WS_MIX      = WS_P        + (size_t)MBT * 8192 * 2;
constexpr size_t WS_E        = WS_MIX      + (size_t)MBT * 2048 * 2;
constexpr size_t WS_DEC      = WS_E        + (size_t)MBT * 1536 * 2;
constexpr size_t WS_OFB      = WS_DEC      + (size_t)64 * 16 * 128 * 4;
constexpr size_t WS_X2B      = WS_OFB      + (size_t)MBT * 3072 * 2;
constexpr size_t WS_RS2      = WS_X2B      + (size_t)T_ALL * 2048 * 2;
constexpr size_t WS_END      = WS_RS2      + (size_t)T_ALL * 4;

constexpr int LDS_BYTES = 131072 + 2048 + 8192;
constexpr int LDS_TK = 131072 + 2048;

struct Params {
  const float* in[24];
  float* out;
  unsigned char* ws;
  int step_lo, step_hi;
  int wave_u, pad_;
};

#define XB_TMO      128
#define XB_XCNT(j)  (256  + 64 * (j))
#define XB_XSUB(j)  (1280 + 64 * (j))
#define XB_XGEN(j)  (2304 + 64 * (j))
#define XB_TOP      3328
#define XB_TOPGEN   3392
#define XCD_BAR_WORDS 3456
#define XB_SPIN_CAP (1u << 18)
#define LAS __attribute__((address_space(3)))

__device__ __forceinline__ unsigned xb_ld(unsigned* p)              { return __hip_atomic_load(p, __ATOMIC_RELAXED, __HIP_MEMORY_SCOPE_AGENT); }
__device__ __forceinline__ unsigned xb_add(unsigned* p, unsigned v) { return __hip_atomic_fetch_add(p, v, __ATOMIC_RELAXED, __HIP_MEMORY_SCOPE_AGENT); }
__device__ __forceinline__ unsigned xb_xcc_id() { return (unsigned)__builtin_amdgcn_s_getreg((3 << 11) | 20) & 0xFu; }
#define XB_SPIN(cond, bar) do { unsigned _sp = 0; while (cond) { __builtin_amdgcn_s_sleep(1); \
    if ((++_sp & 255u) == 0u) { if (xb_ld(&(bar)[XB_TMO])) break; if (_sp > XB_SPIN_CAP) { atomicAdd(&(bar)[XB_TMO], 1u); break; } } } } while (0)

__device__ __forceinline__ bool xb_thread0(int wave_u) { int l; asm volatile("v_mbcnt_lo_u32_b32 %0, -1, 0\n\tv_mbcnt_hi_u32_b32 %0, -1, %0" : "=v"(l)); return wave_u == 0 && l == 0; }
struct XcdBarrier {
    unsigned* bar; unsigned x; int wave_u;
    volatile LAS unsigned* st;
};
__device__ __forceinline__ XcdBarrier xcd_barrier_post(unsigned* bar, volatile LAS unsigned* st, int wave_u) {
    XcdBarrier b; b.bar = bar; b.x = xb_xcc_id(); b.st = st; b.wave_u = wave_u;
    if (xb_thread0(wave_u)) (void)xb_add(&bar[XB_XCNT(b.x)], 1u);
    return b;
}
__device__ __forceinline__ void xcd_barrier_complete(unsigned* bar, unsigned x, unsigned& nloc, unsigned& nx) {
    const unsigned G = gridDim.x * gridDim.y * gridDim.z;
    unsigned sum, cnt, mine, sp = 0u;
    for (;;) {
        sum = 0u; cnt = 0u; mine = 0u;
#pragma unroll
        for (unsigned j = 0; j < 16; ++j) { const unsigned c = xb_ld(&bar[XB_XCNT(j)]); sum += c; cnt += (c > 0u) ? 1u : 0u; mine = (j == x) ? c : mine; }
        if (sum == G) break;
        __builtin_amdgcn_s_sleep(1);
        if ((++sp & 255u) == 0u) { if (xb_ld(&bar[XB_TMO])) break; if (sp > XB_SPIN_CAP) { atomicAdd(&bar[XB_TMO], 1u); break; } }
    }
    nloc = mine > 0u ? mine : 1u; nx = cnt > 0u ? cnt : 1u;
}
__device__ __forceinline__ void xcd_barrier(const XcdBarrier& b) {
    asm volatile("s_waitcnt vmcnt(0)" ::: "memory");
    __syncthreads();
    if (xb_thread0(b.wave_u)) {
        unsigned* bar = b.bar;
        __builtin_amdgcn_s_waitcnt(0);
        unsigned nloc = b.st[0], nx = b.st[1];
        if (nloc == 0u) { xcd_barrier_complete(bar, b.x, nloc, nx); b.st[0] = nloc; b.st[1] = nx; }
        const unsigned old = xb_add(&bar[XB_XSUB(b.x)], 1u);
        const unsigned gen = old / nloc;
        if (old + 1u == (gen + 1u) * nloc) {
            __builtin_amdgcn_fence(__ATOMIC_RELEASE, "agent");
            asm volatile("s_waitcnt vmcnt(0)" ::: "memory");
            const unsigned og = xb_add(&bar[XB_TOP], 1u);
            const unsigned tg = og / nx;
            if (og + 1u == (tg + 1u) * nx) xb_add(&bar[XB_TOPGEN], 1u);
            else XB_SPIN(xb_ld(&bar[XB_TOPGEN]) == tg, bar);
            __builtin_amdgcn_fence(__ATOMIC_ACQUIRE, "agent");
            xb_add(&bar[XB_XGEN(b.x)], 1u);
            asm volatile("s_waitcnt vmcnt(0)" ::: "memory");
        } else {
            XB_SPIN(xb_ld(&bar[XB_XGEN(b.x)]) == gen, bar);
            __builtin_amdgcn_fence(__ATOMIC_ACQUIRE, "agent");
            asm volatile("s_waitcnt vmcnt(0)" ::: "memory");
        }
    }
    __syncthreads();
}

typedef __bf16 bf16x2_t __attribute__((ext_vector_type(2)));
using f32x2_t = __attribute__((ext_vector_type(2))) float;
DEVI unsigned cvtpk(float lo, float hi) { const f32x2_t v = {lo, hi}; const bf16x2_t r = __builtin_convertvector(v, bf16x2_t); return __builtin_bit_cast(unsigned, r); }
DEVI u16 f2bf(float x) { return (u16)(cvtpk(x, 0.f) & 0xffffu); }
DEVI float bf2f(u16 x) { return __uint_as_float(((unsigned)x) << 16); }
DEVI float bflo(unsigned w) { return __uint_as_float(w << 16); }
DEVI float bfhi(unsigned w) { return __uint_as_float(w & 0xffff0000u); }
DEVI int tid_w(int wave_u) { int l; asm volatile("v_mbcnt_lo_u32_b32 %0, -1, 0\n\tv_mbcnt_hi_u32_b32 %0, -1, %0" : "=v"(l)); return (wave_u << 6) | l; }
#define tid_l() tid_w(p.wave_u)
template <int K> DEVI float shx(float v) {
  static_assert(K == 1 || K == 2 || K == 4 || K == 8 || K == 16, "shx");
  if constexpr (K == 1) return __uint_as_float(__builtin_amdgcn_update_dpp(0, __float_as_uint(v), 0xB1, 0xF, 0xF, true));
  else if constexpr (K == 2) return __uint_as_float(__builtin_amdgcn_update_dpp(0, __float_as_uint(v), 0x4E, 0xF, 0xF, true));
  else return __int_as_float(__builtin_amdgcn_ds_swizzle(__float_as_int(v), (K << 10) | 0x1F));
}
DEVI float sum32(float v) { auto r = __builtin_amdgcn_permlane32_swap(__float_as_uint(v), __float_as_uint(v), false, false); return __uint_as_float(r[0]) + __uint_as_float(r[1]); }
DEVI float max32(float v) { auto r = __builtin_amdgcn_permlane32_swap(__float_as_uint(v), __float_as_uint(v), false, false); return fmaxf(__uint_as_float(r[0]), __uint_as_float(r[1])); }
DEVI float bperm(float v, int src_lane) { return __int_as_float(__builtin_amdgcn_ds_bpermute(src_lane << 2, __float_as_int(v))); }
DEVI float wave_sum(float v) {
  v += shx<1>(v); v += shx<2>(v); v += shx<4>(v); v += shx<8>(v); v += shx<16>(v);
  return sum32(v);
}

DEVI void transpose_tile(const Params& p, const float* __restrict__ src, const float* __restrict__ kgain, int K, int N, u16* __restrict__ dst, int tile, float* lds) {
  const int ntk = K / 64;
  const int tk = tile % ntk, tn = tile / ntk;
  const int k0 = tk * 64, n0 = tn * 64;
  const int tid = tid_l();
  __syncthreads();
#pragma unroll
  for (int i = 0; i < 8; ++i) {
    int e = tid + i * NTHR; int kk = e >> 6, nn = e & 63;
    float v = (n0 + nn < N) ? src[(size_t)(k0 + kk) * N + n0 + nn] : 0.f;
    lds[kk * 65 + nn] = v;
  }
  __syncthreads();
#pragma unroll
  for (int i = 0; i < 8; ++i) {
    int e = tid + i * NTHR; int nn = e >> 6, kk = e & 63;
    dst[(size_t)(n0 + nn) * K + k0 + kk] = f2bf(lds[kk * 65 + nn] * (kgain ? kgain[k0 + kk] : 1.f));
  }
}

DEVI void ph_prologue(const Params& p, char* smem) {
  float* lds = (float*)smem;
  const int G = gridDim.x, b = blockIdx.x, tid = tid_l();
#define TJOB(srcp, K_, N_, NP_, OFF_, KG_) do { const int nt_ = ((K_) / 64) * ((NP_) / 64); \
    _Pragma("unroll 1") for (int t = b; t < nt_; t += G) transpose_tile(p, srcp, KG_, K_, N_, (u16*)(p.ws + (OFF_)), t, lds); } while (0)
  TJOB(p.in[3],  2048, 8192, 8192, WS_WT_EVIN, (const float*)nullptr);
  TJOB(p.in[9],  2048, 2048, 2048, WS_WT_EVOUT, (const float*)nullptr);
  TJOB(p.in[11], 2048, ODD_IN, ODD_IN_PAD, WS_WT_ODIN, p.in[10]);
  TJOB(p.in[14], 768,  3072, 3072, WS_WT_UQ, (const float*)nullptr);
  TJOB(p.in[15], 512,  4096, 4096, WS_WT_UKV, (const float*)nullptr);
  TJOB(p.in[18], 2048, 2048, 2048, WS_WT_ODOUT, (const float*)nullptr);
#undef TJOB
  __syncthreads();
  {
    float* sk = lds;
    float* wq = lds + 128 * 129;
#pragma unroll 1
    for (int job = b; job < 2 * 16 * 32; job += G) {
      const int l = job / 512, hp = (job / 32) % 16, kt = job % 32, k0 = kt * 64;
      const float* SK = p.in[21] + ((size_t)(l * 16 + hp) * 128) * 128;
      const float* WQ = p.in[20] + (size_t)l * 2048 * 2048;
      __syncthreads();
      for (int e = tid; e < 128 * 128; e += NTHR) sk[(e >> 7) * 129 + (e & 127)] = SK[e];
      for (int e = tid; e < 64 * 128; e += NTHR) { int kk = e >> 7, d = e & 127; wq[kk * 129 + d] = WQ[(size_t)(k0 + kk) * 2048 + hp * 128 + d]; }
      __syncthreads();
      const int kk = tid & 63, ng = tid >> 6;
      const float gk = p.in[19][l * DM + k0 + kk];
      float acc[16];
#pragma unroll
      for (int i = 0; i < 16; ++i) acc[i] = 0.f;
#pragma unroll 4
      for (int d = 0; d < 128; ++d) {
        const float w = wq[kk * 129 + d];
#pragma unroll
        for (int i = 0; i < 16; ++i) acc[i] += sk[(ng * 16 + i) * 129 + d] * w;
      }
      u16* dst = (u16*)(p.ws + WS_WEFF) + (size_t)l * 2048 * 2048;
#pragma unroll
      for (int i = 0; i < 16; ++i) dst[(size_t)(hp * 128 + ng * 16 + i) * 2048 + k0 + kk] = f2bf(acc[i] * gk);
    }
  }
  {
    float* rc = (float*)(p.ws + WS_ROPE);
    for (int e = b * NTHR + tid; e < 16384 * 32; e += G * NTHR) {
      const int pos = e >> 5, i = e & 31;
      const float inv = 1.0f / powf(10000.f, (float)(2 * i) / 64.f);
      const float ang = (float)pos * inv;
      float s, c; sincosf(ang, &s, &c);
      rc[e] = c; rc[16384 * 32 + e] = s;
    }
  }
}

constexpr float U_SCALE = 90.f, V_SCALE = 22.5f;
constexpr int EROW = 1536, UROW = 1024;
using f32x16v = __attribute__((ext_vector_type(16))) float;
using f32x32v = __attribute__((ext_vector_type(32))) float;
using u32x6 = __attribute__((ext_vector_type(6))) unsigned;
DEVI void ph_convert_uv(const Params& p) {
  const size_t nitem = (size_t)2 * 2 * 16384 * 64;
#pragma unroll 1
  for (size_t i = (size_t)blockIdx.x * NTHR + tid_l(); i < nitem; i += (size_t)gridDim.x * NTHR) {
    const int l = (int)(i & 63); const size_t row = (i >> 6) & 32767; const bool isu = (i >> 21) == 0;
    const float* src = (isu ? p.in[22] : p.in[23]) + row * 2048 + l * 16;
    const float sc = isu ? U_SCALE : V_SCALE;
    f32x16v a, b;
#pragma unroll
    for (int k = 0; k < 4; ++k) {
      const f32x4 x0 = *(const f32x4*)(src + k * 4), x1 = *(const f32x4*)(src + 1024 + k * 4);
#pragma unroll
      for (int e = 0; e < 4; ++e) { a[k * 4 + e] = x0[e] * sc; b[k * 4 + e] = x1[e] * sc; }
    }
    {
      u32x4 w4;
#pragma unroll
      for (int d = 0; d < 4; ++d) {
        unsigned w = 0u;
        w = __builtin_amdgcn_cvt_scalef32_pk_fp4_f32(w, a[d * 4 + 0], b[d * 4 + 0], 1.0f, 0);
        w = __builtin_amdgcn_cvt_scalef32_pk_fp4_f32(w, a[d * 4 + 1], b[d * 4 + 1], 1.0f, 1);
        w = __builtin_amdgcn_cvt_scalef32_pk_fp4_f32(w, a[d * 4 + 2], b[d * 4 + 2], 1.0f, 2);
        w = __builtin_amdgcn_cvt_scalef32_pk_fp4_f32(w, a[d * 4 + 3], b[d * 4 + 3], 1.0f, 3);
        w4[d] = w;
      }
      *(u32x4*)(p.ws + (isu ? WS_UB : WS_VB) + row * UROW + l * 16) = w4;
    }
  }
}

DEVI void ph_copy_x(const Params& p) {
  const size_t n4 = (size_t)T_ALL * DM / 4, h4 = n4 / 2;
  const f32x4* a = (const f32x4*)p.in[0]; const f32x4* c = (const f32x4*)p.in[1];
  f32x4* o = (f32x4*)p.out;
  for (size_t i = (size_t)blockIdx.x * NTHR + threadIdx.x; i < n4; i += (size_t)gridDim.x * NTHR)
    o[i] = (i < h4) ? a[i] : c[i - h4];
}


constexpr int G_BK = 64, G_HALF = 128, G_HT = G_HALF * G_BK;
DEVI int g_lds_byte(int r, int c) {
  int st = (r >> 4) * 2 + (c >> 5), rr = r & 15, cc = c & 31, ob = rr * 64 + cc * 2;
  return st * 1024 + (ob ^ (((ob >> 9) & 1) << 5));
}
DEVI void g_stage_rc(int b, int& R, int& C) {
  int st = b / 1024, sb = b % 1024, swz = sb ^ (((sb >> 9) & 1) << 5);
  R = (st >> 1) * 16 + swz / 64; C = (st & 1) * 32 + (swz % 64) / 2;
}
enum { EPI_BF16 = 0, EPI_F32 = 1, EPI_RESID = 2, EPI_RESID_B = 3, EPI_BF16_RS = 4, EPI_RES_F2B = 5, EPI_RES_B2B = 6, EPI_TOPK = 7 };
struct GemmEpi { void* out; const float* resid; int ldc; u16* out2; const float* rs; };

DEVI void topk_from_lds(const Params& p, char* tile, int tok0, int head, int* IDX, float* GATE, char* smem);
template <int EPI>
DEVI void gemm_tile(const Params& p, const u16* __restrict__ A, const u16* __restrict__ Bt, const int K, const int brow, const int bcol, const GemmEpi ep, char* smem) {
  u16* shm = (u16*)smem;
#define SA(b,h) (shm+((b)*2+(h))*G_HT)
#define SB(b,h) (shm+(4+(b)*2+(h))*G_HT)
#define STAGE_X(T,P,BASE,br,kt) do{long _g=(long)(br)*K+(long)(kt)*G_BK; \
    for(int _i=0;_i<2;++_i){int _b=(T)*16+_i*8192;int _r,_c;g_stage_rc(_b,_r,_c); \
      __builtin_amdgcn_global_load_lds((const unsigned*)(BASE+_g+(long)_r*K+_c), \
        (LAS unsigned*)((char*)(P)+_b),16,0,0);}}while(0)
#define STAGE(P,BASE,br,kt) STAGE_X(tid0,P,BASE,br,kt)
#define LDA(dst,b,h) for(int m=0;m<4;++m)for(int k=0;k<2;++k) \
    dst[m][k]=*reinterpret_cast<const bf16x8*>((char*)SA(b,h)+g_lds_byte(wr*64+m*16+fr,k*32+fq*8))
#define LDB(dst,b,h) for(int n=0;n<2;++n)for(int k=0;k<2;++k) \
    dst[n][k]=*reinterpret_cast<const bf16x8*>((char*)SB(b,h)+g_lds_byte(wc*32+n*16+fr,k*32+fq*8))
#define MMA(ai,bj,At_,Bt_) do{__builtin_amdgcn_s_setprio(1); \
    for(int m=0;m<4;++m)for(int n=0;n<2;++n)for(int k=0;k<2;++k) \
      acc[ai][bj][m][n]=__builtin_amdgcn_mfma_f32_16x16x32_bf16(Bt_[n][k],At_[m][k],acc[ai][bj][m][n],0,0,0); \
    __builtin_amdgcn_s_setprio(0);}while(0)
#define WAIT_V(n) asm volatile("s_waitcnt vmcnt(" #n ")":::"memory")
#define WAIT_L(n) asm volatile("s_waitcnt lgkmcnt(" #n ")":::"memory")
#define BAR __builtin_amdgcn_s_barrier()
#define SCHED __builtin_amdgcn_sched_barrier(0)
  const int tid0=tid_l();
  int wid=tid0>>6,lane=tid0&63,wr=wid>>2,wc=wid&3,fr=lane&15,fq=lane>>4;
  f32x4 acc[2][2][4][2]={};
  bf16x8 At[4][2],B0[2][2],B1[2][2];
  const int nt=K/G_BK;
  STAGE(SB(0,0),Bt,bcol,0); STAGE(SA(0,0),A,brow,0);
  STAGE(SB(0,1),Bt,bcol+G_HALF,0); STAGE(SA(0,1),A,brow+G_HALF,0);
  if(wr==1)BAR;
  WAIT_V(4); BAR;
  STAGE(SB(1,0),Bt,bcol,1); STAGE(SA(1,0),A,brow,1); STAGE(SB(1,1),Bt,bcol+G_HALF,1);
  WAIT_V(6); BAR;
#pragma unroll 1
  for(int t=0;t<nt-2;t+=2){
    LDB(B0,0,0); SCHED; LDA(At,0,0); STAGE(SA(1,1),A,brow+G_HALF,t+1);
    WAIT_L(8); BAR; WAIT_L(0); MMA(0,0,At,B0); BAR; SCHED;
    LDB(B1,0,1); STAGE(SB(0,0),Bt,bcol,t+2);
    BAR; WAIT_L(0); MMA(0,1,At,B1); BAR;
    LDA(At,0,1); STAGE(SA(0,0),A,brow,t+2);
    BAR; WAIT_L(0); MMA(1,0,At,B0); BAR; SCHED;
    STAGE(SB(0,1),Bt,bcol+G_HALF,t+2);
    WAIT_V(6); BAR; MMA(1,1,At,B1); BAR;
    LDB(B0,1,0); SCHED; LDA(At,1,0); STAGE(SA(0,1),A,brow+G_HALF,t+2);
    WAIT_L(8); BAR; WAIT_L(0); MMA(0,0,At,B0); BAR; SCHED;
    LDB(B1,1,1); STAGE(SB(1,0),Bt,bcol,t+3);
    BAR; WAIT_L(0); MMA(0,1,At,B1); BAR;
    LDA(At,1,1); STAGE(SA(1,0),A,brow,t+3);
    BAR; WAIT_L(0); MMA(1,0,At,B0); BAR; SCHED;
    STAGE(SB(1,1),Bt,bcol+G_HALF,t+3);
    WAIT_V(6); BAR; MMA(1,1,At,B1); BAR;
  }
  int tz=tid_l(); wid=tz>>6; lane=tz&63; wr=wid>>2; wc=wid&3; fr=lane&15; fq=lane>>4;
  { LDB(B0,0,0); WAIT_V(0); LDA(At,0,0); STAGE_X(tz,SA(1,1),A,brow+G_HALF,nt-1);
    BAR; WAIT_L(0); MMA(0,0,At,B0); BAR;
    LDB(B1,0,1); BAR; WAIT_L(0); MMA(0,1,At,B1); BAR;
    LDA(At,0,1); WAIT_V(4); BAR; WAIT_L(0); MMA(1,0,At,B0); MMA(1,1,At,B1); BAR; }
  { LDB(B0,1,0); LDA(At,1,0); WAIT_V(2); BAR; WAIT_L(0); MMA(0,0,At,B0); BAR;
    LDB(B1,1,1); WAIT_V(0); BAR; WAIT_L(0); MMA(0,1,At,B1); BAR;
    LDA(At,1,1); BAR; WAIT_L(0); MMA(1,0,At,B0); MMA(1,1,At,B1); BAR; }
  if(wr==0)BAR;
  if constexpr (EPI==EPI_TOPK) {
#if defined(PROBE_KIND) && PROBE_KIND == 10
    const unsigned long long tp0_ = __builtin_amdgcn_s_memrealtime();
#endif
#pragma unroll
    for(int ai=0;ai<2;++ai){
      __syncthreads();
#pragma unroll
      for(int m=0;m<4;++m){
        const int r=wr*64+m*16+fr;
#pragma unroll
        for(int bj=0;bj<2;++bj)
#pragma unroll
        for(int n=0;n<2;++n){
          const int ch=(bj*G_HALF+wc*32+n*16+fq*4)>>2;
          *(f32x4*)(smem+r*1024+((ch^(r&15))<<4))=acc[ai][bj][m][n];
        }
      }
      __syncthreads();
      topk_from_lds(p,smem,brow+ai*G_HALF,bcol>>8,(int*)ep.out,(float*)ep.out2,smem);
    }
    __syncthreads();
#if defined(PROBE_KIND) && PROBE_KIND == 10
    if (tid_l() == 0) { volatile LAS unsigned long long* a_ = (volatile LAS unsigned long long*)(smem + 131072 + 256); *a_ = *a_ + (__builtin_amdgcn_s_memrealtime() - tp0_); }
#endif
    return;
  }
#pragma unroll
  for(int ai=0;ai<2;++ai)
#pragma unroll
  for(int m=0;m<4;++m){
    const long row=brow+ai*G_HALF+wr*64+m*16+fr;
#pragma unroll
    for(int bj=0;bj<2;++bj)
#pragma unroll
    for(int n=0;n<2;++n){
      const int col=bcol+bj*G_HALF+wc*32+n*16+fq*4;
      const f32x4 v=acc[ai][bj][m][n];
      if constexpr (EPI==EPI_BF16) {
        u32x2 w={cvtpk(v[0],v[1]),cvtpk(v[2],v[3])};
        *(u32x2*)((u16*)ep.out+row*ep.ldc+col)=w;
      } else if constexpr (EPI==EPI_BF16_RS) {
        const float sc=ep.rs[row];
        u32x2 w={cvtpk(v[0]*sc,v[1]*sc),cvtpk(v[2]*sc,v[3]*sc)};
        *(u32x2*)((u16*)ep.out+row*ep.ldc+col)=w;
      } else if constexpr (EPI==EPI_RESID_B) {
        const f32x4 r=*(const f32x4*)(ep.resid+row*ep.ldc+col);
        const f32x4 y=r+v;
        *(f32x4*)((float*)ep.out+row*ep.ldc+col)=y;
        u32x2 w={cvtpk(y[0],y[1]),cvtpk(y[2],y[3])};
        *(u32x2*)(ep.out2+row*ep.ldc+col)=w;
      } else if constexpr (EPI==EPI_RES_F2B) {
        const f32x4 r=*(const f32x4*)(ep.resid+row*ep.ldc+col);
        const f32x4 y=r+v;
        *(u32x2*)(ep.out2+row*ep.ldc+col)=(u32x2){cvtpk(y[0],y[1]),cvtpk(y[2],y[3])};
      } else if constexpr (EPI==EPI_RES_B2B) {
        const u32x2 rb=*(const u32x2*)(ep.out2+row*ep.ldc+col);
        *(u32x2*)(ep.out2+row*ep.ldc+col)=(u32x2){cvtpk(bflo(rb[0])+v[0],bfhi(rb[0])+v[1]),cvtpk(bflo(rb[1])+v[2],bfhi(rb[1])+v[3])};
      } else if constexpr (EPI==EPI_F32) {
        *(f32x4*)((float*)ep.out+row*ep.ldc+col)=v;
      } else {
        const f32x4 r=*(const f32x4*)(ep.resid+row*ep.ldc+col);
        *(f32x4*)((float*)ep.out+row*ep.ldc+col)=r+v;
      }
    }
  }
#undef SA
#undef SB
#undef STAGE_X
#undef STAGE
#undef LDA
#undef LDB
#undef MMA
#undef BAR
#undef SCHED
}
DEVI void g_tile_map(int t, int nM, int nN, int& pm, int& pn) {
  const int nwg = nM * nN;
  int wgid = t;
  { int q = nwg / 8, r = nwg % 8, xcd = wgid % 8, off = wgid / 8;
    wgid = (xcd < r ? xcd * (q + 1) : r * (q + 1) + (xcd - r) * q) + off; }
  const int WGM = 8;
  int nig = WGM * nN, gid = wgid / nig, fm = gid * WGM, gsz = min(nM - fm, WGM);
  pm = fm + ((wgid % nig) % gsz); pn = (wgid % nig) / gsz;
}
template <int EPI>
DEVI void ph_gemm(const Params& p, const u16* A, const u16* Bt, int M, int N, int K, GemmEpi ep, char* smem) {
  const int nM = M / 256, nN = N / 256, ntile = nM * nN;
#pragma unroll 1
  for (int t = blockIdx.x; t < ntile; t += gridDim.x) {
    int pm, pn; g_tile_map(t, nM, nN, pm, pn);
    gemm_tile<EPI>(p, A, Bt, K, pm * 256, pn * 256, ep, smem);
  }
}

DEVI int g_perm32(int rho) { const int n = rho >> 4, i = rho & 15; return 8 * (i >> 2) + 4 * n + (i & 3); }
template <int EPI>
DEVI void g_epi_perm(const f32x4 (&acc)[2][2][4][2], const GemmEpi& ep, const int brow, const int bcol, const int wr, const int wc, const int fr, const int fq) {
#pragma unroll
  for (int ai = 0; ai < 2; ++ai)
#pragma unroll
  for (int m = 0; m < 4; ++m) {
    const long row = brow + ai * G_HALF + wr * 64 + m * 16 + fr;
    float sc = 1.f;
    if constexpr (EPI == EPI_BF16_RS) sc = ep.rs[row];
#pragma unroll
    for (int bj = 0; bj < 2; ++bj) {
      const int col = bcol + wc * 64 + bj * 32 + fq * 8;
      f32x4 v0 = acc[ai][bj][m][0], v1 = acc[ai][bj][m][1];
      if constexpr (EPI == EPI_BF16) {
        *(u32x4*)((u16*)ep.out + row * ep.ldc + col) = (u32x4){cvtpk(v0[0], v0[1]), cvtpk(v0[2], v0[3]), cvtpk(v1[0], v1[1]), cvtpk(v1[2], v1[3])};
      } else if constexpr (EPI == EPI_BF16_RS) {
        *(u32x4*)((u16*)ep.out + row * ep.ldc + col) = (u32x4){cvtpk(v0[0] * sc, v0[1] * sc), cvtpk(v0[2] * sc, v0[3] * sc), cvtpk(v1[0] * sc, v1[1] * sc), cvtpk(v1[2] * sc, v1[3] * sc)};
      } else if constexpr (EPI == EPI_RES_F2B) {
        const f32x4 r0 = *(const f32x4*)(ep.resid + row * ep.ldc + col), r1 = *(const f32x4*)(ep.resid + row * ep.ldc + col + 4);
        v0 += r0; v1 += r1;
        *(u32x4*)(ep.out2 + row * ep.ldc + col) = (u32x4){cvtpk(v0[0], v0[1]), cvtpk(v0[2], v0[3]), cvtpk(v1[0], v1[1]), cvtpk(v1[2], v1[3])};
      } else {
        const u32x4 rb = *(const u32x4*)(ep.out2 + row * ep.ldc + col);
        *(u32x4*)(ep.out2 + row * ep.ldc + col) = (u32x4){cvtpk(bflo(rb[0]) + v0[0], bfhi(rb[0]) + v0[1]), cvtpk(bflo(rb[1]) + v0[2], bfhi(rb[1]) + v0[3]),
                                                          cvtpk(bflo(rb[2]) + v1[0], bfhi(rb[2]) + v1[1]), cvtpk(bflo(rb[3]) + v1[2], bfhi(rb[3]) + v1[3])};
      }
    }
    if constexpr (EPI == EPI_RES_F2B || EPI == EPI_RES_B2B) asm volatile("" ::: "memory");
  }
}
template <int EPI>
DEVI void ph_gemm_stream(const Params& p, const u16* __restrict__ A, const u16* __restrict__ Bt, const int M, const int N, const int K, const GemmEpi ep, char* smem) {
  const int nM = M / 256, nN = N / 256, ntile = nM * nN, G = gridDim.x;
  if ((int)blockIdx.x >= ntile) return;
  LAS unsigned char* lds = (LAS unsigned char*)smem;
  const int tid = tid_l(), wid = p.wave_u, lane = tid & 63, wr = wid >> 2, wc = wid & 3, fr = lane & 15, fq = lane >> 4;
  const int nt = K / G_BK;
  constexpr int HTB = G_HT * 2;
  unsigned voffA[2], voffB[2];
#pragma unroll
  for (int i = 0; i < 2; ++i) { int R, C; g_stage_rc(tid * 16 + i * 8192, R, C); const int Rb = (R >> 5) * 64 + g_perm32(R & 31);
    voffA[i] = (unsigned)(R * K + C) * 2u; voffB[i] = (unsigned)(Rb * K + C) * 2u; }
  const size_t kstep = (size_t)(G_BK * 2), hstep = (size_t)G_HALF * K * 2, tstep = 2 * hstep, hstepB = (size_t)32 * K * 2;
  const unsigned ldsw = (unsigned)wid * 1024u;
  const int aoff = g_lds_byte(wr * 64 + fr, fq * 8), boff = g_lds_byte(wc * 32 + fr, fq * 8);
#define QSA(b, h) (((b) * 2 + (h)) * HTB)
#define QSB(b, h) ((4 + (b) * 2 + (h)) * HTB)
#define QSTAGE(bufoff, gbase, voff) do { _Pragma("unroll") for (int _i = 0; _i < 2; ++_i) \
    __builtin_amdgcn_global_load_lds((const unsigned*)((const char*)(gbase) + (voff)[_i]), (LAS unsigned*)(lds + (bufoff) + ldsw + _i * 8192), 16, 0, 0); } while (0)
#define QLDA(dst, b, h) do { _Pragma("unroll") for (int m = 0; m < 4; ++m) _Pragma("unroll") for (int k = 0; k < 2; ++k) dst[m][k] = *(const LAS bf16x8*)(lds + QSA(b, h) + aoff + m * 2048 + k * 1024); } while (0)
#define QLDB(dst, b, h) do { _Pragma("unroll") for (int n = 0; n < 2; ++n) _Pragma("unroll") for (int k = 0; k < 2; ++k) dst[n][k] = *(const LAS bf16x8*)(lds + QSB(b, h) + boff + n * 2048 + k * 1024); } while (0)
#define QMMA(ai, bj, At_, Bt_) do { __builtin_amdgcn_s_setprio(1); _Pragma("unroll") for (int m = 0; m < 4; ++m) _Pragma("unroll") for (int n = 0; n < 2; ++n) _Pragma("unroll") for (int k = 0; k < 2; ++k) \
    acc[ai][bj][m][n] = __builtin_amdgcn_mfma_f32_16x16x32_bf16(Bt_[n][k], At_[m][k], acc[ai][bj][m][n], 0, 0, 0); __builtin_amdgcn_s_setprio(0); } while (0)
#define QWAIT_V(n) asm volatile("s_waitcnt vmcnt(" #n ")" ::: "memory")
#define QWAIT_L(n) asm volatile("s_waitcnt lgkmcnt(" #n ")" ::: "memory")
#define QBAR __builtin_amdgcn_s_barrier()
#define QSCHED __builtin_amdgcn_sched_barrier(0)
  int ui = 0, cpm, cpn, npm = 0, npn = 0;
  g_tile_map(blockIdx.x, nM, nN, cpm, cpn);
  f32x4 acc[2][2][4][2];
#pragma unroll
  for (int a = 0; a < 2; ++a)
#pragma unroll
  for (int b = 0; b < 2; ++b)
#pragma unroll
  for (int m = 0; m < 4; ++m)
#pragma unroll
  for (int n = 0; n < 2; ++n) acc[a][b][m][n] = (f32x4){0.f, 0.f, 0.f, 0.f};
  bf16x8 At[4][2], B0[2][2], B1[2][2];
  const char* cA = (const char*)A + (size_t)cpm * tstep; const char* cB = (const char*)Bt + (size_t)cpn * tstep;
  __syncthreads();
  QSTAGE(QSB(0, 0), cB, voffB); QSTAGE(QSA(0, 0), cA, voffA); QSTAGE(QSB(0, 1), cB + hstepB, voffB); QSTAGE(QSA(0, 1), cA + hstep, voffA);
  if (wr == 1) QBAR;
  QWAIT_V(4); QBAR;
  QSTAGE(QSB(1, 0), cB + kstep, voffB); QSTAGE(QSA(1, 0), cA + kstep, voffA); QSTAGE(QSB(1, 1), cB + hstepB + kstep, voffB);
  QWAIT_V(6); QBAR;
#pragma unroll 1
  for (;;) {
    const int tn = (int)blockIdx.x + (ui + 1) * G;
    const bool has_next = tn < ntile;
    if (has_next) g_tile_map(tn, nM, nN, npm, npn);
    const char* nA = has_next ? (const char*)A + (size_t)npm * tstep : cA; const char* nB = has_next ? (const char*)Bt + (size_t)npn * tstep : cB;
#pragma unroll 1
    for (int t = 0; t < nt; t += 2) {
      const bool last = (t == nt - 2);
      const char* a1 = cA + (size_t)(t + 1) * kstep;
      const char* a2 = last ? nA : cA + (size_t)(t + 2) * kstep; const char* b2 = last ? nB : cB + (size_t)(t + 2) * kstep;
      const char* a3 = a2 + kstep; const char* b3 = b2 + kstep;
      QLDB(B0, 0, 0); QSCHED; QLDA(At, 0, 0); QSTAGE(QSA(1, 1), a1 + hstep, voffA);
      QWAIT_L(8); QBAR; QWAIT_L(0); QMMA(0, 0, At, B0); QBAR; QSCHED;
      QLDB(B1, 0, 1); QSTAGE(QSB(0, 0), b2, voffB);
      QBAR; QWAIT_L(0); QMMA(0, 1, At, B1); QBAR;
      QLDA(At, 0, 1); QSTAGE(QSA(0, 0), a2, voffA);
      QBAR; QWAIT_L(0); QMMA(1, 0, At, B0); QBAR; QSCHED;
      QSTAGE(QSB(0, 1), b2 + hstepB, voffB);
      QWAIT_V(6); QBAR; QMMA(1, 1, At, B1); QBAR;
      QLDB(B0, 1, 0); QSCHED; QLDA(At, 1, 0); QSTAGE(QSA(0, 1), a2 + hstep, voffA);
      QWAIT_L(8); QBAR; QWAIT_L(0); QMMA(0, 0, At, B0); QBAR; QSCHED;
      QLDB(B1, 1, 1); QSTAGE(QSB(1, 0), b3, voffB);
      QBAR; QWAIT_L(0); QMMA(0, 1, At, B1); QBAR;
      QLDA(At, 1, 1); QSTAGE(QSA(1, 0), a3, voffA);
      QBAR; QWAIT_L(0); QMMA(1, 0, At, B0); QBAR; QSCHED;
      QSTAGE(QSB(1, 1), b3 + hstepB, voffB);
      QWAIT_V(6); QBAR; QMMA(1, 1, At, B1); QBAR;
    }
    g_epi_perm<EPI>(acc, ep, cpm * 256, cpn * 256, wr, wc, fr, fq);
    if (!has_next) break;
#pragma unroll
    for (int a = 0; a < 2; ++a)
#pragma unroll
    for (int b = 0; b < 2; ++b)
#pragma unroll
    for (int m = 0; m < 4; ++m)
#pragma unroll
    for (int n = 0; n < 2; ++n) acc[a][b][m][n] = (f32x4){0.f, 0.f, 0.f, 0.f};
    cpm = npm; cpn = npn; cA = nA; cB = nB; ++ui;
  }
  QWAIT_V(0);
  if (wr == 0) QBAR;
  QBAR;
#undef QSA
#undef QSB
#undef QSTAGE
#undef QLDA
#undef QLDB
#undef QMMA
#undef QWAIT_V
#undef QWAIT_L
#undef QBAR
#undef QSCHED
}

DEVI void ph_norm(const Params& p, const float* __restrict__ x, const float* __restrict__ gain, u16* __restrict__ out, int nrows) {
  const int tid = tid_l(); const int lane = tid & 63, gw = blockIdx.x * 8 + (tid >> 6), nw = gridDim.x * 8;
  f32x4 g[8];
#pragma unroll
  for (int c = 0; c < 8; ++c) g[c] = *(const f32x4*)(gain + c * 256 + lane * 4);
  f32x4 v[8], vn[8];
  if (gw < nrows) {
#pragma unroll
    for (int c = 0; c < 8; ++c) v[c] = *(const f32x4*)(x + (size_t)gw * DM + c * 256 + lane * 4);
  }
#pragma unroll 1
  for (int r = gw; r < nrows; r += nw) {
    if (r + nw < nrows) {
#pragma unroll
      for (int c = 0; c < 8; ++c) vn[c] = *(const f32x4*)(x + (size_t)(r + nw) * DM + c * 256 + lane * 4);
    }
    float ss = 0.f;
#pragma unroll
    for (int c = 0; c < 8; ++c) ss += v[c][0]*v[c][0] + v[c][1]*v[c][1] + v[c][2]*v[c][2] + v[c][3]*v[c][3];
    ss = wave_sum(ss);
    const float rstd = rsqrtf(ss * (1.f / DM) + EPS);
#pragma unroll
    for (int c = 0; c < 8; ++c) {
      u32x2 w = {cvtpk(v[c][0] * rstd * g[c][0], v[c][1] * rstd * g[c][1]), cvtpk(v[c][2] * rstd * g[c][2], v[c][3] * rstd * g[c][3])};
      *(u32x2*)(out + (size_t)r * DM + c * 256 + lane * 4) = w;
    }
#pragma unroll
    for (int c = 0; c < 8; ++c) v[c] = vn[c];
  }
}

DEVI const float* xin_mb(const Params& p, int mb) { return (mb < 2 ? p.in[0] : p.in[1]) + (size_t)(mb & 1) * MBT * DM; }
DEVI float frcp(float x) { return __builtin_amdgcn_rcpf(x); }
DEVI float sigmoidf_(float x) { return frcp(1.f + __expf(-x)); }

DEVI void l0_post_item(u32x4 w, int seg, int ch, const float* qg, const float* kg, const float* lbl, u32x4& o) {
  float v[8];
#pragma unroll
  for (int j = 0; j < 4; ++j) { v[2*j] = bflo(w[j]); v[2*j+1] = bfhi(w[j]); }
  if (seg <= 1) {
    float ss = 0.f;
#pragma unroll
    for (int j = 0; j < 8; ++j) ss += v[j] * v[j];
    ss += shx<1>(ss); ss += shx<2>(ss); ss += shx<4>(ss); ss += shx<8>(ss);
    const float rstd = rsqrtf(ss * (1.f / 128.f) + EPS);
    const float* g = (seg == 0 ? qg : kg) + (ch & 15) * 8;
#pragma unroll
    for (int j = 0; j < 8; ++j) v[j] = v[j] * rstd * g[j];
  } else if (seg == 3 || seg == 7) {
#pragma unroll
    for (int j = 0; j < 8; ++j) v[j] = v[j] * sigmoidf_(v[j]);
  } else {
    const int dir = seg - 4; const int k0 = (ch & 127) * 8;
#pragma unroll
    for (int j = 0; j < 8; ++j) {
      const float l0 = lbl[(dir * 2 + 0) * 1024 + k0 + j], l1 = lbl[(dir * 2 + 1) * 1024 + k0 + j];
      const float lb = 1.f / (1.f + __expf(l1 - l0));
      const float f = lb + (1.f - lb) * (1.f / (1.f + __expf(-v[j])));
      v[j] = __logf(f);
    }
  }
  o = (u32x4){cvtpk(v[0], v[1]), cvtpk(v[2], v[3]), cvtpk(v[4], v[5]), cvtpk(v[6], v[7])};
}
DEVI void ph_l0_post(const Params& p) {
  u16* P = (u16*)(p.ws + WS_P);
  const float* qg = p.in[4]; const float* kg = p.in[5]; const float* lbl = p.in[7];
  const size_t total = (size_t)MBT * 768, gs = (size_t)gridDim.x * NTHR;
#pragma unroll 1
  for (size_t it0 = (size_t)blockIdx.x * NTHR + tid_l(); it0 < total; it0 += 4 * gs) {
    u32x4 w[4]; u16* ptr[4]; int seg[4], ch[4]; bool ok[4];
#pragma unroll
    for (int j = 0; j < 4; ++j) {
      const size_t it = it0 + j * gs; ok[j] = it < total;
      const unsigned tok = (unsigned)it / 768u; const int r = (int)((unsigned)it - tok * 768u); const int s6 = r >> 7; ch[j] = r & 127;
      seg[j] = s6 + (s6 >= 2) + (s6 >= 5);
      ptr[j] = P + (size_t)tok * 8192 + seg[j] * 1024 + ch[j] * 8;
      if (ok[j]) w[j] = *(const u32x4*)ptr[j];
    }
#pragma unroll
    for (int j = 0; j < 4; ++j) if (ok[j]) { u32x4 o; l0_post_item(w[j], seg[j], ch[j], qg, kg, lbl, o); *(u32x4*)ptr[j] = o; }
  }
}

template <int OFF> DEVI s16x4 tr_read(int vb) {
  return __builtin_amdgcn_ds_read_tr16_b64_v4i16((LAS s16x4*)(unsigned)(vb + OFF));
}
template <int OFF> DEVI s16x4 tr_read_asm(int vb) {
  s16x4 r; asm volatile("ds_read_b64_tr_b16 %0, %1 offset:%2" : "=&v"(r) : "v"(vb), "i"(OFF) : "memory"); return r;
}
template <int OFF0, int OFF1> DEVI bf16x8 tr_read2w(int vb) {
  const s16x4 a = tr_read<OFF0>(vb), b = tr_read<OFF1>(vb);
  return (bf16x8){a[0], a[1], a[2], a[3], b[0], b[1], b[2], b[3]};
}
DEVI bf16x8 pk44(s16x4 l, s16x4 h) { return (bf16x8){l[0], l[1], l[2], l[3], h[0], h[1], h[2], h[3]}; }

DEVI void ph_na(const Params& p, int mb, char* smem) {
  const u16* P = (const u16*)(p.ws + WS_P);
  u16* MIX = (u16*)(p.ws + WS_MIX);
  const float* rpb = p.in[6];
  const int S = (mb < 2) ? 2048 : 16384; const int rows = S / 64;
  const int nunits = (MBT / 64) * 4;
#pragma unroll 1
  for (int u = blockIdx.x; u < nunits; u += gridDim.x) {
    const int tid = tid_l(), wid = tid >> 6, lane = tid & 63, fr = lane & 15, fq = lane >> 4;
    char* vl = smem + wid * 9216;
    const int vlb = (int)(uintptr_t)vl + (fq * 4 + (fr >> 2)) * 288 + (fr & 3) * 8;
    const int hp = u & 3, rowg = u >> 2;
    const int j = wid & 3, h = hp * 2 + (wid >> 2);
    const int seqrow0 = (rowg / rows) * rows;
    const int r = rowg - seqrow0;
    const int r0 = min(max(r - 4, 0), rows - 8);
    const int kc0 = min(max(j * 16 - 8, 0), 32);
    const size_t qtok = (size_t)rowg * 64 + j * 16 + fr;
    bf16x8 qf[4];
    {
      u32x4 qw[4]; float ssq = 0.f;
#pragma unroll
      for (int ks = 0; ks < 4; ++ks) { qw[ks] = *(const u32x4*)(P + qtok * 8192 + h * 128 + ks * 32 + fq * 8);
#pragma unroll
        for (int e = 0; e < 4; ++e) { const float a = bflo(qw[ks][e]), b = bfhi(qw[ks][e]); ssq += a * a + b * b; } }
      ssq += shx<16>(ssq); ssq = sum32(ssq);
      const float rq = rsqrtf(ssq * (1.f / 128.f) + EPS);
#pragma unroll
      for (int ks = 0; ks < 4; ++ks) {
        const float* gq = p.in[4] + ks * 32 + fq * 8; const float* gk = p.in[5] + ks * 32 + fq * 8;
        u32x4 o;
#pragma unroll
        for (int e = 0; e < 4; ++e) o[e] = cvtpk(bflo(qw[ks][e]) * rq * gq[2 * e] * gk[2 * e], bfhi(qw[ks][e]) * rq * gq[2 * e + 1] * gk[2 * e + 1]);
        qf[ks] = *reinterpret_cast<bf16x8*>(&o);
      }
    }
    f32x4 sacc[16];
#pragma unroll
    for (int i = 0; i < 16; ++i) sacc[i] = (f32x4){0.f, 0.f, 0.f, 0.f};
    bf16x8 kbuf[3][2][4];
#define NA_KLOAD(b_, w_) do { _Pragma("unroll") for (int c2_ = 0; c2_ < 2; ++c2_) { \
      const u16* kp_ = P + ((size_t)(seqrow0 + r0 + (w_)) * 64 + kc0 + c2_ * 16 + fr) * 8192 + 1024 + h * 128 + fq * 8; \
      _Pragma("unroll") for (int ks_ = 0; ks_ < 4; ++ks_) kbuf[b_][c2_][ks_] = *(const bf16x8*)(kp_ + ks_ * 32); } } while (0)
    NA_KLOAD(0, 0); NA_KLOAD(1, 1);
#pragma unroll
    for (int w = 0; w < 8; ++w) {
      if (w + 2 < 8) NA_KLOAD((w + 2) % 3, w + 2);
      __builtin_amdgcn_sched_barrier(0);
#pragma unroll
      for (int c2 = 0; c2 < 2; ++c2) {
        float ssk = 0.f;
#pragma unroll
        for (int ks = 0; ks < 4; ++ks) {
          const bf16x8 a = kbuf[w % 3][c2][ks];
          sacc[w * 2 + c2] = __builtin_amdgcn_mfma_f32_16x16x32_bf16(a, qf[ks], sacc[w * 2 + c2], 0, 0, 0);
          const u32x4 aw = *reinterpret_cast<const u32x4*>(&a);
#pragma unroll
          for (int e = 0; e < 4; ++e) { const float x = bflo(aw[e]), y = bfhi(aw[e]); ssk += x * x + y * y; }
        }
        ssk += shx<16>(ssk); ssk = sum32(ssk);
        const float rk = rsqrtf(ssk * (1.f / 128.f) + EPS);
#pragma unroll
        for (int e = 0; e < 4; ++e) sacc[w * 2 + c2][e] *= bperm(rk, fq * 4 + e);
        asm volatile("" : "+v"(sacc[w * 2 + c2]));
        if (c2 == 1) __builtin_amdgcn_sched_barrier(0);
      }
    }
#undef NA_KLOAD
    const float scale = 0.08838834764831845f;
    const int qcol = j * 16 + fr; const int qc0 = min(max(qcol - 8, 0), 48);
    float mx = -1e30f;
#pragma unroll
    for (int w = 0; w < 8; ++w) {
      const int dr = r0 + w - r + 7;
      const float* brow = rpb + (h * 15 + dr) * 31;
#pragma unroll
      for (int c2 = 0; c2 < 2; ++c2)
#pragma unroll
        for (int e = 0; e < 4; ++e) {
          const int kcol = kc0 + c2 * 16 + fq * 4 + e;
          const bool valid = (kcol >= qc0) && (kcol < qc0 + 16);
          const int dcol = min(max(kcol - qcol + 15, 0), 30);
          const float sv = valid ? sacc[w * 2 + c2][e] * scale + brow[dcol] : -1e30f;
          sacc[w * 2 + c2][e] = sv; mx = fmaxf(mx, sv);
        }
    }
    mx = fmaxf(mx, shx<16>(mx)); mx = max32(mx);
    float sum = 0.f;
#pragma unroll
    for (int i = 0; i < 16; ++i)
#pragma unroll
      for (int e = 0; e < 4; ++e) { const float sv = sacc[i][e]; const float pe = (sv > -1e29f) ? __expf(sv - mx) : 0.f; sacc[i][e] = pe; sum += pe; }
    sum += shx<16>(sum); sum = sum32(sum);
    const float inv = frcp(sum);
    bf16x8 paw[8];
#pragma unroll
    for (int w = 0; w < 8; ++w) {
      const f32x4 a0 = sacc[w * 2], a1 = sacc[w * 2 + 1];
      u32x4 pw = {cvtpk(a0[0] * inv, a0[1] * inv), cvtpk(a0[2] * inv, a0[3] * inv), cvtpk(a1[0] * inv, a1[1] * inv), cvtpk(a1[2] * inv, a1[3] * inv)};
      paw[w] = *reinterpret_cast<bf16x8*>(&pw);
    }
    f32x4 oacc[8];
#pragma unroll
    for (int c = 0; c < 8; ++c) oacc[c] = (f32x4){0.f, 0.f, 0.f, 0.f};
    u32x4 vreg[8];
#define NA_VLOAD(w_) do { const size_t vt0_ = (size_t)(seqrow0 + r0 + (w_)) * 64 + kc0; _Pragma("unroll") for (int i = 0; i < 8; ++i) { \
      const int q_ = i * 64 + lane; vreg[i] = *(const u32x4*)(P + (vt0_ + (q_ >> 4)) * 8192 + 2048 + h * 128 + (q_ & 15) * 8); } } while (0)
    NA_VLOAD(0);
#pragma unroll
    for (int w = 0; w < 8; ++w) {
      __builtin_amdgcn_sched_barrier(0);
#pragma unroll
      for (int i = 0; i < 8; ++i) { const int q = i * 64 + lane; *(u32x4*)(vl + (q >> 4) * 288 + (q & 15) * 16) = vreg[i]; }
      if (w + 1 < 8) NA_VLOAD(w + 1);
      asm volatile("s_waitcnt lgkmcnt(0)" ::: "memory"); __builtin_amdgcn_sched_barrier(0);
      const bf16x8 pa = paw[w];
#define NA_PV(c) do { const bf16x8 bt_ = tr_read2w<(c) * 32, (c) * 32 + 16 * 288>(vlb); __builtin_amdgcn_sched_barrier(0); \
        oacc[c] = __builtin_amdgcn_mfma_f32_16x16x32_bf16(pa, bt_, oacc[c], 0, 0, 0); } while (0)
      NA_PV(0); NA_PV(1); NA_PV(2); NA_PV(3); NA_PV(4); NA_PV(5); NA_PV(6); NA_PV(7);
#undef NA_PV
      asm volatile("" : "+v"(oacc[0]), "+v"(oacc[1]), "+v"(oacc[2]), "+v"(oacc[3]), "+v"(oacc[4]), "+v"(oacc[5]), "+v"(oacc[6]), "+v"(oacc[7]));
    }
#pragma unroll
    for (int c = 0; c < 8; ++c)
#pragma unroll
      for (int e = 0; e < 4; ++e)
        MIX[((size_t)rowg * 64 + j * 16 + fq * 4 + e) * 2048 + h * 128 + c * 16 + fr] = f2bf(oacc[c][e]);
  }
}

constexpr int HS = 1024, HNSEG = MBT / HS, HROW = 288;
template <bool OUT>
DEVI void ph_hgrn_pass(const Params& p, int mb, char* smem) {
  const u16* P = (const u16*)(p.ws + WS_P);
  float* E = (float*)(p.ws + WS_E); float* DEC = (float*)(p.ws + WS_DEC); u16* OFB = (u16*)(p.ws + WS_OFB);
  const int tid = tid_l(), wid = tid >> 6, lane = tid & 63, fr = lane & 15, fq = lane >> 4;
  const int pk = wid * 16 + fr;
  constexpr int HSET = 28672;
  const int vvb_0  = (int)(uintptr_t)(smem + 18432) + (fq * 4 + (fr >> 2)) * HROW + (wid * 16 + (fr & 3) * 4) * 2;
  const int vvb2_0 = (int)(uintptr_t)(smem + 18432) + (fq * 8 + (fr >> 2)) * HROW + (wid * 16 + (fr & 3) * 4) * 2;
  const int kdb_0  = (int)(uintptr_t)(smem + 9216) + (fq * 8 + (fr >> 2)) * HROW + ((fr & 3) * 4) * 2;
#pragma unroll 1
  for (int chain = blockIdx.x; chain < HNSEG * 16; chain += gridDim.x) {
    const int seg = chain >> 4, hd = chain & 15, h = hd >> 1, dir = hd & 1;
    const size_t tok0 = (size_t)seg * HS;
    float* Eb = E + (size_t)(seg * 16 + hd) * 16384 + wid * 16 + fr;
    f32x4 S[8];
#pragma unroll
    for (int kt = 0; kt < 8; ++kt)
#pragma unroll
      for (int r = 0; r < 4; ++r) S[kt][r] = OUT ? Eb[(kt * 16 + fq * 4 + r) * 128] : 0.f;
    __syncthreads();
    float lsum = 0.f;
    const float* lbl = p.in[7];
    const float lbv = 1.f / (1.f + __expf(lbl[(dir * 2 + 1) * 1024 + h * 128 + pk] - lbl[(dir * 2 + 0) * 1024 + h * 128 + pk]));
    u16 rl[8], rq[8]; u32x4 rv;
#define H_LOADRAW(c) do { _Pragma("unroll") for (int i = 0; i < 8; ++i) { const int tg = (c) * 32 + fq * 8 + i; \
      const u16* pr = P + (tok0 + (dir ? HS - 1 - tg : tg)) * 8192 + h * 128 + pk; rl[i] = pr[4096 + dir * 1024]; if (OUT) rq[i] = pr[3072]; } \
      { const int tg = (c) * 32 + (tid >> 4); rv = *(const u32x4*)(P + (tok0 + (dir ? HS - 1 - tg : tg)) * 8192 + 6144 + h * 128 + (tid & 15) * 8); } } while (0)
    H_LOADRAW(0);
    auto H_PRE = [&](const int c) {
      char* const sb = smem + (c & 1) * HSET; char* QD = sb; char* KD = sb + 9216; char* VV = sb + 18432; float* EB = (float*)(sb + 27648);
      float kkv[8], bl[8]; float cs = 0.f;
#pragma unroll
      for (int i = 0; i < 8; ++i) {
        const float ez = __expf(-bf2f(rl[i])); const float sg = frcp(1.f + ez);
        kkv[i] = (1.f - lbv) * ez * sg;
        cs += __log2f(lbv + (1.f - lbv) * sg); bl[i] = cs;
      }
      const float t0 = bperm(cs, fr), t1 = bperm(cs, fr + 16), t2 = bperm(cs, fr + 32), t3 = bperm(cs, fr + 48);
      const float off = (fq > 0 ? t0 : 0.f) + (fq > 1 ? t1 : 0.f) + (fq > 2 ? t2 : 0.f);
      const float btot = t0 + t1 + t2 + t3;
      lsum += btot;
#pragma unroll
      for (int i = 0; i < 8; ++i) {
        const int tau = fq * 8 + i; const float bb = off + bl[i];
        *(u16*)(KD + tau * HROW + pk * 2) = f2bf(kkv[i] * __builtin_amdgcn_exp2f(fminf(-bb, 100.f)));
        if (OUT) { const float zq = bf2f(rq[i]); *(u16*)(QD + tau * HROW + pk * 2) = f2bf(zq * frcp(1.f + __expf(-zq)) * __builtin_amdgcn_exp2f(bb)); }
      }
      if (fq == 0) EB[pk] = __builtin_amdgcn_exp2f(btot);
      *(u32x4*)(VV + (tid >> 4) * HROW + (tid & 15) * 16) = rv;
      if (c + 1 < HS / 32) H_LOADRAW(c + 1);
    };
    H_PRE(0);
#pragma unroll 1
    for (int c = 0; c < HS / 32; ++c) {
      char* const sb = smem + (c & 1) * HSET; char* QD = sb; char* KD = sb + 9216; float* EB = (float*)(sb + 27648);
      const int vvb = vvb_0 + (c & 1) * HSET, vvb2 = vvb2_0 + (c & 1) * HSET, kdb = kdb_0 + (c & 1) * HSET;
      __syncthreads();
      if (OUT) {
        f32x4 at00 = {0.f, 0.f, 0.f, 0.f}, at01 = at00, at11 = at00;
#pragma unroll
        for (int ks = 0; ks < 4; ++ks) {
          const bf16x8 k0 = *(const bf16x8*)(KD + fr * HROW + ks * 64 + fq * 16), k1 = *(const bf16x8*)(KD + (16 + fr) * HROW + ks * 64 + fq * 16);
          const bf16x8 q0 = *(const bf16x8*)(QD + fr * HROW + ks * 64 + fq * 16), q1 = *(const bf16x8*)(QD + (16 + fr) * HROW + ks * 64 + fq * 16);
          at00 = __builtin_amdgcn_mfma_f32_16x16x32_bf16(k0, q0, at00, 0, 0, 0);
          at01 = __builtin_amdgcn_mfma_f32_16x16x32_bf16(k0, q1, at01, 0, 0, 0);
          at11 = __builtin_amdgcn_mfma_f32_16x16x32_bf16(k1, q1, at11, 0, 0, 0);
        }
#pragma unroll
        for (int r = 0; r < 4; ++r) { const bool keep = (fq * 4 + r) <= fr; at00[r] = keep ? at00[r] : 0.f; at11[r] = keep ? at11[r] : 0.f; }
        u32x4 w0 = {cvtpk(at00[0], at00[1]), cvtpk(at00[2], at00[3]), 0u, 0u};
        u32x4 w1 = {cvtpk(at01[0], at01[1]), cvtpk(at01[2], at01[3]), cvtpk(at11[0], at11[1]), cvtpk(at11[2], at11[3])};
        const bf16x8 pa0 = *reinterpret_cast<bf16x8*>(&w0), pa1 = *reinterpret_cast<bf16x8*>(&w1);
        const bf16x8 bv = tr_read2w<0, 16 * HROW>(vvb);
        f32x4 o0 = {0.f, 0.f, 0.f, 0.f}, o1 = o0;
        o0 = __builtin_amdgcn_mfma_f32_16x16x32_bf16(pa0, bv, o0, 0, 0, 0);
        o1 = __builtin_amdgcn_mfma_f32_16x16x32_bf16(pa1, bv, o1, 0, 0, 0);
#pragma unroll
        for (int ks = 0; ks < 4; ++ks) {
          const f32x4 sa = S[2 * ks], sb = S[2 * ks + 1];
          u32x4 sw = {cvtpk(sa[0], sa[1]), cvtpk(sa[2], sa[3]), cvtpk(sb[0], sb[1]), cvtpk(sb[2], sb[3])};
          const bf16x8 sop = *reinterpret_cast<bf16x8*>(&sw);
          const char* qa = QD + fr * HROW + (ks * 32 + fq * 4) * 2;
          const u32x2 a0l = *(const u32x2*)(qa), a0h = *(const u32x2*)(qa + 32);
          const u32x2 a1l = *(const u32x2*)(qa + 16 * HROW), a1h = *(const u32x2*)(qa + 16 * HROW + 32);
          u32x4 aw0 = {a0l[0], a0l[1], a0h[0], a0h[1]}, aw1 = {a1l[0], a1l[1], a1h[0], a1h[1]};
          o0 = __builtin_amdgcn_mfma_f32_16x16x32_bf16(*reinterpret_cast<bf16x8*>(&aw0), sop, o0, 0, 0, 0);
          o1 = __builtin_amdgcn_mfma_f32_16x16x32_bf16(*reinterpret_cast<bf16x8*>(&aw1), sop, o1, 0, 0, 0);
        }
#pragma unroll
        for (int r = 0; r < 4; ++r) {
          const int tg0 = c * 32 + fq * 4 + r, tg1 = tg0 + 16;
          OFB[((size_t)dir * MBT + tok0 + (dir ? HS - 1 - tg0 : tg0)) * 1024 + h * 128 + wid * 16 + fr] = f2bf(o0[r]);
          OFB[((size_t)dir * MBT + tok0 + (dir ? HS - 1 - tg1 : tg1)) * 1024 + h * 128 + wid * 16 + fr] = f2bf(o1[r]);
        }
      }
      {
        const bf16x8 vop = tr_read2w<0, 4 * HROW>(vvb2);
#define H_UPD(kt) do { const bf16x8 aop_ = tr_read2w<(kt) * 32, (kt) * 32 + 4 * HROW>(kdb); \
          S[kt] = __builtin_amdgcn_mfma_f32_16x16x32_bf16(aop_, vop, S[kt], 0, 0, 0); } while (0)
        H_UPD(0); H_UPD(1); H_UPD(2); H_UPD(3); H_UPD(4); H_UPD(5); H_UPD(6); H_UPD(7);
#undef H_UPD
#pragma unroll
        for (int kt = 0; kt < 8; ++kt) { const f32x4 e = *(const f32x4*)(EB + kt * 16 + fq * 4); S[kt] *= e; }
      }
      if (c + 1 < HS / 32) H_PRE(c + 1);
    }
#undef H_LOADRAW
    if (!OUT) {
#pragma unroll
      for (int kt = 0; kt < 8; ++kt)
#pragma unroll
        for (int r = 0; r < 4; ++r) Eb[(kt * 16 + fq * 4 + r) * 128] = S[kt][r];
      if (fq == 0) DEC[(seg * 16 + hd) * 128 + pk] = __builtin_amdgcn_exp2f(lsum);
    }
  }
}

DEVI void ph_hgrn_carry(const Params& p, int mb) {
  const int S = (mb < 2) ? 2048 : 16384; const int sps = S / HS;
  float* E = (float*)(p.ws + WS_E); const float* DEC = (const float*)(p.ws + WS_DEC);
#pragma unroll 1
  for (int e = blockIdx.x * NTHR + tid_l(); e < 16 * 16384; e += gridDim.x * NTHR) {
    const int hd = e >> 14, kv = e & 16383, k = kv >> 7, dir = hd & 1;
    float run = 0.f, ev[HNSEG], dv[HNSEG];
#pragma unroll
    for (int s = 0; s < HNSEG; ++s) { const int seg = dir ? HNSEG - 1 - s : s; ev[s] = E[((size_t)seg * 16 + hd) * 16384 + kv]; dv[s] = DEC[(seg * 16 + hd) * 128 + k]; }
#pragma unroll
    for (int s = 0; s < HNSEG; ++s) {
      const int seg = dir ? HNSEG - 1 - s : s;
      const bool first = dir ? (((seg + 1) % sps) == 0) : ((seg % sps) == 0);
      if (first) run = 0.f;
      E[((size_t)seg * 16 + hd) * 16384 + kv] = run; run = dv[s] * run + ev[s];
    }
  }
}

DEVI void ph_hg_combine(const Params& p) {
  const u16* P = (const u16*)(p.ws + WS_P); const u16* OFB = (const u16*)(p.ws + WS_OFB);
  u16* MIX = (u16*)(p.ws + WS_MIX); const float* og = p.in[8];
  const int cstride = gridDim.x * NTHR;
#pragma unroll 1
  for (int it0 = blockIdx.x * NTHR + tid_l(); it0 < MBT * 128; it0 += 2 * cstride) {
   const int it1 = (it0 + cstride < MBT * 128) ? it0 + cstride : it0;
   u32x4 awv[2], bwv[2], gwv[2];
#pragma unroll
   for (int q = 0; q < 2; ++q) { const int it = q ? it1 : it0; const int tok = it >> 7, col = (it & 127) * 8;
     awv[q] = *(const u32x4*)(OFB + (size_t)tok * 1024 + col); bwv[q] = *(const u32x4*)(OFB + ((size_t)MBT + tok) * 1024 + col);
     gwv[q] = *(const u32x4*)(P + (size_t)tok * 8192 + 7168 + col); }
#pragma unroll
   for (int q = 0; q < 2; ++q) {
    const int it = q ? it1 : it0;
    const int tok = it >> 7, ch = it & 127, col = ch * 8;
    const u32x4 aw = awv[q], bw = bwv[q];
    float o[8];
#pragma unroll
    for (int j = 0; j < 4; ++j) { o[2 * j] = bflo(aw[j]) + bflo(bw[j]); o[2 * j + 1] = bfhi(aw[j]) + bfhi(bw[j]); }
    float ss = 0.f;
#pragma unroll
    for (int j = 0; j < 8; ++j) ss += o[j] * o[j];
    ss += shx<1>(ss); ss += shx<2>(ss); ss += shx<4>(ss); ss += shx<8>(ss);
    const float rstd = rsqrtf(ss * (1.f / 128.f) + EPS);
    const u32x4 gw = gwv[q];
    float g[8];
#pragma unroll
    for (int j = 0; j < 4; ++j) { g[2*j] = bflo(gw[j]); g[2*j+1] = bfhi(gw[j]); }
#pragma unroll
    for (int j = 0; j < 8; ++j) g[j] = g[j] * sigmoidf_(g[j]);
    const float* gn = og + (col & 127);
#pragma unroll
    for (int j = 0; j < 8; ++j) o[j] = o[j] * rstd * gn[j] * g[j];
    u32x4 w = {cvtpk(o[0], o[1]), cvtpk(o[2], o[3]), cvtpk(o[4], o[5]), cvtpk(o[6], o[7])};
    *(u32x4*)(MIX + (size_t)tok * 2048 + 1024 + col) = w;
   }
  }
}


DEVI unsigned fkey(float x) { const unsigned u = __float_as_uint(x); return (u & 0x80000000u) ? ~u : (u | 0x80000000u); }
DEVI unsigned wave_umax(unsigned v) {
  v = max(v, (unsigned)__builtin_amdgcn_update_dpp(0, v, 0xB1, 0xF, 0xF, true));
  v = max(v, (unsigned)__builtin_amdgcn_update_dpp(0, v, 0x4E, 0xF, 0xF, true));
  v = max(v, (unsigned)__builtin_amdgcn_update_dpp(0, v, 0x141, 0xF, 0xF, true));
  v = max(v, (unsigned)__builtin_amdgcn_update_dpp(0, v, 0x140, 0xF, 0xF, true));
  v = max(v, (unsigned)__builtin_amdgcn_ds_swizzle((int)v, (16 << 10) | 0x1F));
  auto r = __builtin_amdgcn_permlane32_swap(v, v, false, false);
  return (unsigned)__builtin_amdgcn_readfirstlane((int)max(r[0], r[1]));
}
template <int C, int N>
DEVI int radix_counts(const unsigned (&key)[C][N], const unsigned (&cand)[C], int (&cnt)[C]) {
  unsigned long long m[C][N];
#pragma unroll
  for (int c = 0; c < C; ++c)
#pragma unroll
    for (int n = 0; n < N; ++n) m[c][n] = __ballot(key[c][n] >= cand[c]);
  __builtin_amdgcn_sched_barrier(0);
#pragma unroll
  for (int c = 0; c < C; ++c) { cnt[c] = 0;
#pragma unroll
    for (int n = 0; n < N; ++n) cnt[c] += __popcll(m[c][n]); }
  return 0;
}
template <int C, int N>
DEVI void radix16(const unsigned (&key)[C][N], unsigned (&prefix)[C]) {
  int cacc[C]; int cnt[C]; unsigned cand[C];
  bool generic = false;
#pragma unroll
  for (int c = 0; c < C; ++c) {
    unsigned mk = key[c][0];
#pragma unroll
    for (int n = 1; n < N; ++n) mk = max(mk, key[c][n]);
    const unsigned M = wave_umax(mk);
    generic = generic || (M < 0x80800000u);
    prefix[c] = M & 0xFF800000u; cacc[c] = 0;
  }
  if (!generic) {
#pragma unroll 1
    for (int t = 0; t < 12; ++t) {
      radix_counts<C, N>(key, prefix, cnt);
      bool ok = true;
#pragma unroll
      for (int c = 0; c < C; ++c) { cacc[c] = cnt[c]; if (cnt[c] < 16) { ok = false; if (prefix[c] > 0x80800000u) prefix[c] -= 0x00800000u; else generic = true; } }
      if (ok || generic) break;
      if (t == 11) generic = true;
    }
  }
  int start = 22;
  if (generic) { start = 31;
#pragma unroll
    for (int c = 0; c < C; ++c) { prefix[c] = 0u; cacc[c] = 64 * N; } }
#pragma unroll 1
  for (int bit0 = start; bit0 >= 0; bit0 -= 2) {
    bool alldone = true;
#pragma unroll
    for (int c = 0; c < C; ++c) alldone = alldone && (cacc[c] == 16);
    if (alldone) break;
#pragma unroll
    for (int u = 0; u < 2; ++u) {
      const int bit = bit0 - u;
      const unsigned bmask = bit >= 0 ? (1u << bit) : 0u;
#pragma unroll
      for (int c = 0; c < C; ++c) cand[c] = prefix[c] | bmask;
      radix_counts<C, N>(key, cand, cnt);
#pragma unroll
      for (int c = 0; c < C; ++c) if (cnt[c] >= 16) { prefix[c] = cand[c]; cacc[c] = cnt[c]; }
      __builtin_amdgcn_sched_barrier(0);
    }
  }
}
template <int N>
DEVI void compact16(const unsigned (&key)[N], unsigned prefix, const float (&v)[N], const int (&id)[N], float* outv, int* outi, int lane) {
  int base = 0;
  const unsigned long long below = (1ull << lane) - 1ull;
#pragma unroll
  for (int n = 0; n < N; ++n) {
    const bool sel = key[n] >= prefix;
    const unsigned long long m = __ballot(sel);
    const int pos = base + __popcll(m & below);
    if (sel && pos < 16) { outv[pos] = v[n]; outi[pos] = id[n]; }
    base += __popcll(m);
  }
}

DEVI void ph_topk(const Params& p, int mb, char* smem) {
  const float* SC = (const float*)(p.ws + WS_P);
  int* IDX = (int*)(p.ws + WS_IDX) + (size_t)mb * MBT * 128; float* GATE = (float*)(p.ws + WS_GATE) + (size_t)mb * MBT * 128;
  const int tid = tid_l(), wid = tid >> 6, lane = tid & 63;
  float* wv = (float*)smem + wid * 256; int* wi = (int*)wv;
  const int npair2 = MBT * 8 / 2;
  const int stride = gridDim.x * 8;
  float cur[2][4], nxt[2][4];
  int it = blockIdx.x * 8 + wid;
  const int sti = lane < 16 ? 0 : lane < 24 ? 1 : lane < 29 ? 2 : lane < 33 ? 3 : lane < 36 ? 4 : lane < 38 ? 5 : lane < 40 ? 6 : lane < 42 ? 7 : lane < 50 ? lane - 34 : 0;
  const int stj = lane < 16 ? lane : lane < 24 ? lane - 16 : lane < 29 ? lane - 24 : lane < 33 ? lane - 29 : lane < 36 ? lane - 33 : lane < 38 ? lane - 36 : lane < 40 ? lane - 38 : lane < 42 ? lane - 40 : 0;
#define TK_LOAD(dst, item) do { const int tok_ = (item) >> 2, h_ = (item) & 3; _Pragma("unroll") for (int q = 0; q < 2; ++q) { \
      const float* sp_ = SC + (size_t)tok_ * 2048 + (h_ + 4 * q) * 256 + lane; dst[q][0] = sp_[0]; dst[q][1] = sp_[64]; dst[q][2] = sp_[128]; dst[q][3] = sp_[192]; } } while (0)
  if (it < npair2) TK_LOAD(cur, it);
#pragma unroll 1
  for (; it < npair2; it += stride) {
    if (it + stride < npair2) TK_LOAD(nxt, it + stride);
    const int tok = it >> 2, h0 = it & 3;
    unsigned key[4][2], pre[4];
#pragma unroll
    for (int q = 0; q < 2; ++q) { key[2 * q][0] = fkey(cur[q][0]); key[2 * q][1] = fkey(cur[q][1]); key[2 * q + 1][0] = fkey(cur[q][2]); key[2 * q + 1][1] = fkey(cur[q][3]); }
    radix16<4, 2>(key, pre);
    const int ia[2] = {lane, lane + 64};
#pragma unroll
    for (int q = 0; q < 2; ++q) {
      const float a[2] = {cur[q][0], cur[q][1]}, bb[2] = {cur[q][2], cur[q][3]};
      compact16<2>(key[2 * q], pre[2 * q], a, ia, wv + q * 128, wi + q * 128 + 16, lane);
      compact16<2>(key[2 * q + 1], pre[2 * q + 1], bb, ia, wv + q * 128 + 32, wi + q * 128 + 48, lane);
    }
    { const int g = lane >> 4, r = lane & 15; const int base = (g >> 1) * 128 + (g & 1) * 32;
      const float myv = wv[base + r]; const int myi = wi[base + 16 + r];
      int rank = 0;
#pragma unroll
      for (int j = 0; j < 16; ++j) { const float o = wv[base + j]; rank += ((o > myv) || (o == myv && j < r)) ? 1 : 0; }
      wv[base + rank] = myv; wi[base + 16 + rank] = myi; }
    float cv[2][1]; int ci[2][1]; unsigned ck[2][1], cp[2];
#pragma unroll
    for (int q = 0; q < 2; ++q) {
      const float s1 = wv[q * 128 + sti], s2 = wv[q * 128 + 32 + stj];
      cv[q][0] = (lane < 50) ? s1 + s2 : -__builtin_inff();
      ci[q][0] = wi[q * 128 + 16 + sti] * 128 + wi[q * 128 + 48 + stj];
      ck[q][0] = fkey(cv[q][0]);
    }
    radix16<2, 1>(ck, cp);
#pragma unroll
    for (int q = 0; q < 2; ++q) {
      compact16<1>(ck[q], cp[q], cv[q], ci[q], wv + q * 128 + 64, wi + q * 128 + 80, lane);
      if (lane < 16) {
        const int h = h0 + 4 * q;
        GATE[(size_t)tok * 128 + h * 16 + lane] = wv[q * 128 + 64 + lane];
        IDX[(size_t)tok * 128 + h * 16 + lane] = wi[q * 128 + 80 + lane];
      }
    }
#pragma unroll
    for (int q = 0; q < 2; ++q)
#pragma unroll
      for (int e = 0; e < 4; ++e) cur[q][e] = nxt[q][e];
  }
#undef TK_LOAD
}

constexpr int TKA_I[14] = {0, 0, 0, 0, 0, 0, 0, 0, 0, 0, 0, 0, 0, 2}, TKA_J[14] = {1, 2, 3, 4, 5, 6, 7, 8, 9, 10, 11, 12, 0, 2};
constexpr int TKB_I[14] = {0, 0, 0, 1, 1, 1, 1, 1, 1, 2, 2, 0, 1, 3}, TKB_J[14] = {13, 14, 15, 2, 3, 4, 5, 6, 7, 3, 4, 0, 1, 3};
DEVI float tk_other32(float v, bool hi32) { auto r = __builtin_amdgcn_permlane32_swap(__float_as_uint(v), __float_as_uint(v), false, false); return __uint_as_float(hi32 ? r[0] : r[1]); }
DEVI void tk_merge16(float (&m)[16], const float (&pt)[16]) {
#pragma unroll
  for (int i = 0; i < 16; ++i) m[i] = fmaxf(m[i], pt[15 - i]);
#pragma unroll
  for (int sft = 8; sft >= 1; sft >>= 1)
#pragma unroll
    for (int i = 0; i < 16; ++i) if ((i & sft) == 0) { const float a = m[i], b = m[i | sft]; m[i] = fmaxf(a, b); m[i | sft] = fminf(a, b); }
}
DEVI void topk_from_lds(const Params& p, char* tile, int tok0, int head, int* IDX, float* GATE, char* smem) {
  const int tid = tid_l(), wid = tid >> 6, lane = tid & 63;
  const int r = lane & 15, q = lane >> 4, h = q & 1, tr = q >> 1;
  char* rowp = tile + (wid * 16 + r) * 1024;
  char* listp = rowp + r * 16;
  bool dup_any = false;
  {
    float x[64];
#pragma unroll
    for (int k = 0; k < 16; ++k) { const f32x4 v = *(const f32x4*)(rowp + (((q * 16 + k) ^ r) << 4)); x[4 * k] = v[0]; x[4 * k + 1] = v[1]; x[4 * k + 2] = v[2]; x[4 * k + 3] = v[3]; }
    float t[16];
#pragma unroll
    for (int i = 0; i < 16; ++i) t[i] = -__builtin_inff();
#pragma unroll
    for (int j = 0; j < 64; ++j) {
#pragma unroll
      for (int i = (j < 15 ? j : 15); i >= 1; --i) t[i] = __builtin_amdgcn_fmed3f(x[j], t[i - 1], t[i]);
      t[0] = fmaxf(t[0], x[j]);
    }
    float pt[16], m[16];
#pragma unroll
    for (int i = 0; i < 16; ++i) { pt[i] = shx<16>(t[i]); m[i] = t[i]; }
    tk_merge16(m, pt);
    const float thr = m[15];
    int a_own = 0, a_par = 0;
#pragma unroll
    for (int i = 0; i < 16; ++i) { a_own += (t[i] >= thr) ? 1 : 0; a_par += (pt[i] >= thr) ? 1 : 0; }
    float* lv = (float*)listp + tr * 32; int* li = (int*)lv + 16;
    if (!__any(a_own + a_par > 16)) {
      int cnt = h ? a_par : 0;
#pragma unroll
      for (int j = 0; j < 64; ++j) if (x[j] >= thr && cnt < 16) { lv[cnt] = x[j]; li[cnt] = h * 64 + j; ++cnt; }
    } else {
      int g_own = 0, g_par = 0;
#pragma unroll
      for (int i = 0; i < 16; ++i) { g_own += (t[i] > thr) ? 1 : 0; g_par += (pt[i] > thr) ? 1 : 0; }
      const int need = 16 - g_own - g_par;
      const int e0 = h ? (a_par - g_par) : (a_own - g_own);
      const int tk0 = min(e0, need), tk = h ? need - tk0 : tk0;
      int cnt = h ? g_par + tk0 : 0, ties = 0;
#pragma unroll
      for (int j = 0; j < 64; ++j) {
        const float v = x[j]; const bool eq = (v == thr) && (ties < tk);
        if ((v > thr || eq) && cnt < 16) { lv[cnt] = v; li[cnt] = h * 64 + j; ++cnt; }
        ties += eq ? 1 : 0;
      }
    }
    bool dup = false;
#pragma unroll
    for (int i = 0; i < 15; ++i) dup = dup || (m[i] == m[i + 1]);
    dup_any = __any(dup);
    if (!dup_any) {
      asm volatile("s_waitcnt lgkmcnt(0)" ::: "memory");
      float ev[8]; int ec[8];
#pragma unroll
      for (int k = 0; k < 8; ++k) { ev[k] = lv[h * 8 + k]; ec[k] = li[h * 8 + k]; }
      asm volatile("s_waitcnt lgkmcnt(0)" ::: "memory");
#pragma unroll
      for (int k = 0; k < 8; ++k) {
        int rank = 0;
#pragma unroll
        for (int i = 0; i < 16; ++i) rank += (m[i] > ev[k]) ? 1 : 0;
        lv[rank] = ev[k]; li[rank] = ec[k];
      }
    }
  }
  asm volatile("s_waitcnt lgkmcnt(0)" ::: "memory");
#pragma unroll 1
  for (int itr = 0; itr < (dup_any ? 8 : 0); ++itr) {
    const int tk_r = itr * 2 + (q >> 1);
    float* L = (float*)(tile + (wid * 16 + tk_r) * 1024 + tk_r * 16) + (q & 1) * 32; int* Li = (int*)L + 16;
    const float myv = L[r]; const int myi = Li[r];
    int rank = 0;
#pragma unroll
    for (int j = 0; j < 16; ++j) { const float o = L[j]; rank += ((o > myv) || (o == myv && j < r)) ? 1 : 0; }
    L[rank] = myv; Li[rank] = myi;
  }
  asm volatile("s_waitcnt lgkmcnt(0)" ::: "memory");
  {
    const float* Lo = (const float*)listp + tr * 32; const float* Lx = (const float*)listp + (1 - tr) * 32;
    float ov[16], xv[16]; int oi[16], xi[16];
#pragma unroll
    for (int k = 0; k < 4; ++k) {
      const f32x4 a = *(const f32x4*)(Lo + 4 * k), b = *(const f32x4*)(Lx + 4 * k);
      const u32x4 c = *(const u32x4*)(Lo + 16 + 4 * k), d = *(const u32x4*)(Lx + 16 + 4 * k);
#pragma unroll
      for (int e = 0; e < 4; ++e) { ov[4 * k + e] = a[e]; xv[4 * k + e] = b[e]; oi[4 * k + e] = (int)c[e]; xi[4 * k + e] = (int)d[e]; }
    }
    float c[14]; int ce[14];
#pragma unroll
    for (int n = 0; n < 14; ++n) {
      const float so = h ? ov[TKB_I[n]] : ov[TKA_I[n]], sx = h ? xv[TKB_J[n]] : xv[TKA_J[n]];
      const int eo = h ? oi[TKB_I[n]] : oi[TKA_I[n]], ex = h ? xi[TKB_J[n]] : xi[TKA_J[n]];
      const bool dead = (n >= 12 && tr) || (n == 11 && h);
      c[n] = dead ? -__builtin_inff() : so + sx;
      ce[n] = tr ? ex * 128 + eo : eo * 128 + ex;
    }
    float m[16], pt[16];
#pragma unroll
    for (int i = 0; i < 16; ++i) m[i] = -__builtin_inff();
#pragma unroll
    for (int n = 0; n < 14; ++n) {
#pragma unroll
      for (int i = (n < 15 ? n : 15); i >= 1; --i) m[i] = __builtin_amdgcn_fmed3f(c[n], m[i - 1], m[i]);
      m[0] = fmaxf(m[0], c[n]);
    }
#pragma unroll
    for (int i = 0; i < 16; ++i) pt[i] = shx<16>(m[i]);
    tk_merge16(m, pt);
    const bool hi32 = tr != 0;
#pragma unroll
    for (int i = 0; i < 16; ++i) pt[i] = tk_other32(m[i], hi32);
    tk_merge16(m, pt);
    const float thr = m[15];
    int gt = 0, eq = 0;
#pragma unroll
    for (int n = 0; n < 14; ++n) { gt += (c[n] > thr) ? 1 : 0; eq += (c[n] == thr) ? 1 : 0; }
    const int pk = gt | (eq << 8);
    const int pk1 = __float_as_int(shx<16>(__int_as_float(pk)));
    const int pk2 = __float_as_int(tk_other32(__int_as_float(pk + pk1), hi32));
    const int tot = pk + pk1 + pk2;
    const int before = (h ? pk1 : 0) + (tr ? pk2 : 0);
    const int need = 16 - (tot & 0xff), eq_before = before >> 8;
    const int tk = max(0, min(eq, need - eq_before));
    int pos = (before & 0xff) + min(eq_before, need), ties = 0;
    const size_t ob = ((size_t)tok0 + wid * 16 + r) * 128 + head * 16;
#pragma unroll
    for (int n = 0; n < 14; ++n) {
      const float v = c[n]; const bool iseq = (v == thr) && (ties < tk);
      if ((v > thr || iseq) && pos < 16) { GATE[ob + pos] = v; IDX[ob + pos] = ce[n]; ++pos; }
      ties += iseq ? 1 : 0;
    }
  }
}

DEVI float gelu_exact(float a) { return 0.5f * a * (1.f + erff(a * 0.70710678118654752f)); }

using f32x2 = __attribute__((ext_vector_type(2))) float;
DEVI float wave_sum_dpp(float v) {
  v += __uint_as_float(__builtin_amdgcn_update_dpp(0, __float_as_uint(v), 0xB1, 0xF, 0xF, true));
  v += __uint_as_float(__builtin_amdgcn_update_dpp(0, __float_as_uint(v), 0x4E, 0xF, 0xF, true));
  v += __uint_as_float(__builtin_amdgcn_update_dpp(0, __float_as_uint(v), 0x141, 0xF, 0xF, true));
  v += __uint_as_float(__builtin_amdgcn_update_dpp(0, __float_as_uint(v), 0x140, 0xF, 0xF, true));
  v += shx<16>(v); v = sum32(v);
  return v;
}
constexpr int EXG = 8;
DEVI float row16_sum(float v) {
  v += __uint_as_float(__builtin_amdgcn_update_dpp(0, __float_as_uint(v), 0xB1, 0xF, 0xF, true));
  v += __uint_as_float(__builtin_amdgcn_update_dpp(0, __float_as_uint(v), 0x4E, 0xF, 0xF, true));
  v += __uint_as_float(__builtin_amdgcn_update_dpp(0, __float_as_uint(v), 0x141, 0xF, 0xF, true));
  v += __uint_as_float(__builtin_amdgcn_update_dpp(0, __float_as_uint(v), 0x140, 0xF, 0xF, true));
  return v;
}
DEVI float row16_max(float v) {
  v = fmaxf(v, __uint_as_float(__builtin_amdgcn_update_dpp(0, __float_as_uint(v), 0xB1, 0xF, 0xF, true)));
  v = fmaxf(v, __uint_as_float(__builtin_amdgcn_update_dpp(0, __float_as_uint(v), 0x4E, 0xF, 0xF, true)));
  v = fmaxf(v, __uint_as_float(__builtin_amdgcn_update_dpp(0, __float_as_uint(v), 0x141, 0xF, 0xF, true)));
  v = fmaxf(v, __uint_as_float(__builtin_amdgcn_update_dpp(0, __float_as_uint(v), 0x140, 0xF, 0xF, true)));
  return v;
}
DEVI void ex_load(u32x2 (&buf)[EXG][3], const unsigned char* tab, int i0, int i1, int gg, int lane) {
#pragma unroll
  for (int q = 0; q < EXG; ++q) {
    const int e = gg * EXG + q;
    const int ia = __builtin_amdgcn_readlane(i0, e & 63), ib = __builtin_amdgcn_readlane(i1, e & 63);
    const int ie = (e < 64) ? ia : ib;
    const unsigned char* r = tab + (size_t)ie * EROW + lane * 8;
    buf[q][0] = *(const u32x2*)r; buf[q][1] = *(const u32x2*)(r + 512); buf[q][2] = *(const u32x2*)(r + 1024);
  }
}
DEVI f32x32v ex_dec(const u32x2 (&w)[3]) {
  const u32x6 x = {w[0][0], w[0][1], w[1][0], w[1][1], w[2][0], w[2][1]};
  return __builtin_amdgcn_cvt_scalef32_pk32_f32_fp6(x, 1.0f);
}
DEVI void exu_load(u32x4 (&buf)[EXG], const unsigned char* tab, int i0, int i1, int gg, int lane) {
#pragma unroll
  for (int q = 0; q < EXG; ++q) {
    const int e = gg * EXG + q;
    const int ia = __builtin_amdgcn_readlane(i0, e & 63), ib = __builtin_amdgcn_readlane(i1, e & 63);
    const int ie = (e < 64) ? ia : ib;
    buf[q] = *(const u32x4*)(tab + (size_t)ie * UROW + lane * 16);
  }
}
DEVI void ex_dots(const u32x4 (&buf)[EXG], const f32x2 (&hx)[16], float& a_lo, float& a_hi, int gg, int lane) {
  float part[EXG];
#pragma unroll
  for (int q = 0; q < EXG; ++q) {
    f32x2 s2 = {0.f, 0.f};
#pragma unroll
    for (int d = 0; d < 4; ++d) {
      s2 += __builtin_amdgcn_cvt_scalef32_pk_f32_fp4(buf[q][d], 1.0f, 0) * hx[d * 4 + 0];
      s2 += __builtin_amdgcn_cvt_scalef32_pk_f32_fp4(buf[q][d], 1.0f, 1) * hx[d * 4 + 1];
      s2 += __builtin_amdgcn_cvt_scalef32_pk_f32_fp4(buf[q][d], 1.0f, 2) * hx[d * 4 + 2];
      s2 += __builtin_amdgcn_cvt_scalef32_pk_f32_fp4(buf[q][d], 1.0f, 3) * hx[d * 4 + 3];
    }
    part[q] = s2[0] + s2[1];
    __builtin_amdgcn_sched_barrier(0);
  }
#pragma unroll
  for (int q = 0; q < EXG; ++q) part[q] = wave_sum_dpp(part[q]);
#pragma unroll
  for (int q = 0; q < EXG; ++q) { const int e = gg * EXG + q; if (lane == (e & 63)) { if (e < 64) a_lo = part[q]; else a_hi = part[q]; } }
}
DEVI void ex_acc(const u32x4 (&buf)[EXG], f32x2 (&acc)[16], float w0, float w1, int gg) {
#pragma unroll
  for (int q = 0; q < EXG; ++q) {
    const int e = gg * EXG + q;
    const float wa = __uint_as_float(__builtin_amdgcn_readlane(__float_as_uint(w0), e & 63)), wb = __uint_as_float(__builtin_amdgcn_readlane(__float_as_uint(w1), e & 63));
    const float we = (e < 64) ? wa : wb;
    const f32x2 w2 = {we, we};
#pragma unroll
    for (int d = 0; d < 4; ++d) {
      acc[d * 4 + 0] += w2 * __builtin_amdgcn_cvt_scalef32_pk_f32_fp4(buf[q][d], 1.0f, 0);
      acc[d * 4 + 1] += w2 * __builtin_amdgcn_cvt_scalef32_pk_f32_fp4(buf[q][d], 1.0f, 1);
      acc[d * 4 + 2] += w2 * __builtin_amdgcn_cvt_scalef32_pk_f32_fp4(buf[q][d], 1.0f, 2);
      acc[d * 4 + 3] += w2 * __builtin_amdgcn_cvt_scalef32_pk_f32_fp4(buf[q][d], 1.0f, 3);
    }
    __builtin_amdgcn_sched_barrier(0);
  }
}
DEVI void ph_experts(const Params& p, int layer) {
  const unsigned char* UB = p.ws + WS_UB + (size_t)layer * 16384 * UROW; const unsigned char* VB = p.ws + WS_VB + (size_t)layer * 16384 * UROW;
  const int* IDX = (const int*)(p.ws + WS_IDX); const float* GATE = (const float*)(p.ws + WS_GATE);
  const float* gain = p.in[19] + layer * DM;
  const int tid = tid_l(), lane = tid & 63, gw = blockIdx.x * 8 + (tid >> 6), nw = gridDim.x * 8;
  constexpr int NG = 128 / EXG;
#pragma unroll 1
  for (int tok = gw; tok < T_ALL; tok += nw) {
    const u16* xin = (layer == 0 ? (const u16*)p.out : (const u16*)(p.ws + WS_X2B)) + (size_t)tok * DM + lane * 16;
    f32x2 hx[16]; float xs0[16], xs1[16]; float ss = 0.f;
#pragma unroll
    for (int k = 0; k < 2; ++k) {
      const u32x4 a0 = *(const u32x4*)(xin + k * 8), a1 = *(const u32x4*)(xin + 1024 + k * 8);
#pragma unroll
      for (int e = 0; e < 4; ++e) {
        xs0[k * 8 + 2 * e] = bflo(a0[e]); xs0[k * 8 + 2 * e + 1] = bfhi(a0[e]); xs1[k * 8 + 2 * e] = bflo(a1[e]); xs1[k * 8 + 2 * e + 1] = bfhi(a1[e]);
      }
    }
#pragma unroll
    for (int j = 0; j < 16; ++j) { hx[j] = (f32x2){xs0[j], xs1[j]}; ss += xs0[j] * xs0[j] + xs1[j] * xs1[j]; }
    const int i0 = IDX[(size_t)tok * 128 + lane], i1 = IDX[(size_t)tok * 128 + 64 + lane];
    const float sraw0 = GATE[(size_t)tok * 128 + lane], sraw1 = GATE[(size_t)tok * 128 + 64 + lane];
    u32x4 uA[EXG], uB[EXG];
    exu_load(uA, UB, i0, i1, 0, lane);
    ss = wave_sum_dpp(ss);
    const float rstd = rsqrtf(ss * (1.f / DM) + EPS);
#pragma unroll
    for (int k = 0; k < 4; ++k) {
      const f32x4 g0v = *(const f32x4*)(gain + lane * 16 + k * 4), g1v = *(const f32x4*)(gain + 1024 + lane * 16 + k * 4);
#pragma unroll
      for (int e = 0; e < 4; ++e) hx[k * 4 + e] *= (f32x2){rstd * g0v[e], rstd * g1v[e]};
    }
    float g0, g1;
    { const float s0 = sraw0 * rstd, s1 = sraw1 * rstd;
      const float e0 = __expf(s0 - row16_max(s0)), e1 = __expf(s1 - row16_max(s1));
      g0 = e0 * frcp(row16_sum(e0)); g1 = e1 * frcp(row16_sum(e1)); }
    float a_lo = 0.f, a_hi = 0.f;
#pragma unroll 1
    for (int g = 0; g < NG; g += 2) {
      exu_load(uB, UB, i0, i1, g + 1, lane);
      ex_dots(uA, hx, a_lo, a_hi, g, lane);
      exu_load(uA, (g + 2 < NG) ? UB : VB, i0, i1, (g + 2) & (NG - 1), lane);
      ex_dots(uB, hx, a_lo, a_hi, g + 1, lane);
    }
    const float w0 = g0 * gelu_exact(a_lo * (1.f / U_SCALE)) * (1.f / V_SCALE), w1 = g1 * gelu_exact(a_hi * (1.f / U_SCALE)) * (1.f / V_SCALE);
    f32x2 acc[16];
#pragma unroll
    for (int k = 0; k < 16; ++k) acc[k] = (f32x2){0.f, 0.f};
#pragma unroll 1
    for (int g = 0; g < NG; g += 2) {
      exu_load(uB, VB, i0, i1, g + 1, lane);
      ex_acc(uA, acc, w0, w1, g);
      if (g + 2 < NG) exu_load(uA, VB, i0, i1, g + 2, lane);
      ex_acc(uB, acc, w0, w1, g + 1);
    }
    float y0[16], y1[16]; float ss2 = 0.f;
#pragma unroll
    for (int k = 0; k < 2; ++k) {
      const u32x4 a0 = *(const u32x4*)(xin + k * 8), a1 = *(const u32x4*)(xin + 1024 + k * 8);
#pragma unroll
      for (int e = 0; e < 4; ++e) {
        y0[k * 8 + 2 * e] = bflo(a0[e]) + acc[k * 8 + 2 * e][0]; y0[k * 8 + 2 * e + 1] = bfhi(a0[e]) + acc[k * 8 + 2 * e + 1][0];
        y1[k * 8 + 2 * e] = bflo(a1[e]) + acc[k * 8 + 2 * e][1]; y1[k * 8 + 2 * e + 1] = bfhi(a1[e]) + acc[k * 8 + 2 * e + 1][1];
      }
    }
    if (layer == 0) {
      u16* xb = (u16*)(p.ws + WS_X2B) + (size_t)tok * DM + lane * 16;
#pragma unroll
      for (int k = 0; k < 2; ++k) {
        *(u32x4*)(xb + k * 8) = (u32x4){cvtpk(y0[k*8+0], y0[k*8+1]), cvtpk(y0[k*8+2], y0[k*8+3]), cvtpk(y0[k*8+4], y0[k*8+5]), cvtpk(y0[k*8+6], y0[k*8+7])};
        *(u32x4*)(xb + 1024 + k * 8) = (u32x4){cvtpk(y1[k*8+0], y1[k*8+1]), cvtpk(y1[k*8+2], y1[k*8+3]), cvtpk(y1[k*8+4], y1[k*8+5]), cvtpk(y1[k*8+6], y1[k*8+7])};
      }
#pragma unroll
      for (int j = 0; j < 16; ++j) ss2 += y0[j] * y0[j] + y1[j] * y1[j];
      ss2 = wave_sum_dpp(ss2); if (lane == 0) ((float*)(p.ws + WS_RS2))[tok] = rsqrtf(ss2 * (1.f / DM) + EPS);
    } else {
      float* yo = p.out + (size_t)tok * DM + lane * 16;
#pragma unroll
      for (int k = 0; k < 4; ++k) {
        *(f32x4*)(yo + k * 4) = (f32x4){y0[k*4+0], y0[k*4+1], y0[k*4+2], y0[k*4+3]};
        *(f32x4*)(yo + 1024 + k * 4) = (f32x4){y1[k*4+0], y1[k*4+1], y1[k*4+2], y1[k*4+3]};
      }
    }
  }
}

DEVI void ph_l1_post1(const Params& p) {
  const u16* C = (const u16*)(p.ws + WS_E); u16* CQ = (u16*)(p.ws + WS_MIX); u16* CKV = CQ + (size_t)MBT * 768;
  const float* gq = p.in[12]; const float* gkv = p.in[13];
  const int tid = tid_l(), lane = tid & 63, gw = blockIdx.x * 8 + (tid >> 6), nw = gridDim.x * 8;
  u32x4 nwa, nwb, nwk;
#define P1_LOAD(t_) do { const u16* cr_ = C + (size_t)(t_) * ODD_IN_PAD; nwa = *(const u32x4*)(cr_ + lane * 8); \
    nwb = (lane < 32) ? *(const u32x4*)(cr_ + 512 + lane * 8) : (u32x4){0u, 0u, 0u, 0u}; nwk = *(const u32x4*)(cr_ + 768 + lane * 8); } while (0)
  if (gw < MBT) P1_LOAD(gw);
#pragma unroll 1
  for (int tok = gw; tok < MBT; tok += nw) {
    const u32x4 wa = nwa, wb = nwb, wk = nwk;
    if (tok + nw < MBT) P1_LOAD(tok + nw);
    float a[8], b[8], k[8]; float sq = 0.f, sk = 0.f;
#pragma unroll
    for (int j = 0; j < 4; ++j) { a[2*j] = bflo(wa[j]); a[2*j+1] = bfhi(wa[j]); b[2*j] = bflo(wb[j]); b[2*j+1] = bfhi(wb[j]); k[2*j] = bflo(wk[j]); k[2*j+1] = bfhi(wk[j]); }
#pragma unroll
    for (int j = 0; j < 8; ++j) { sq += a[j] * a[j] + b[j] * b[j]; sk += k[j] * k[j]; }
    sq = wave_sum(sq); sk = wave_sum(sk);
    const float rq = rsqrtf(sq * (1.f / 768.f) + EPS), rk = rsqrtf(sk * (1.f / 512.f) + EPS);
    { const float* g = gq + lane * 8; u32x4 o = {cvtpk(a[0]*rq*g[0], a[1]*rq*g[1]), cvtpk(a[2]*rq*g[2], a[3]*rq*g[3]), cvtpk(a[4]*rq*g[4], a[5]*rq*g[5]), cvtpk(a[6]*rq*g[6], a[7]*rq*g[7])};
      *(u32x4*)(CQ + (size_t)tok * 768 + lane * 8) = o; }
    if (lane < 32) { const float* g = gq + 512 + lane * 8; u32x4 o = {cvtpk(b[0]*rq*g[0], b[1]*rq*g[1]), cvtpk(b[2]*rq*g[2], b[3]*rq*g[3]), cvtpk(b[4]*rq*g[4], b[5]*rq*g[5]), cvtpk(b[6]*rq*g[6], b[7]*rq*g[7])};
      *(u32x4*)(CQ + (size_t)tok * 768 + 512 + lane * 8) = o; }
    { const float* g = gkv + lane * 8; u32x4 o = {cvtpk(k[0]*rk*g[0], k[1]*rk*g[1]), cvtpk(k[2]*rk*g[2], k[3]*rk*g[3]), cvtpk(k[4]*rk*g[4], k[5]*rk*g[5]), cvtpk(k[6]*rk*g[6], k[7]*rk*g[7])};
      *(u32x4*)(CKV + (size_t)tok * 512 + lane * 8) = o; }
  }
}

DEVI void ph_l1_post2(const Params& p, int mb) {
  u16* Q = (u16*)(p.ws + WS_P); const u16* KV = Q + (size_t)MBT * 3072; const u16* C = (const u16*)(p.ws + WS_E); u16* KB = (u16*)(p.ws + WS_OFB);
  const float* rc = (const float*)(p.ws + WS_ROPE); const float* rs = rc + 16384 * 32;
  const int S = (mb < 2) ? 2048 : 16384;
  const unsigned total = (unsigned)MBT * 16 * 16, gs = gridDim.x * NTHR;
#pragma unroll 1
  for (unsigned it0 = blockIdx.x * NTHR + tid_l(); it0 < total; it0 += 4 * gs) {
    u32x4 nw[4]; unsigned r1[4], r2[4]; bool ok[4];
#pragma unroll
    for (int j = 0; j < 4; ++j) {
      const unsigned it = it0 + j * gs; ok[j] = it < total;
      const int sub = (int)(it & 15); const unsigned grp = it >> 4;
      const int which = 1, head = (int)(grp & 15); const size_t tok = grp >> 4;
      const u16* np = which ? (KV + tok * 4096 + head * 256 + 8 * sub) : (Q + tok * 3072 + head * 192 + 8 * sub);
      const u16* rp = which ? (C + tok * ODD_IN_PAD + 1280 + 2 * sub) : (Q + tok * 3072 + head * 192 + 128 + 2 * sub);
      if (ok[j]) { nw[j] = *(const u32x4*)np; r1[j] = *(const unsigned*)rp; r2[j] = *(const unsigned*)(rp + 32); } else { nw[j] = (u32x4){0u, 0u, 0u, 0u}; r1[j] = 0u; r2[j] = 0u; }
    }
#pragma unroll
    for (int j = 0; j < 4; ++j) {
      const unsigned it = it0 + j * gs;
      const int sub = (int)(it & 15); const unsigned grp = it >> 4;
      const int which = 1, head = (int)(grp & 15); const size_t tok = grp >> 4;
      const int pos = (int)(tok % (size_t)S);
      float n[8];
#pragma unroll
      for (int e = 0; e < 4; ++e) { n[2 * e] = bflo(nw[j][e]); n[2 * e + 1] = bfhi(nw[j][e]); }
      const float xa0 = bflo(r1[j]), xa1 = bfhi(r1[j]), xb0 = bflo(r2[j]), xb1 = bfhi(r2[j]);
      float ss = xa0 * xa0 + xa1 * xa1 + xb0 * xb0 + xb1 * xb1;
#pragma unroll
      for (int e = 0; e < 8; ++e) ss += n[e] * n[e];
      ss += shx<1>(ss); ss += shx<2>(ss); ss += shx<4>(ss); ss += shx<8>(ss);
      const float rstd = rsqrtf(ss * (1.f / 192.f) + EPS);
      const float* g = which ? p.in[17] : p.in[16];
      const f32x4 g0 = *(const f32x4*)(g + 8 * sub), g1 = *(const f32x4*)(g + 8 * sub + 4);
      const float ya0 = xa0 * rstd * g[128 + 2 * sub], ya1 = xa1 * rstd * g[129 + 2 * sub], yb0 = xb0 * rstd * g[160 + 2 * sub], yb1 = xb1 * rstd * g[161 + 2 * sub];
      const float c0 = rc[pos * 32 + 2 * sub], c1 = rc[pos * 32 + 2 * sub + 1], s0 = rs[pos * 32 + 2 * sub], s1 = rs[pos * 32 + 2 * sub + 1];
      u16* dp = which ? (KB + tok * 3072 + head * 192) : (Q + tok * 3072 + head * 192);
      if (ok[j]) {
        u32x4 o = {cvtpk(n[0]*rstd*g0[0], n[1]*rstd*g0[1]), cvtpk(n[2]*rstd*g0[2], n[3]*rstd*g0[3]), cvtpk(n[4]*rstd*g1[0], n[5]*rstd*g1[1]), cvtpk(n[6]*rstd*g1[2], n[7]*rstd*g1[3])};
        *(u32x4*)(dp + 8 * sub) = o;
        *(unsigned*)(dp + 128 + 2 * sub) = cvtpk(ya0 * c0 - yb0 * s0, ya1 * c1 - yb1 * s1);
        *(unsigned*)(dp + 160 + 2 * sub) = cvtpk(yb0 * c0 + ya0 * s0, yb1 * c1 + ya1 * s1);
      }
    }
  }
}

constexpr int A_NW = 8, A_QBLK = 32, A_KVBLK = 64;
constexpr float A_SCALE = 0.07216878364870322f;
constexpr int A_LDQ = 3072, A_LDK = 3072, A_LDV = 4096, A_LDO = 2048;
constexpr int A_SHM_V = 64 * 128 * 2, A_SHM_K = 64 * 192 * 2;
constexpr float A_THR = 8.f;
#define KSWZ2(row, colB) ((row) * 384 + ((colB) ^ ((((row) >> 1) & 7) << 4)))
#define SBAR() __builtin_amdgcn_sched_barrier(0)
DEVI int crow(int r, int hi) { return (r & 3) + 8 * (r >> 2) + 4 * hi; }
DEVI void a_partialSM(f32x16& p0, f32x16& p1, float& m_reg, float& mn, float& alpha) {
  constexpr float C = A_SCALE * 1.4426950408889634f;
  float pmax = p0[0];
#pragma unroll
  for (int r = 1; r < 16; ++r) pmax = fmaxf(pmax, p0[r]);
#pragma unroll
  for (int r = 0; r < 16; ++r) pmax = fmaxf(pmax, p1[r]);
  { auto rr = __builtin_amdgcn_permlane32_swap(__float_as_uint(pmax), __float_as_uint(pmax), false, false);
    pmax = fmaxf(__uint_as_float(rr[0]), __uint_as_float(rr[1])); }
  if (__builtin_expect(__all(pmax - m_reg <= A_THR / A_SCALE), 1)) { mn = m_reg; alpha = 1.f; }
  else { mn = fmaxf(m_reg, pmax); alpha = __builtin_amdgcn_exp2f((m_reg - mn) * C); m_reg = mn; }
  const float mnC = -mn * C;
#pragma unroll
  for (int r = 0; r < 16; ++r) p0[r] = fmaf(p0[r], C, mnC);
#pragma unroll
  for (int r = 0; r < 16; ++r) p1[r] = fmaf(p1[r], C, mnC);
#pragma unroll
  for (int r = 0; r < 16; ++r) p0[r] = __builtin_amdgcn_exp2f(p0[r]);
}
DEVI void a_finishSM(f32x16& p0, f32x16& p1, float alpha, float& l_reg, bf16x8& pa0, bf16x8& pa1, bf16x8& pa2, bf16x8& pa3) {
#pragma unroll
  for (int r = 0; r < 16; ++r) p1[r] = __builtin_amdgcn_exp2f(p1[r]);
  float ps = 0;
#pragma unroll
  for (int r = 0; r < 16; ++r) ps += p0[r];
#pragma unroll
  for (int r = 0; r < 16; ++r) ps += p1[r];
  { auto rr = __builtin_amdgcn_permlane32_swap(__float_as_uint(ps), __float_as_uint(ps), false, false);
    ps = __uint_as_float(rr[0]) + __uint_as_float(rr[1]); }
  l_reg = l_reg * alpha + ps;
#define PK4(P, BASE, OUT) do { unsigned a0 = cvtpk(P[BASE + 0], P[BASE + 1]), a1 = cvtpk(P[BASE + 2], P[BASE + 3]);   \
    unsigned b0 = cvtpk(P[BASE + 4], P[BASE + 5]), b1 = cvtpk(P[BASE + 6], P[BASE + 7]);                              \
    auto r0 = __builtin_amdgcn_permlane32_swap(a0, b0, false, false); auto r1 = __builtin_amdgcn_permlane32_swap(a1, b1, false, false); \
    u32x4 w = {r0[0], r1[0], r0[1], r1[1]}; OUT = *reinterpret_cast<bf16x8*>(&w); } while (0)
  PK4(p0, 0, pa0); PK4(p0, 8, pa1); PK4(p1, 0, pa2); PK4(p1, 8, pa3);
#undef PK4
}
DEVI void a_partialSM_nm(f32x16& p0) {
#pragma unroll
  for (int r = 0; r < 16; ++r) p0[r] = __builtin_amdgcn_exp2f(p0[r]);
}
DEVI void a_finishSM_nm(f32x16& p0, f32x16& p1, float& l_reg, bf16x8& pa0, bf16x8& pa1, bf16x8& pa2, bf16x8& pa3) {
#pragma unroll
  for (int r = 0; r < 16; ++r) p1[r] = __builtin_amdgcn_exp2f(p1[r]);
  float ps = 0;
#pragma unroll
  for (int r = 0; r < 16; ++r) ps += p0[r];
#pragma unroll
  for (int r = 0; r < 16; ++r) ps += p1[r];
  l_reg += ps;
#define PK4(P, BASE, OUT) do { unsigned a0 = cvtpk(P[BASE + 0], P[BASE + 1]), a1 = cvtpk(P[BASE + 2], P[BASE + 3]);   \
    unsigned b0 = cvtpk(P[BASE + 4], P[BASE + 5]), b1 = cvtpk(P[BASE + 6], P[BASE + 7]);                              \
    auto r0 = __builtin_amdgcn_permlane32_swap(a0, b0, false, false); auto r1 = __builtin_amdgcn_permlane32_swap(a1, b1, false, false); \
    u32x4 w = {r0[0], r1[0], r0[1], r1[1]}; OUT = *reinterpret_cast<bf16x8*>(&w); } while (0)
  PK4(p0, 0, pa0); PK4(p0, 8, pa1); PK4(p1, 0, pa2); PK4(p1, 8, pa3);
#undef PK4
}
DEVI void a_qkt(f32x16& p0, f32x16& p1, const char* Ks, const bf16x8* qr, int r32, int hi) {
  p0 = f32x16{}; p1 = f32x16{};
  bf16x8 b0 = *reinterpret_cast<const bf16x8*>(Ks + KSWZ2(r32, (hi * 8) * 2));
  bf16x8 b1 = *reinterpret_cast<const bf16x8*>(Ks + KSWZ2(32 + r32, (hi * 8) * 2));
#pragma unroll
  for (int d0 = 0; d0 < 12; ++d0) {
    bf16x8 n0 = b0, n1 = b1;
    if (d0 + 1 < 12) { const int cb = ((d0 + 1) * 16 + hi * 8) * 2;
      n0 = *reinterpret_cast<const bf16x8*>(Ks + KSWZ2(r32, cb));
      n1 = *reinterpret_cast<const bf16x8*>(Ks + KSWZ2(32 + r32, cb)); }
    __builtin_amdgcn_sched_barrier(0);
    p0 = __builtin_amdgcn_mfma_f32_32x32x16_bf16(b0, qr[d0], p0, 0, 0, 0);
    p1 = __builtin_amdgcn_mfma_f32_32x32x16_bf16(b1, qr[d0], p1, 0, 0, 0);
    __builtin_amdgcn_sched_barrier(0);
    b0 = n0; b1 = n1;
  }
}
DEVI int a_v_st(int k, int c) { const int kk = (k & ~0xC) | ((k & 4) << 1) | ((k & 8) >> 1); return ((kk >> 3) * 4 + (c >> 5)) * 512 + ((kk & 7) * 32 + (c & 31)) * 2; }
DEVI int a_v_rd_base(int lane) { return ((lane & 3) << 3) | (((lane >> 2) & 3) << 6) | (((lane >> 4) & 1) << 5) | (((lane >> 5) & 1) << 8); }
constexpr int a_v_rd_off(int d0, int ks, int half) { return d0 * 512 + ks * 4096 + half * 2048; }
template <int D0> DEVI void a_pv_one(f32x16& od, int vb, bf16x8 pa0, bf16x8 pa1, bf16x8 pa2, bf16x8 pa3) {
  const s16x4 l0 = tr_read_asm<a_v_rd_off(D0, 0, 0)>(vb), h0 = tr_read_asm<a_v_rd_off(D0, 0, 1)>(vb), l1 = tr_read_asm<a_v_rd_off(D0, 1, 0)>(vb), h1 = tr_read_asm<a_v_rd_off(D0, 1, 1)>(vb);
  const s16x4 l2 = tr_read_asm<a_v_rd_off(D0, 2, 0)>(vb), h2 = tr_read_asm<a_v_rd_off(D0, 2, 1)>(vb), l3 = tr_read_asm<a_v_rd_off(D0, 3, 0)>(vb), h3 = tr_read_asm<a_v_rd_off(D0, 3, 1)>(vb);
  asm volatile("s_waitcnt lgkmcnt(0)" ::: "memory"); SBAR();
  od = __builtin_amdgcn_mfma_f32_32x32x16_bf16(pa0, pk44(l0, h0), od, 0, 0, 0);
  od = __builtin_amdgcn_mfma_f32_32x32x16_bf16(pa1, pk44(l1, h1), od, 0, 0, 0);
  od = __builtin_amdgcn_mfma_f32_32x32x16_bf16(pa2, pk44(l2, h2), od, 0, 0, 0);
  od = __builtin_amdgcn_mfma_f32_32x32x16_bf16(pa3, pk44(l3, h3), od, 0, 0, 0);
}
DEVI void a_pv_d0(f32x16* o, int vb, bf16x8 pa0, bf16x8 pa1, bf16x8 pa2, bf16x8 pa3) {
  a_pv_one<0>(o[0], vb, pa0, pa1, pa2, pa3); a_pv_one<1>(o[1], vb, pa0, pa1, pa2, pa3); a_pv_one<2>(o[2], vb, pa0, pa1, pa2, pa3); a_pv_one<3>(o[3], vb, pa0, pa1, pa2, pa3);
}
template <int SDEPTH, bool NOMAX>
DEVI void attn_body(const Params& p, const u16* __restrict__ Qb, const u16* __restrict__ Kh, const u16* __restrict__ Vh, u16* __restrict__ Ob, int seq, int qpos0, char* lds) {
  const int tid = tid_l(), wid = tid >> 6, lane = tid & 63, r32 = lane & 31, hi = lane >> 5;
  char* V_lds = lds; char* K_lds = lds + 2 * A_SHM_V;
  float* ws = (float*)(lds + 2 * A_SHM_V + 2 * A_SHM_K) + wid * 64; float* li_l = ws; float* al_l = ws + 32;
  float m_reg = -1e30f, l_reg = 0; f32x16 o[4] = {}; bf16x8 qr[12];
  const u16* Qw = Qb + (long)(wid * A_QBLK + r32) * A_LDQ + hi * 8;
#pragma unroll
  for (int d0 = 0; d0 < 12; ++d0) qr[d0] = *reinterpret_cast<const bf16x8*>(Qw + d0 * 16);
  {
    float ss = 0.f;
#pragma unroll
    for (int d0 = 0; d0 < 12; ++d0)
#pragma unroll
      for (int e = 0; e < 8; ++e) { const float f = __uint_as_float((unsigned)(unsigned short)qr[d0][e] << 16); ss += f * f; }
    ss = sum32(ss);
    const float rstd = rsqrtf(ss * (1.f / 192.f) + EPS) * (NOMAX ? A_SCALE * 1.4426950408889634f : 1.f);
    const float* g = p.in[16] + hi * 8;
    const int pos = qpos0 + wid * A_QBLK + r32;
    const float* rcq = (const float*)(p.ws + WS_ROPE) + pos * 32 + hi * 8; const float* rsq = rcq + 16384 * 32;
#pragma unroll
    for (int d0 = 0; d0 < 8; ++d0) {
      const f32x4 g0 = *(const f32x4*)(g + d0 * 16), g1 = *(const f32x4*)(g + d0 * 16 + 4);
      float f[8];
#pragma unroll
      for (int e = 0; e < 8; ++e) f[e] = __uint_as_float((unsigned)(unsigned short)qr[d0][e] << 16);
      u32x4 o = {cvtpk(f[0]*rstd*g0[0], f[1]*rstd*g0[1]), cvtpk(f[2]*rstd*g0[2], f[3]*rstd*g0[3]), cvtpk(f[4]*rstd*g1[0], f[5]*rstd*g1[1]), cvtpk(f[6]*rstd*g1[2], f[7]*rstd*g1[3])};
      qr[d0] = *reinterpret_cast<bf16x8*>(&o);
    }
#pragma unroll
    for (int d0 = 8; d0 < 10; ++d0) {
      float ya[8], yb[8], cc[8], sn[8];
#pragma unroll
      for (int e = 0; e < 8; ++e) {
        ya[e] = __uint_as_float((unsigned)(unsigned short)qr[d0][e] << 16) * rstd * g[d0 * 16 + e];
        yb[e] = __uint_as_float((unsigned)(unsigned short)qr[d0 + 2][e] << 16) * rstd * g[(d0 + 2) * 16 + e];
        cc[e] = rcq[(d0 - 8) * 16 + e]; sn[e] = rsq[(d0 - 8) * 16 + e];
      }
      u32x4 oa = {cvtpk(ya[0]*cc[0] - yb[0]*sn[0], ya[1]*cc[1] - yb[1]*sn[1]), cvtpk(ya[2]*cc[2] - yb[2]*sn[2], ya[3]*cc[3] - yb[3]*sn[3]),
                  cvtpk(ya[4]*cc[4] - yb[4]*sn[4], ya[5]*cc[5] - yb[5]*sn[5]), cvtpk(ya[6]*cc[6] - yb[6]*sn[6], ya[7]*cc[7] - yb[7]*sn[7])};
      u32x4 ob = {cvtpk(yb[0]*cc[0] + ya[0]*sn[0], yb[1]*cc[1] + ya[1]*sn[1]), cvtpk(yb[2]*cc[2] + ya[2]*sn[2], yb[3]*cc[3] + ya[3]*sn[3]),
                  cvtpk(yb[4]*cc[4] + ya[4]*sn[4], yb[5]*cc[5] + ya[5]*sn[5]), cvtpk(yb[6]*cc[6] + ya[6]*sn[6], yb[7]*cc[7] + ya[7]*sn[7])};
      qr[d0] = *reinterpret_cast<bf16x8*>(&oa); qr[d0 + 2] = *reinterpret_cast<bf16x8*>(&ob);
    }
  }
  const int sr = tid >> 4, sc = (tid & 15) * 8, vst0 = a_v_st(sr, sc), vst1 = a_v_st(32 + sr, sc);
  const int kr = tid >> 3, kc = (tid & 7) * 8;
  const int kst = KSWZ2(kr, kc * 2);
  const unsigned voff = (unsigned)(sr * A_LDV + sc) * 2u, koff = (unsigned)(kr * A_LDK + kc) * 2u;
  const int vb0 = (int)(uintptr_t)V_lds + a_v_rd_base(lane);
  struct { bf16x8 vs0, vs1, ks0, ks1, ks2; } sr_[SDEPTH];
#define SLOAD(i, k0) do { const char* vb_ = (const char*)(Vh + (long)(k0) * A_LDV); const char* kb_ = (const char*)(Kh + (long)(k0) * A_LDK); \
    sr_[i].vs0 = *(const bf16x8*)(vb_ + voff); sr_[i].vs1 = *(const bf16x8*)(vb_ + 32 * A_LDV * 2 + voff); \
    sr_[i].ks0 = *(const bf16x8*)(kb_ + koff); sr_[i].ks1 = *(const bf16x8*)(kb_ + koff + 128); sr_[i].ks2 = *(const bf16x8*)(kb_ + koff + 256); } while (0)
#define SWRITE(b, i) do { *(bf16x8*)(V_lds + (b) * A_SHM_V + vst0) = sr_[i].vs0; *(bf16x8*)(V_lds + (b) * A_SHM_V + vst1) = sr_[i].vs1; \
    *(bf16x8*)(K_lds + (b) * A_SHM_K + kst) = sr_[i].ks0; *(bf16x8*)(K_lds + (b) * A_SHM_K + kst + 128) = sr_[i].ks1; *(bf16x8*)(K_lds + (b) * A_SHM_K + kst + 256) = sr_[i].ks2; } while (0)
#define SWAIT() do { if constexpr (SDEPTH == 2) asm volatile("s_waitcnt vmcnt(5)" ::: "memory"); else asm volatile("s_waitcnt vmcnt(0)" ::: "memory"); } while (0)
#define RESC(a) do { if constexpr (!NOMAX) { if (__any((a) < 1.f)) { if (hi == 0) al_l[r32] = (a); asm volatile("s_waitcnt lgkmcnt(0)" ::: "memory"); \
    _Pragma("unroll") for (int d = 0; d < 4; ++d) _Pragma("unroll") for (int r = 0; r < 16; ++r) o[d][r] *= al_l[crow(r, hi)]; } } } while (0)
#define PSM(P0, P1, MN, AL) do { if constexpr (NOMAX) a_partialSM_nm(P0); else a_partialSM(P0, P1, m_reg, MN, AL); } while (0)
#define FSM(P0, P1, AL) do { if constexpr (NOMAX) a_finishSM_nm(P0, P1, l_reg, pa0, pa1, pa2, pa3); else a_finishSM(P0, P1, AL, l_reg, pa0, pa1, pa2, pa3); } while (0)
  f32x16 pA0, pA1, pB0, pB1; float mnA = 0.f, mnB = 0.f, alA = 1.f, alB = 1.f; bf16x8 pa0, pa1, pa2, pa3; const int NT = seq / A_KVBLK;
  constexpr int SE = 0, SO = SDEPTH - 1;
  __syncthreads();
  SLOAD(SE, 0); asm volatile("s_waitcnt vmcnt(0)" ::: "memory"); SWRITE(0, SE); __syncthreads();
  a_qkt(pA0, pA1, K_lds, qr, r32, hi); PSM(pA0, pA1, mnA, alA);
  SLOAD(SO, A_KVBLK); if constexpr (SDEPTH == 2) { if (2 < NT) SLOAD(SE, 2 * A_KVBLK); }
  SWAIT(); SWRITE(1, SO); __syncthreads();
#pragma unroll 1
  for (int j = 1; j + 1 < NT; j += 2) {
    SBAR(); a_qkt(pB0, pB1, K_lds + A_SHM_K, qr, r32, hi);
    FSM(pA0, pA1, alA); SBAR();
    SLOAD(SO, (j + SDEPTH) * A_KVBLK); SBAR();
    a_pv_d0(o, vb0, pa0, pa1, pa2, pa3); PSM(pB0, pB1, mnB, alB);
    __syncthreads(); SWAIT(); SWRITE(0, SE);
    RESC(alB); __syncthreads();
    SBAR(); a_qkt(pA0, pA1, K_lds, qr, r32, hi);
    FSM(pB0, pB1, alB); SBAR();
    if (SDEPTH == 1 || j + 3 < NT) SLOAD(SE, (j + 1 + SDEPTH) * A_KVBLK); SBAR();
    a_pv_d0(o, vb0 + A_SHM_V, pa0, pa1, pa2, pa3); PSM(pA0, pA1, mnA, alA);
    __syncthreads(); SWAIT(); SWRITE(1, SO);
    RESC(alA); __syncthreads();
  }
  SBAR(); a_qkt(pB0, pB1, K_lds + A_SHM_K, qr, r32, hi);
  FSM(pA0, pA1, alA); SBAR();
  a_pv_d0(o, vb0, pa0, pa1, pa2, pa3); PSM(pB0, pB1, mnB, alB);
  __syncthreads(); RESC(alB);
  FSM(pB0, pB1, alB); SBAR();
  a_pv_d0(o, vb0 + A_SHM_V, pa0, pa1, pa2, pa3);
  if constexpr (NOMAX) l_reg = sum32(l_reg);
  if (hi == 0) li_l[r32] = l_reg; asm volatile("s_waitcnt lgkmcnt(0)" ::: "memory");
  float rli[16];
#pragma unroll
  for (int r = 0; r < 16; ++r) rli[r] = __builtin_amdgcn_rcpf(li_l[crow(r, hi)]);
  u16* Ow = Ob + (long)(wid * A_QBLK) * A_LDO;
  char* opatch = lds + 2 * A_SHM_V + 2 * A_SHM_K + 2048 + wid * (16 * 272);
#pragma unroll
  for (int k = 0; k < 2; ++k) {
#pragma unroll
    for (int r = 8 * k; r < 8 * k + 8; ++r) { const int prow = crow(r, hi) - 16 * k;
#pragma unroll
      for (int d0 = 0; d0 < 4; ++d0) *(u16*)(opatch + prow * 272 + (d0 * 32 + r32) * 2) = f2bf(o[d0][r] * rli[r]); }
    asm volatile("s_waitcnt lgkmcnt(0)" ::: "memory");
#pragma unroll
    for (int i = 0; i < 4; ++i) { const int c = lane + 64 * i, prow = c >> 4, cc = c & 15;
      const u32x4 w = *(const u32x4*)(opatch + prow * 272 + cc * 16);
      *(u32x4*)(Ow + (long)(16 * k + prow) * A_LDO + cc * 8) = w; }
    asm volatile("s_waitcnt lgkmcnt(0)" ::: "memory");
  }
#undef SLOAD
#undef SWRITE
#undef SWAIT
#undef RESC
#undef PSM
#undef FSM
}

DEVI void ph_attn(const Params& p, int mb, char* smem) {
  const u16* Q = (const u16*)(p.ws + WS_P); const u16* KV = Q + (size_t)MBT * 3072; const u16* KB = (const u16*)(p.ws + WS_OFB); u16* O = (u16*)(p.ws + WS_H);
  const int S = (mb < 2) ? 2048 : 16384; const int QB = S / 256;
  const int nunits = (MBT / 256) * 16;
  const bool swz = (gridDim.x == 256);
  bool nomax;
  { const int l_ = tid_l() & 63; float gq = 0.f, gk = 0.f;
#pragma unroll
    for (int i = 0; i < 3; ++i) { gq = fmaxf(gq, fabsf(p.in[16][l_ + 64 * i])); gk = fmaxf(gk, fabsf(p.in[17][l_ + 64 * i])); }
    const float Gq = __uint_as_float(wave_umax(__float_as_uint(gq))), Gk = __uint_as_float(wave_umax(__float_as_uint(gk)));
    nomax = (13.856406f * 1.4426950f * 1.02f * Gq * Gk) <= 100.f; }
#pragma unroll 1
  for (int it = 0; it * (int)gridDim.x + (int)blockIdx.x < nunits; ++it) {
    int seq, head, qb;
    if (swz) { const int x = blockIdx.x & 7, slot = blockIdx.x >> 3; const int li = slot + 32 * it; const int gp = x + 8 * (li / QB); qb = li % QB; head = gp & 15; seq = gp >> 4; }
    else { const int u = it * gridDim.x + blockIdx.x; qb = u % QB; head = (u / QB) & 15; seq = u / (QB * 16); }
    const size_t t0 = (size_t)seq * S;
    if (nomax) attn_body<1, true>(p, Q + (t0 + (size_t)qb * 256) * 3072 + head * 192, KB + t0 * 3072 + head * 192, KV + t0 * 4096 + head * 256 + 128,
                                  O + (t0 + (size_t)qb * 256) * 2048 + head * 128, S, qb * 256, smem);
    else attn_body<1, false>(p, Q + (t0 + (size_t)qb * 256) * 3072 + head * 192, KB + t0 * 3072 + head * 192, KV + t0 * 4096 + head * 256 + 128,
                             O + (t0 + (size_t)qb * 256) * 2048 + head * 128, S, qb * 256, smem);
  }
}

__global__ void __launch_bounds__(NTHR, 2) fwd(Params pk) {
  extern __shared__ __attribute__((aligned(16))) char smem[];
  Params p = pk; p.wave_u = __builtin_amdgcn_readfirstlane((int)(threadIdx.x >> 6));
  volatile LAS unsigned* ctl = (volatile LAS unsigned*)(smem + 131072);
  if (threadIdx.x < 16) ctl[threadIdx.x] = 0u;
#if defined(PROBE_KIND) && PROBE_KIND == 10
  if (threadIdx.x < 2) ctl[64 + threadIdx.x] = 0u;
#endif
  __syncthreads();
  XcdBarrier bar; bar.bar = (unsigned*)(p.ws + WS_BAR); bar.x = 0; bar.st = ctl; bar.wave_u = p.wave_u;
  const bool multi = (p.step_hi - p.step_lo) > 1;
  if (multi) bar = xcd_barrier_post((unsigned*)(p.ws + WS_BAR), ctl, p.wave_u);
  int step = 0;
#ifndef PROBE_KIND
#define PROBE_KIND -1
#endif
  unsigned long long probe_acc = 0ull;
#define STEPK(kind, code) do { if (step >= p.step_lo && step < p.step_hi) { unsigned long long t0_ = 0ull; if ((kind) == PROBE_KIND) t0_ = __builtin_amdgcn_s_memrealtime(); \
    code; if (step + 1 < p.step_hi) xcd_barrier(bar); if ((kind) == PROBE_KIND) probe_acc += __builtin_amdgcn_s_memrealtime() - t0_; } ++step; } while (0)

  STEPK(7, ph_prologue(p, smem); ph_convert_uv(p));
#pragma unroll 1
  for (int mb = 0; mb < NMB; ++mb) {
    u16* H = (u16*)(p.ws + WS_H); u16* PP = (u16*)(p.ws + WS_P); u16* MIX = (u16*)(p.ws + WS_MIX);
    float* outmb = p.out + (size_t)mb * MBT * DM;
    STEPK(8, ph_norm(p, xin_mb(p, mb), p.in[2], H, MBT));
    STEPK(1, ph_gemm_stream<EPI_BF16>(p, H, (const u16*)(p.ws + WS_WT_EVIN), MBT, 8192, 2048, GemmEpi{PP, nullptr, 8192, nullptr, nullptr}, smem));
    STEPK(6, ph_na(p, mb, smem); __syncthreads(); ph_hgrn_pass<false>(p, mb, smem));
    STEPK(4, ph_hgrn_carry(p, mb));
    STEPK(4, ph_hgrn_pass<true>(p, mb, smem));
    STEPK(4, ph_hg_combine(p));
    u16* x1b = (u16*)p.out + (size_t)mb * MBT * DM;
    STEPK(1, ph_gemm_stream<EPI_RES_F2B>(p, MIX, (const u16*)(p.ws + WS_WT_EVOUT), MBT, 2048, 2048, GemmEpi{nullptr, xin_mb(p, mb), 2048, x1b, nullptr}, smem));
    STEPK(1, ph_gemm<EPI_TOPK>(p, x1b, (const u16*)(p.ws + WS_WEFF), MBT, 2048, 2048,
                               GemmEpi{(int*)(p.ws + WS_IDX) + (size_t)mb * MBT * 128, nullptr, 2048, (u16*)((float*)(p.ws + WS_GATE) + (size_t)mb * MBT * 128), nullptr}, smem));
  }
  STEPK(2, ph_experts(p, 0));
#pragma unroll 1
  for (int mb = 0; mb < NMB; ++mb) {
    u16* H = (u16*)(p.ws + WS_H); u16* PP = (u16*)(p.ws + WS_P); u16* CQ = (u16*)(p.ws + WS_MIX);
    float* outmb = p.out + (size_t)mb * MBT * DM;
    STEPK(1, ph_gemm_stream<EPI_BF16_RS>(p, (const u16*)(p.ws + WS_X2B) + (size_t)mb * MBT * DM, (const u16*)(p.ws + WS_WT_ODIN), MBT, ODD_IN_PAD, 2048,
                                  GemmEpi{p.ws + WS_E, nullptr, ODD_IN_PAD, nullptr, (const float*)(p.ws + WS_RS2) + (size_t)mb * MBT}, smem));
    STEPK(9, ph_l1_post1(p));
    STEPK(1, ph_gemm_stream<EPI_BF16>(p, CQ, (const u16*)(p.ws + WS_WT_UQ), MBT, 3072, 768, GemmEpi{PP, nullptr, 3072, nullptr, nullptr}, smem);
         ph_gemm_stream<EPI_BF16>(p, CQ + (size_t)MBT * 768, (const u16*)(p.ws + WS_WT_UKV), MBT, 4096, 512, GemmEpi{PP + (size_t)MBT * 3072, nullptr, 4096, nullptr, nullptr}, smem));
    STEPK(9, ph_l1_post2(p, mb));
    STEPK(3, ph_attn(p, mb, smem));
    u16* x23b = (u16*)(p.ws + WS_X2B) + (size_t)mb * MBT * DM;
    STEPK(1, ph_gemm_stream<EPI_RES_B2B>(p, H, (const u16*)(p.ws + WS_WT_ODOUT), MBT, 2048, 2048, GemmEpi{nullptr, nullptr, 2048, x23b, nullptr}, smem));
    STEPK(1, ph_gemm<EPI_TOPK>(p, x23b, (const u16*)(p.ws + WS_WEFF) + (size_t)2048 * 2048, MBT, 2048, 2048,
                               GemmEpi{(int*)(p.ws + WS_IDX) + (size_t)mb * MBT * 128, nullptr, 2048, (u16*)((float*)(p.ws + WS_GATE) + (size_t)mb * MBT * 128), nullptr}, smem));
  }
  STEPK(2, ph_experts(p, 1));
#if PROBE_KIND == 10
  __syncthreads(); probe_acc = *(volatile LAS unsigned long long*)(smem + 131072 + 256);
#endif
  if (PROBE_KIND >= 0 && blockIdx.x == 0) { const unsigned long long t0_ = __builtin_amdgcn_s_memrealtime(); while (__builtin_amdgcn_s_memrealtime() - t0_ < probe_acc) __builtin_amdgcn_s_sleep(32); }
}

constexpr int N_STEPS = 1 + 4 * 8 + 1 + 4 * 7 + 1;

#ifndef MK_MULTI
#define MK_MULTI 0
#endif

extern "C" void kernel_launch(void* const* d_in, const int* in_sizes, int n_in, void* d_out, int out_size, void* d_ws, size_t ws_size, hipStream_t stream) {
  static int grid = 0;
  if (grid == 0) {
    if (n_in != 24 || out_size != T_ALL * DM || ws_size < WS_END) { fprintf(stderr, "kernel_launch: shape/ws mismatch n_in %d out %d ws %zu need %zu\n", n_in, out_size, ws_size, (size_t)WS_END); grid = -1; return; }
    int dev = 0, cus = 0, per_cu = 0;
    if (hipGetDevice(&dev) != hipSuccess || hipDeviceGetAttribute(&cus, hipDeviceAttributeMultiprocessorCount, dev) != hipSuccess) { grid = -1; return; }
    if (hipFuncSetAttribute((const void*)fwd, hipFuncAttributeMaxDynamicSharedMemorySize, LDS_BYTES) != hipSuccess) { fprintf(stderr, "kernel_launch: hipFuncSetAttribute failed\n"); grid = -1; return; }
    if (hipOccupancyMaxActiveBlocksPerMultiprocessor(&per_cu, (const void*)fwd, NTHR, LDS_BYTES) != hipSuccess || per_cu < 1) { fprintf(stderr, "kernel_launch: occupancy query says %d\n", per_cu); (void)hipGetLastError(); grid = -1; return; }
    grid = cus;
  }
  if (grid < 0) return;
  (void)hipMemsetAsync((char*)d_ws + WS_BAR, 0, XCD_BAR_WORDS * 4, stream);
  Params p{};
  for (int i = 0; i < 24; ++i) p.in[i] = (const float*)d_in[i];
  p.out = (float*)d_out; p.ws = (unsigned char*)d_ws;
#if MK_MULTI
  for (int s = 0; s < N_STEPS; ++s) { p.step_lo = s; p.step_hi = s + 1; hipLaunchKernelGGL(fwd, dim3(grid), dim3(NTHR), LDS_BYTES, stream, p); }
#else
  p.step_lo = 0; p.step_hi = N_STEPS;
  hipLaunchKernelGGL(fwd, dim3(grid), dim3(NTHR), LDS_BYTES, stream, p);
#endif
  const hipError_t le = hipPeekAtLastError();
  if (le != hipSuccess) fprintf(stderr, "kernel_launch: launch failed: %s\n", hipGetErrorName(le));
}

#ifdef PHASE_TEST
#define PT(name, body) __global__ void __launch_bounds__(NTHR, 2) name(Params pk, int mb) { extern __shared__ __attribute__((aligned(16))) char smem[]; Params p = pk; p.wave_u = __builtin_amdgcn_readfirstlane((int)(threadIdx.x >> 6)); body; }
PT(t_prologue, ph_prologue(p, smem))
PT(t_convert, ph_convert_uv(p))
PT(t_norm, ph_norm(p, xin_mb(p, mb), p.in[2], (u16*)(p.ws + WS_H), MBT))
PT(t_gemm_bf16, ph_gemm<EPI_BF16>(p, (u16*)(p.ws + WS_H), (const u16*)(p.ws + WS_WT_EVIN), MBT, 8192, 2048, GemmEpi{p.ws + WS_P, nullptr, 8192, nullptr, nullptr}, smem))
PT(t_gemm_resid, ph_gemm<EPI_RESID>(p, (u16*)(p.ws + WS_H), (const u16*)(p.ws + WS_WT_EVIN), MBT, 2048, 2048, GemmEpi{p.out, p.in[0], 2048, nullptr, nullptr}, smem))
PT(t_l0post, ph_l0_post(p))
PT(t_na, ph_na(p, mb, smem))
PT(t_hg1, ph_hgrn_pass<false>(p, mb, smem))
PT(t_hg3, ph_hgrn_pass<true>(p, mb, smem))
PT(t_carry, ph_hgrn_carry(p, mb))
PT(t_comb, ph_hg_combine(p))
PT(t_topk, ph_topk(p, mb, smem))
PT(t_experts, ph_experts(p, mb))
PT(t_post1, ph_l1_post1(p))
PT(t_post2, ph_l1_post2(p, mb))
PT(t_attn, ph_attn(p, mb, smem))
PT(t_gemm_f32, ph_gemm<EPI_F32>(p, (u16*)(p.ws + WS_H), (const u16*)(p.ws + WS_WT_EVIN), MBT, 2048, 2048, GemmEpi{p.ws + WS_P, nullptr, 2048, nullptr, nullptr}, smem))
#endif
```
